# Optimizing an MI355X kernel written in HIP

```python
import math
import jax
import jax.numpy as jnp
from jax import lax
import numpy as np

D_MODEL = 1024
BATCH = 8
SEQ = 4096
DEPTH = 2

GRID_W = 64
CTX_LEN = 256
ROPE_BASE = 10000.0
NORM_EPS = 1e-6
Q_BLOCK = 128
MASK_VALUE = -1e30
GATE_FLOOR = 1e-30

N_BRANCH = 4
BRANCH_W = D_MODEL // N_BRANCH

A_HEADS = 4
A_KV_HEADS = 2
A_HEAD_DIM = 64
A_WINDOW = 128

B_HEADS = 4
B_KEY_DIM = 64
B_VAL_DIM = 64
B_CHUNK = 64

C_HEADS = 4
C_Q_LORA = 256
C_KV_LORA = 128
C_NOPE = 64
C_ROPE = 32
C_V = 64

D_HEADS = 4
D_HEAD_DIM = 32

N_GROUPS = 4
EXPERTS_PER_GROUP = 8
N_EXPERTS = N_GROUPS * EXPERTS_PER_GROUP
EXPERT_TOP_K = 2
EXPERT_HIDDEN = 256

IN_SPLITS = (
    A_HEADS * A_HEAD_DIM, A_KV_HEADS * A_HEAD_DIM, A_KV_HEADS * A_HEAD_DIM,
    B_HEADS * B_KEY_DIM, B_HEADS * B_KEY_DIM, B_HEADS * B_KEY_DIM,
    B_HEADS * B_VAL_DIM, B_HEADS * B_VAL_DIM,
    C_Q_LORA, C_KV_LORA, C_ROPE,
    2 * D_HEADS * D_HEAD_DIM, 2 * D_HEADS * D_HEAD_DIM, 2 * D_HEADS * D_HEAD_DIM,
)
D_IN = sum(IN_SPLITS)

kernel_name = 'hybrid_parallel_mixer_dit_block'


def rms_norm(x, gain):
    xf = x.astype(jnp.float32)
    y = xf * lax.rsqrt(jnp.mean(jnp.square(xf), axis=-1, keepdims=True) + NORM_EPS)
    return (y * gain.astype(jnp.float32)).astype(x.dtype)


def rope_2d(x, row, col):
    half = x.shape[-1] // 2
    quarter = half // 2
    inv_freq = 1.0 / (ROPE_BASE ** (jnp.arange(quarter, dtype=jnp.float32) / quarter))

    def rotate(xa, pos):
        ang = pos.astype(jnp.float32)[:, None] * inv_freq[None, :]
        cos = jnp.cos(ang)[None, :, None, :]
        sin = jnp.sin(ang)[None, :, None, :]
        xa = xa.astype(jnp.float32)
        x1, x2 = xa[..., :quarter], xa[..., quarter:]
        return jnp.concatenate([x1 * cos - x2 * sin, x2 * cos + x1 * sin], axis=-1)

    out = jnp.concatenate([rotate(x[..., :half], row), rotate(x[..., half:], col)], axis=-1)
    return out.astype(x.dtype)


def _map_query_blocks(fn, q):
    b, l = q.shape[0], q.shape[1]
    nb = l // Q_BLOCK
    qb = jnp.moveaxis(q.reshape((b, nb, Q_BLOCK) + q.shape[2:]), 1, 0)
    out = lax.map(fn, qb)
    return jnp.moveaxis(out, 0, 1).reshape((b, l) + out.shape[3:])


def _softmax_attend(q, k, v, scale):
    s = jnp.einsum('bqhd,bkhd->bhqk', q, k, preferred_element_type=jnp.float32) * scale
    p = jax.nn.softmax(s, axis=-1)
    return jnp.einsum('bhqk,bkhe->bqhe', p.astype(v.dtype), v)


def _sink_softmax(s, sink):
    sink = jnp.broadcast_to(sink, s.shape[:-1] + (1,))
    p = jax.nn.softmax(jnp.concatenate([s, sink], axis=-1), axis=-1)
    return p[..., :-1]


def window_gqa_mixer(q_l, k_l, v_l, q_c, k_c, v_c, sink, row, col, with_ctx):
    b, l, _ = q_l.shape
    n_ctx = q_c.shape[1]
    g = A_HEADS // A_KV_HEADS
    w = A_WINDOW
    nb = l // w
    scale = A_HEAD_DIM ** -0.5
    q_l = rope_2d(q_l.reshape(b, l, A_HEADS, A_HEAD_DIM), row, col)
    k_l = rope_2d(k_l.reshape(b, l, A_KV_HEADS, A_HEAD_DIM), row, col)
    v_l = v_l.reshape(b, l, A_KV_HEADS, A_HEAD_DIM)
    k_c = k_c.reshape(b, n_ctx, A_KV_HEADS, A_HEAD_DIM)
    v_c = v_c.reshape(b, n_ctx, A_KV_HEADS, A_HEAD_DIM)
    sink_g = sink.astype(jnp.float32).reshape(A_KV_HEADS, g)

    def band(t):
        tb = jnp.pad(t.reshape(b, nb, w, A_KV_HEADS, A_HEAD_DIM), ((0, 0), (1, 1), (0, 0), (0, 0), (0, 0)))
        return jnp.concatenate([tb[:, :-2], tb[:, 1:-1], tb[:, 2:]], axis=2)

    k_band, v_band = band(k_l), band(v_l)
    qb = q_l.reshape(b, nb, w, A_KV_HEADS, g, A_HEAD_DIM)
    rel = jnp.arange(3 * w)[None, :] - w - jnp.arange(w)[:, None]
    kpos = (jnp.arange(nb)[:, None] - 1) * w + jnp.arange(3 * w)[None, :]
    mask = (jnp.abs(rel) <= w)[None] & ((kpos >= 0) & (kpos < l))[:, None, :]
    s_band = jnp.einsum('bnqhgd,bnkhd->bnhgqk', qb, k_band, preferred_element_type=jnp.float32) * scale
    s_band = jnp.where(mask[None, :, None, None], s_band, MASK_VALUE)
    s_ctx = jnp.einsum('bnqhgd,bchd->bnhgqc', qb, k_c, preferred_element_type=jnp.float32) * scale
    p = _sink_softmax(jnp.concatenate([s_band, s_ctx], axis=-1), sink_g[None, None, :, :, None, None])
    p = p.astype(v_l.dtype)
    o = (jnp.einsum('bnhgqk,bnkhd->bnqhgd', p[..., :3 * w], v_band)
         + jnp.einsum('bnhgqc,bchd->bnqhgd', p[..., 3 * w:], v_c))
    o_l = o.reshape(b, l, A_HEADS * A_HEAD_DIM)
    o_c = None
    if with_ctx:
        qc = q_c.reshape(b, n_ctx, A_KV_HEADS, g, A_HEAD_DIM)
        s = jnp.einsum('bqhgd,bkhd->bhgqk', qc, k_c, preferred_element_type=jnp.float32) * scale
        pc = _sink_softmax(s, sink_g[None, :, :, None, None]).astype(v_c.dtype)
        o_c = jnp.einsum('bhgqk,bkhd->bqhgd', pc, v_c).reshape(b, n_ctx, A_HEADS * A_HEAD_DIM)
    return o_l, o_c


def _hgrn_gate(zf, lb):
    zf = zf.astype(jnp.float32)
    lb = lb.astype(jnp.float32)
    f = lb + (1.0 - lb) * jax.nn.sigmoid(zf)
    logf = jnp.log(jnp.maximum(f, GATE_FLOOR))
    k = (1.0 - lb) * jax.nn.sigmoid(-zf)
    return logf, k


def _gla_chunk_scan(q, k, v, logf, s0, with_output):
    b, l, h, _ = q.shape
    dv = v.shape[-1]
    n = l // B_CHUNK

    def chunks(t):
        t = t.astype(jnp.float32).reshape(b, n, B_CHUNK, h, t.shape[-1])
        return jnp.moveaxis(t, 1, 0).swapaxes(2, 3)

    xs = (chunks(q), chunks(k), chunks(v), chunks(logf))
    tri = jnp.tril(jnp.ones((B_CHUNK, B_CHUNK), dtype=bool))[:, :, None]

    def step(state, inp):
        qi, ki, vi, fi = inp
        a = jnp.cumsum(fi, axis=2)
        a_end = a[:, :, -1:, :]
        state_next = (jnp.exp(a_end[:, :, 0, :])[..., None] * state
                      + jnp.einsum('bhcd,bhce->bhde', ki * jnp.exp(a_end - a), vi))
        if not with_output:
            return state_next, None
        o_inter = jnp.einsum('bhtd,bhde->bhte', qi * jnp.exp(a), state)
        rel = a[:, :, :, None, :] - a[:, :, None, :, :]
        decay = jnp.where(tri, jnp.exp(jnp.where(tri, rel, 0.0)), 0.0)
        wts = jnp.einsum('bhtd,bhsd,bhtsd->bhts', qi, ki, decay)
        return state_next, o_inter + jnp.einsum('bhts,bhse->bhte', wts, vi)

    s_fin, o = lax.scan(step, s0.astype(jnp.float32), xs)
    if not with_output:
        return None, s_fin
    o = jnp.moveaxis(o.swapaxes(2, 3), 0, 1).reshape(b, l, h, dv).astype(v.dtype)
    return o, s_fin


def hgrn2_mixer(z_l, z_c, lb, g_norm, with_ctx):
    def prep(z):
        zq, zff, zfb, zi, zg = z
        bt, lt, _ = zq.shape
        hk = lambda t: t.reshape(bt, lt, B_HEADS, B_KEY_DIM)
        logf_f, k_f = _hgrn_gate(zff, lb[0])
        logf_b, k_b = _hgrn_gate(zfb, lb[1])
        return (hk(zq), hk(k_f), hk(logf_f), hk(k_b), hk(logf_b),
                zi.reshape(bt, lt, B_HEADS, B_VAL_DIM), zg.reshape(bt, lt, B_HEADS, B_VAL_DIM))

    def flip(t):
        return jnp.flip(t, axis=1)

    def readout(o, g):
        o = rms_norm(o, g_norm) * jax.nn.silu(g)
        return o.reshape(o.shape[0], o.shape[1], B_HEADS * B_VAL_DIM)

    q_c, kf_c, lf_c, kb_c, lbk_c, v_c, g_c = prep(z_c)
    s0 = jnp.zeros((q_c.shape[0], B_HEADS, B_KEY_DIM, B_VAL_DIM), jnp.float32)
    oc_f, s_f = _gla_chunk_scan(q_c, kf_c, v_c, lf_c, s0, with_ctx)
    oc_b, s_b = _gla_chunk_scan(flip(q_c), flip(kb_c), flip(v_c), flip(lbk_c), s0, with_ctx)
    q_l, kf_l, lf_l, kb_l, lbk_l, v_l, g_l = prep(z_l)
    ol_f, _ = _gla_chunk_scan(q_l, kf_l, v_l, lf_l, s_f, True)
    ol_b, _ = _gla_chunk_scan(flip(q_l), flip(kb_l), flip(v_l), flip(lbk_l), s_b, True)
    o_l = readout(ol_f + flip(ol_b), g_l)
    o_c = readout(oc_f + flip(oc_b), g_c) if with_ctx else None
    return o_l, o_c


def mla_mixer(cq_l, ckv_l, kr_l, cq_c, ckv_c, kr_c, q_norm, kv_norm, w_uq, w_ukv, row, col, with_ctx):
    scale = (C_NOPE + C_ROPE) ** -0.5

    def queries(cq, rotary):
        bt, lt, _ = cq.shape
        q = (rms_norm(cq, q_norm) @ w_uq).reshape(bt, lt, C_HEADS, C_NOPE + C_ROPE)
        q_rope = q[..., C_NOPE:]
        if rotary:
            q_rope = rope_2d(q_rope, row, col)
        return jnp.concatenate([q[..., :C_NOPE], q_rope], axis=-1)

    def keys_values(ckv, kr, rotary):
        bt, lt, _ = ckv.shape
        kv = (rms_norm(ckv, kv_norm) @ w_ukv).reshape(bt, lt, C_HEADS, C_NOPE + C_V)
        k_rope = kr.reshape(bt, lt, 1, C_ROPE)
        if rotary:
            k_rope = rope_2d(k_rope, row, col)
        k = jnp.concatenate([kv[..., :C_NOPE], jnp.broadcast_to(k_rope, (bt, lt, C_HEADS, C_ROPE))], axis=-1)
        return k, kv[..., C_NOPE:]

    k_c, v_c = keys_values(ckv_c, kr_c, False)
    k_l, v_l = keys_values(ckv_l, kr_l, True)
    k_all = jnp.concatenate([k_l, k_c], axis=1)
    v_all = jnp.concatenate([v_l, v_c], axis=1)
    o_l = _map_query_blocks(lambda qb: _softmax_attend(qb, k_all, v_all, scale), queries(cq_l, True))
    o_l = o_l.reshape(o_l.shape[0], o_l.shape[1], C_HEADS * C_V)
    o_c = None
    if with_ctx:
        o_c = _softmax_attend(queries(cq_c, False), k_c, v_c, scale)
        o_c = o_c.reshape(o_c.shape[0], o_c.shape[1], C_HEADS * C_V)
    return o_l, o_c


def diff_mixer(q_l, k_l, v_l, q_c, k_c, v_c, lam_p, subln, layer, row, col, with_ctx):
    lam_init = 0.8 - 0.6 * math.exp(-0.3 * layer)
    lam_p = lam_p.astype(jnp.float32)
    lam = jnp.exp(jnp.sum(lam_p[0] * lam_p[1])) - jnp.exp(jnp.sum(lam_p[2] * lam_p[3])) + lam_init
    scale = D_HEAD_DIM ** -0.5

    def qk(t, rotary):
        bt, lt, _ = t.shape
        t = t.reshape(bt, lt, 2 * D_HEADS, D_HEAD_DIM)
        if rotary:
            t = rope_2d(t, row, col)
        return t.reshape(bt, lt, D_HEADS, 2, D_HEAD_DIM)

    def vals(t):
        return t.reshape(t.shape[0], t.shape[1], D_HEADS, 2 * D_HEAD_DIM)

    def attend(q, k, v):
        s = jnp.einsum('bqhmd,bkhmd->bmhqk', q, k, preferred_element_type=jnp.float32) * scale
        p = jax.nn.softmax(s, axis=-1)
        a = p[:, 0] - lam * p[:, 1]
        return jnp.einsum('bhqk,bkhe->bqhe', a.astype(v.dtype), v)

    def finish(o):
        o = rms_norm(o, subln) * (1.0 - lam_init)
        return o.reshape(o.shape[0], o.shape[1], D_HEADS * 2 * D_HEAD_DIM)

    kc, vc = qk(k_c, False), vals(v_c)
    k_all = jnp.concatenate([qk(k_l, True), kc], axis=1)
    v_all = jnp.concatenate([vals(v_l), vc], axis=1)
    o_l = finish(_map_query_blocks(lambda qb: attend(qb, k_all, v_all), qk(q_l, True)))
    o_c = finish(attend(qk(q_c, False), kc, vc)) if with_ctx else None
    return o_l, o_c


def merge_branches(h, branches, w_gate, w_branch, w_out):
    gates = jax.nn.sigmoid(h @ w_gate)
    y = jnp.zeros_like(h)
    for i, br in enumerate(branches):
        y = y + gates[..., i * D_MODEL:(i + 1) * D_MODEL] * (br @ w_branch[i])
    return y @ w_out


def hier_moe(h, w_rg, b_rg, w_re, b_re, w_gate, w_up, w_down):
    n = h.shape[0]
    p_group = jax.nn.softmax((h @ w_rg).astype(jnp.float32) + b_rg.astype(jnp.float32), axis=-1)
    g_val, g_idx = lax.top_k(p_group, 1)
    e_logits = ((h @ w_re).astype(jnp.float32) + b_re.astype(jnp.float32)).reshape(n, N_GROUPS, EXPERTS_PER_GROUP)
    e_logits = jnp.take_along_axis(e_logits, g_idx[:, :, None], axis=1)[:, 0]
    e_val, e_idx = lax.top_k(jax.nn.softmax(e_logits, axis=-1), EXPERT_TOP_K)
    e_val = e_val / jnp.sum(e_val, axis=-1, keepdims=True)
    expert_id = g_idx * EXPERTS_PER_GROUP + e_idx
    weights = jnp.sum(jax.nn.one_hot(expert_id, N_EXPERTS, dtype=jnp.float32) * (g_val * e_val)[..., None], axis=1)
    weights = weights.astype(h.dtype)
    y = jnp.zeros_like(h)
    for e in range(N_EXPERTS):
        he = jax.nn.silu(h @ w_gate[e]) * (h @ w_up[e])
        y = y + weights[:, e:e + 1] * (he @ w_down[e])
    return y


def setup_inputs(seed: int = 0) -> dict:
    key = jax.random.key(seed)
    ks = iter(jax.random.split(key, 40))
    d = D_MODEL

    def nrm(shape, s):
        return jax.random.normal(next(ks), shape, jnp.float32) * s

    def gain(shape):
        return 1.0 + nrm(shape, 0.02)

    return {
        'x': nrm((BATCH, SEQ, d), 1.0),
        'c': nrm((BATCH, d), 1.0),
        'ctx': nrm((BATCH, CTX_LEN, d), 1.0),
        'c_ctx': nrm((d,), 1.0),
        'w_mod': nrm((DEPTH, d, 6 * d), d ** -0.5),
        'b_mod': nrm((DEPTH, 6 * d), 0.02),
        'norm1': gain((DEPTH, d)),
        'norm2': gain((DEPTH, d)),
        'w_in': nrm((DEPTH, d, D_IN), d ** -0.5),
        'w_gate': nrm((DEPTH, d, N_BRANCH * d), d ** -0.5),
        'w_branch': nrm((DEPTH, N_BRANCH, BRANCH_W, d), BRANCH_W ** -0.5),
        'w_out': nrm((DEPTH, d, d), d ** -0.5),
        'attn_sink': nrm((DEPTH, A_HEADS), 0.5),
        'hgrn_lb_logits': nrm((DEPTH, 2, B_HEADS * B_KEY_DIM), 0.5),
        'hgrn_norm': gain((DEPTH, B_VAL_DIM)),
        'mla_q_norm': gain((DEPTH, C_Q_LORA)),
        'mla_kv_norm': gain((DEPTH, C_KV_LORA)),
        'mla_w_uq': nrm((DEPTH, C_Q_LORA, C_HEADS * (C_NOPE + C_ROPE)), C_Q_LORA ** -0.5),
        'mla_w_ukv': nrm((DEPTH, C_KV_LORA, C_HEADS * (C_NOPE + C_V)), C_KV_LORA ** -0.5),
        'diff_lambda': nrm((DEPTH, 4, D_HEAD_DIM), 0.1),
        'diff_subln': gain((DEPTH, 2 * D_HEAD_DIM)),
        'w_router_group': nrm((DEPTH, d, N_GROUPS), d ** -0.5),
        'b_router_group': nrm((DEPTH, N_GROUPS), 0.01),
        'w_router_expert': nrm((DEPTH, d, N_EXPERTS), d ** -0.5),
        'b_router_expert': nrm((DEPTH, N_EXPERTS), 0.01),
        'w_expert_gate': nrm((DEPTH, N_EXPERTS, d, EXPERT_HIDDEN), d ** -0.5),
        'w_expert_up': nrm((DEPTH, N_EXPERTS, d, EXPERT_HIDDEN), d ** -0.5),
        'w_expert_down': nrm((DEPTH, N_EXPERTS, EXPERT_HIDDEN, d), EXPERT_HIDDEN ** -0.5),
        'final_norm': gain((d,)),
    }


def reference(x, c, ctx, c_ctx, w_mod, b_mod, norm1, norm2, w_in, w_gate, w_branch, w_out,
              attn_sink, hgrn_lb_logits, hgrn_norm, mla_q_norm, mla_kv_norm, mla_w_uq, mla_w_ukv,
              diff_lambda, diff_subln, w_router_group, b_router_group, w_router_expert,
              b_router_expert, w_expert_gate, w_expert_up, w_expert_down, final_norm):
    b, l, d = x.shape
    rows = l // GRID_W
    row = jnp.repeat(jnp.arange(rows, dtype=jnp.int32), GRID_W)
    col = jnp.arange(rows * GRID_W, dtype=jnp.int32) % GRID_W
    sm = jax.nn.softmax(hgrn_lb_logits.astype(jnp.float32), axis=0)
    lower_bounds = jnp.cumsum(sm, axis=0) - sm[0]
    split_at = [int(s) for s in np.cumsum(IN_SPLITS)[:-1]]
    silu_c = jax.nn.silu(c)
    silu_cc = jax.nn.silu(c_ctx)
    for li in range(DEPTH):
        with_ctx = li < DEPTH - 1
        m_l = (silu_c @ w_mod[li] + b_mod[li]).reshape(b, 6, 1, d)
        m_c = (silu_cc @ w_mod[li] + b_mod[li]).reshape(6, d)
        h_l = rms_norm(x, norm1[li]) * (1 + m_l[:, 1]) + m_l[:, 0]
        h_c = rms_norm(ctx, norm1[li]) * (1 + m_c[1]) + m_c[0]
        z_l = jnp.split(h_l @ w_in[li], split_at, axis=-1)
        z_c = jnp.split(h_c @ w_in[li], split_at, axis=-1)
        a_l, a_c = window_gqa_mixer(*z_l[0:3], *z_c[0:3], attn_sink[li], row, col, with_ctx)
        b_l, b_c = hgrn2_mixer(z_l[3:8], z_c[3:8], lower_bounds[li], hgrn_norm[li], with_ctx)
        c_l, c_c = mla_mixer(*z_l[8:11], *z_c[8:11], mla_q_norm[li], mla_kv_norm[li],
                             mla_w_uq[li], mla_w_ukv[li], row, col, with_ctx)
        d_l, d_c = diff_mixer(*z_l[11:14], *z_c[11:14], diff_lambda[li], diff_subln[li], li, row, col, with_ctx)
        x = x + m_l[:, 2] * merge_branches(h_l, (a_l, b_l, c_l, d_l), w_gate[li], w_branch[li], w_out[li])
        moe_w = (w_router_group[li], b_router_group[li], w_router_expert[li], b_router_expert[li],
                 w_expert_gate[li], w_expert_up[li], w_expert_down[li])
        h2_l = rms_norm(x, norm2[li]) * (1 + m_l[:, 4]) + m_l[:, 3]
        if with_ctx:
            ctx = ctx + m_c[2] * merge_branches(h_c, (a_c, b_c, c_c, d_c), w_gate[li], w_branch[li], w_out[li])
            h2_c = rms_norm(ctx, norm2[li]) * (1 + m_c[4]) + m_c[3]
            f = hier_moe(jnp.concatenate([h2_l.reshape(-1, d), h2_c.reshape(-1, d)], axis=0), *moe_w)
            x = x + m_l[:, 5] * f[:b * l].reshape(b, l, d)
            ctx = ctx + m_c[5] * f[b * l:].reshape(ctx.shape)
        else:
            x = x + m_l[:, 5] * hier_moe(h2_l.reshape(-1, d), *moe_w).reshape(b, l, d)
    return rms_norm(x, final_norm)
```

```cpp
#include <hip/hip_runtime.h>
#include <stdint.h>
#include <stdio.h>

#ifndef N_LAUNCH_MODE
#define N_LAUNCH_MODE 1
#endif

#define LAS __attribute__((address_space(3)))
typedef LAS unsigned char* ldsp;
typedef unsigned short bf16_t;
typedef short bf16x8 __attribute__((ext_vector_type(8)));
typedef short s16x4 __attribute__((ext_vector_type(4)));
typedef float f32x2 __attribute__((ext_vector_type(2)));
typedef float f32x4 __attribute__((ext_vector_type(4)));
typedef float f32x16 __attribute__((ext_vector_type(16)));
typedef unsigned u32x2 __attribute__((ext_vector_type(2)));
typedef unsigned u32x4 __attribute__((ext_vector_type(4)));
typedef __bf16 bf16x2_t __attribute__((ext_vector_type(2)));
#define DI __device__ __forceinline__

constexpr int D = 1024, NBAT = 8, SEQ = 4096, CTXL = 256;
constexpr int ML = NBAT * SEQ, MC = NBAT * CTXL, MT = ML + MC;
constexpr int NZ = 3072, KEYS = SEQ + CTXL;
constexpr int ZA_Q = 0, ZA_K = 256, ZA_V = 384, ZB_Q = 512, ZB_FF = 768, ZB_FB = 1024, ZB_I = 1280, ZB_G = 1536,
              ZC_Q = 1792, ZC_KV = 2048, ZC_KR = 2176, ZD_Q = 2208, ZD_K = 2464, ZD_V = 2720;
constexpr int ZY = 768;
constexpr int NCHUNK = MT / 64;
constexpr int MOE_MAXROWS = 77824;
constexpr float NORM_EPS = 1e-6f;
constexpr int LDS_BYTES = 155648;
constexpr int HALF_ROWS = MT / 2;

constexpr size_t WS_CTL = 0;
constexpr size_t CTL_CNT = 16384;
constexpr size_t WS_MODV = 65536;
constexpr size_t WS_ROPE16 = 524288;
constexpr size_t WS_ROPE8 = WS_ROPE16 + 8192;
constexpr size_t WS_LAM = WS_ROPE8 + 4096;
constexpr size_t WS_TOKI = 1048576;
constexpr size_t WS_ROWI = WS_TOKI + (size_t)MT * 32;
constexpr size_t WS_ROWW = WS_ROWI + (size_t)MOE_MAXROWS * 4;
constexpr size_t WS_HE = WS_ROWW + (size_t)MOE_MAXROWS * 4;
constexpr size_t WS_WT = 4u << 20;
constexpr size_t WT_IN = 0, WT_G = WT_IN + (size_t)NZ * 1024 * 2, WT_B = WT_G + (size_t)4096 * 1024 * 2, WT_O = WT_B + (size_t)4 * 1024 * 256 * 2,
                 WT_MLA = WT_O + (size_t)1024 * 1024 * 2, WT_E1 = WT_MLA + (size_t)1024 * 384 * 2, WT_E2 = WT_E1 + (size_t)32 * 512 * 1024 * 2,
                 WT_END = WT_E2 + (size_t)32 * 1024 * 256 * 2;
constexpr size_t WS_CTXS = WS_WT + WT_END;
constexpr size_t WS_HB = WS_CTXS + (size_t)MC * 1024 * 4;
constexpr size_t WS_Z = WS_HB + (size_t)MT * 1024 * 2;
constexpr size_t WS_X = WS_Z + (size_t)MT * NZ * 2;
constexpr size_t X_QC = 0, X_KC = X_QC + (size_t)MT * 384 * 2, X_CVT = X_KC + (size_t)NBAT * 4 * KEYS * 96 * 2, X_AVT = X_CVT + (size_t)NBAT * 4 * 64 * KEYS * 2,
                 X_DVT = X_AVT + (size_t)NBAT * 2 * 64 * KEYS * 2, X_U = X_DVT + (size_t)NBAT * 4 * 64 * KEYS * 2, X_END_MIX = X_U + (size_t)NCHUNK * 4 * 2 * 4096 * 2;
constexpr size_t X_SIZE = (size_t)HALF_ROWS * 4096 * 2;
static_assert(X_END_MIX <= X_SIZE, "mixer extras must fit the gate region");
constexpr size_t WS_END = WS_X + X_SIZE;
constexpr size_t WS_XG = WS_Z;
constexpr size_t WS_HMID = WS_XG + (size_t)MOE_MAXROWS * 1024 * 2;
constexpr size_t WS_Y = WS_HMID + (size_t)MOE_MAXROWS * 256 * 2;
static_assert(WS_Y + (size_t)2 * MT * 1024 * 2 <= WS_END, "MoE buffers must fit");

struct Params { const float* in[29]; float* out; unsigned char* ws; };

DI unsigned pk2(float a, float b) { f32x2 v = {a, b}; bf16x2_t r = __builtin_convertvector(v, bf16x2_t); return __builtin_bit_cast(unsigned, r); }
DI float bflo(unsigned u) { return __uint_as_float(u << 16); }
DI float bfhi(unsigned u) { return __uint_as_float(u & 0xffff0000u); }
DI float bf2f(bf16_t v) { return __uint_as_float((unsigned)v << 16); }
DI bf16_t f2bf(float f) { return (bf16_t)(pk2(f, 0.f) & 0xffffu); }
DI float sigmoidf_(float v) { return __builtin_amdgcn_rcpf(1.f + __expf(-v)); }
DI float wave_sum(float v) { for (int o = 32; o >= 1; o >>= 1) v += __shfl_xor(v, o); return v; }
DI void row_bk(int row, int& b, int& key) { if (row < ML) { b = row >> 12; key = row & 4095; } else { const int r = row - ML; b = r >> 8; key = SEQ + (r & 255); } }
DI int key_row(int b, int key) { return key < SEQ ? b * SEQ + key : ML + b * CTXL + (key - SEQ); }
DI int chunk_row0(int cidx) { return cidx < 512 ? cidx * 64 : ML + (cidx - 512) * 64; }

#define XB_TMO      128
#define XB_XCNT(j)  (256  + 64 * (j))
#define XB_XSUB(j)  (1280 + 64 * (j))
#define XB_XGEN(j)  (2304 + 64 * (j))
#define XB_TOP      3328
#define XB_TOPGEN   3392
#define XCD_BAR_WORDS 3456
#define XB_SPIN_CAP (1u << 22)
DI unsigned xb_ld(unsigned* p)              { return __hip_atomic_load(p, __ATOMIC_RELAXED, __HIP_MEMORY_SCOPE_AGENT); }
DI unsigned xb_add(unsigned* p, unsigned v) { return __hip_atomic_fetch_add(p, v, __ATOMIC_RELAXED, __HIP_MEMORY_SCOPE_AGENT); }
DI unsigned xb_xcc_id() { return (unsigned)__builtin_amdgcn_s_getreg((3 << 11) | 20) & 0xFu; }
#define XB_SPIN(cond, bar) do { unsigned _sp = 0; while (cond) { __builtin_amdgcn_s_sleep(1); \
    if ((++_sp & 255u) == 0u) { if (xb_ld(&(bar)[XB_TMO])) break; if (_sp > XB_SPIN_CAP) { atomicAdd(&(bar)[XB_TMO], 1u); break; } } } } while (0)
struct XcdBarrier { unsigned* bar; unsigned x; volatile LAS unsigned* st; };
DI XcdBarrier xcd_barrier_post(unsigned* bar, volatile LAS unsigned* st) {
    XcdBarrier b; b.bar = bar; b.x = xb_xcc_id(); b.st = st;
    if (threadIdx.x == 0) (void)xb_add(&bar[XB_XCNT(b.x)], 1u);
    return b;
}
DI void xcd_barrier_complete(unsigned* bar, unsigned x, unsigned& nloc, unsigned& nx) {
    const unsigned G = gridDim.x * gridDim.y * gridDim.z;
    unsigned sum, cnt, mine, sp = 0u;
    for (;;) {
        sum = 0u; cnt = 0u; mine = 0u;
#pragma unroll
        for (unsigned j = 0; j < 16; ++j) { const unsigned c = xb_ld(&bar[XB_XCNT(j)]); sum += c; cnt += (c > 0u) ? 1u : 0u; mine = (j == x) ? c : mine; }
        if (sum == G) break;
        __builtin_amdgcn_s_sleep(1);
        if ((++sp & 255u) == 0u) { if (xb_ld(&bar[XB_TMO])) break; if (sp > XB_SPIN_CAP) { atomicAdd(&bar[XB_TMO], 1u); break; } }
    }
    nloc = mine > 0u ? mine : 1u; nx = cnt > 0u ? cnt : 1u;
}
DI void xcd_barrier(const XcdBarrier& b) {
    asm volatile("s_waitcnt vmcnt(0)" ::: "memory");
    __syncthreads();
    if (threadIdx.x == 0) {
        unsigned* bar = b.bar;
        __builtin_amdgcn_s_waitcnt(0);
        unsigned nloc = b.st[0], nx = b.st[1];
        if (nloc == 0u) { xcd_barrier_complete(bar, b.x, nloc, nx); b.st[0] = nloc; b.st[1] = nx; }
        const unsigned old = xb_add(&bar[XB_XSUB(b.x)], 1u);
        const unsigned gen = old / nloc;
        if (old + 1u == (gen + 1u) * nloc) {
            __builtin_amdgcn_fence(__ATOMIC_RELEASE, "agent");
            asm volatile("s_waitcnt vmcnt(0)" ::: "memory");
            const unsigned og = xb_add(&bar[XB_TOP], 1u);
            const unsigned tg = og / nx;
            if (og + 1u == (tg + 1u) * nx) xb_add(&bar[XB_TOPGEN], 1u);
            else XB_SPIN(xb_ld(&bar[XB_TOPGEN]) == tg, bar);
            __builtin_amdgcn_fence(__ATOMIC_ACQUIRE, "agent");
            xb_add(&bar[XB_XGEN(b.x)], 1u);
            asm volatile("s_waitcnt vmcnt(0)" ::: "memory");
        } else {
            XB_SPIN(xb_ld(&bar[XB_XGEN(b.x)]) == gen, bar);
            __builtin_amdgcn_fence(__ATOMIC_ACQUIRE, "agent");
            asm volatile("s_waitcnt vmcnt(0)" ::: "memory");
        }
    }
    __syncthreads();
}

namespace pg8 {
constexpr int BM = 256, BK = 64, HALF = 128, HTB = HALF * BK * 2, STAGE_BYTES = 8 * HTB, NXCD = 8, WGM = 8;
DI int lds_byte(int r, int c) { const int st = (r >> 4) * 2 + (c >> 5), rr = r & 15, cc = c & 31, ob = rr * 64 + cc * 2; return st * 1024 + (ob ^ (((ob >> 9) & 1) << 5)); }
DI void stage_rc(int b, int& R, int& C) { const int st = b / 1024, sb = b % 1024, swz = sb ^ (((sb >> 9) & 1) << 5); R = (st >> 1) * 16 + swz / 64; C = (st & 1) * 32 + (swz % 64) / 2; }
DI int perm32(int rho) { const int n = rho >> 4, i = rho & 15; return 8 * (i >> 2) + 4 * n + (i & 3); }
struct Unit { int pm, pn, aux; };
DI void tile_of(int L, int nM, int nN, int& pm, int& pn) {
    const int nwg = nM * nN; int wgid = L;
    { const int q = nwg / NXCD, r = nwg % NXCD, xcd = wgid % NXCD, off = wgid / NXCD; wgid = (xcd < r ? xcd * (q + 1) : r * (q + 1) + (xcd - r) * q) + off; }
    const int nig = WGM * nN, gid = wgid / nig, fm = gid * WGM, gsz = (nM - fm) < WGM ? (nM - fm) : WGM;
    pm = fm + ((wgid % nig) % gsz); pn = (wgid % nig) / gsz;
}

template <class Epi, class Sched>
DI void gemm_phase(ldsp lds, const int lda, const int ldb, const int K, const Sched& S, const Epi& E) {
    const int tid = threadIdx.x, wid = __builtin_amdgcn_readfirstlane(tid >> 6), lane = tid & 63, wr = wid >> 2, wc = wid & 3, fr = lane & 15, fq = lane >> 4;
    const int nt = K / BK;
    unsigned voffA[2], voffB[2];
#pragma unroll
    for (int i = 0; i < 2; ++i) { int R, C; stage_rc(tid * 16 + i * 8192, R, C); const int Rb = Epi::PERM ? ((R & ~31) + perm32(R & 31)) : R;
        voffA[i] = (unsigned)(R * lda + C) * 2u; voffB[i] = (unsigned)(Rb * ldb + C) * 2u; }
    const size_t kstep = (size_t)(BK * 2);
    const size_t hstepA = (size_t)HALF * lda * 2, hstepB = (size_t)HALF * ldb * 2;
    const unsigned ldsw = (unsigned)wid * 1024u;
    const int aoff = lds_byte(wr * 64 + fr, fq * 8), boff = lds_byte(wc * 32 + fr, fq * 8);
#define PG8_SA(b, h) (((b) * 2 + (h)) * HTB)
#define PG8_SB(b, h) ((4 + (b) * 2 + (h)) * HTB)
#define PG8_STAGE(bufoff, gbase, voff) do { _Pragma("unroll") for (int _i = 0; _i < 2; ++_i) \
        __builtin_amdgcn_global_load_lds((const unsigned*)((const char*)(gbase) + (voff)[_i]), (LAS unsigned*)(lds + (bufoff) + ldsw + _i * 8192), 16, 0, 0); } while (0)
#define PG8_LDA(dst, b, h) do { _Pragma("unroll") for (int m = 0; m < 4; ++m) _Pragma("unroll") for (int k = 0; k < 2; ++k) dst[m][k] = *(const LAS bf16x8*)(lds + PG8_SA(b, h) + aoff + m * 2048 + k * 1024); } while (0)
#define PG8_LDB(dst, b, h) do { _Pragma("unroll") for (int n = 0; n < 2; ++n) _Pragma("unroll") for (int k = 0; k < 2; ++k) dst[n][k] = *(const LAS bf16x8*)(lds + PG8_SB(b, h) + boff + n * 2048 + k * 1024); } while (0)
#define PG8_MMA(ai, bj, At, Bt) do { __builtin_amdgcn_s_setprio(1); _Pragma("unroll") for (int m = 0; m < 4; ++m) _Pragma("unroll") for (int n = 0; n < 2; ++n) _Pragma("unroll") for (int k = 0; k < 2; ++k) \
        acc[ai][bj][m][n] = __builtin_amdgcn_mfma_f32_16x16x32_bf16(Bt[n][k], At[m][k], acc[ai][bj][m][n], 0, 0, 0); __builtin_amdgcn_s_setprio(0); } while (0)
#define PG8_WAIT_V(n) asm volatile("s_waitcnt vmcnt(" #n ")" ::: "memory")
#define PG8_WAIT_L(n) asm volatile("s_waitcnt lgkmcnt(" #n ")" ::: "memory")
#define PG8_BAR __builtin_amdgcn_s_barrier()
#define PG8_SCHED __builtin_amdgcn_sched_barrier(0)
    Unit cur, nxt; int ui = 0;
    if (!S.next(0, cur)) return;
    f32x4 acc[2][2][4][2];
#pragma unroll
    for (int a = 0; a < 2; ++a)
#pragma unroll
        for (int b = 0; b < 2; ++b)
#pragma unroll
            for (int m = 0; m < 4; ++m)
#pragma unroll
                for (int n = 0; n < 2; ++n) acc[a][b][m][n] = (f32x4){0.f, 0.f, 0.f, 0.f};
    bf16x8 At[4][2], B0[2][2], B1[2][2];
    const char* cA = S.abase(cur); const char* cB = S.bbase(cur);
    PG8_STAGE(PG8_SB(0, 0), cB, voffB); PG8_STAGE(PG8_SA(0, 0), cA, voffA); PG8_STAGE(PG8_SB(0, 1), cB + hstepB, voffB); PG8_STAGE(PG8_SA(0, 1), cA + hstepA, voffA);
    if (wr == 1) PG8_BAR;
    PG8_WAIT_V(4); PG8_BAR;
    PG8_STAGE(PG8_SB(1, 0), cB + kstep, voffB); PG8_STAGE(PG8_SA(1, 0), cA + kstep, voffA); PG8_STAGE(PG8_SB(1, 1), cB + hstepB + kstep, voffB);
    PG8_WAIT_V(6); PG8_BAR;
    for (;;) {
        const bool has_next = S.next(ui + 1, nxt);
        const char* nA = has_next ? S.abase(nxt) : cA; const char* nB = has_next ? S.bbase(nxt) : cB;
        for (int t = 0; t < nt; t += 2) {
            const bool last = (t == nt - 2);
            const char* a1 = cA + (size_t)(t + 1) * kstep;
            const char* a2 = last ? nA : cA + (size_t)(t + 2) * kstep; const char* b2 = last ? nB : cB + (size_t)(t + 2) * kstep;
            const char* a3 = a2 + kstep; const char* b3 = b2 + kstep;
            PG8_LDB(B0, 0, 0); PG8_SCHED; PG8_LDA(At, 0, 0); PG8_STAGE(PG8_SA(1, 1), a1 + hstepA, voffA);
            PG8_WAIT_L(8); PG8_BAR; PG8_WAIT_L(0); PG8_MMA(0, 0, At, B0); PG8_BAR; PG8_SCHED;
            PG8_LDB(B1, 0, 1); PG8_STAGE(PG8_SB(0, 0), b2, voffB);
            PG8_BAR; PG8_WAIT_L(0); PG8_MMA(0, 1, At, B1); PG8_BAR;
            PG8_LDA(At, 0, 1); PG8_STAGE(PG8_SA(0, 0), a2, voffA);
            PG8_BAR; PG8_WAIT_L(0); PG8_MMA(1, 0, At, B0); PG8_BAR; PG8_SCHED;
            PG8_STAGE(PG8_SB(0, 1), b2 + hstepB, voffB);
            PG8_WAIT_V(6); PG8_BAR; PG8_MMA(1, 1, At, B1); PG8_BAR;
            PG8_LDB(B0, 1, 0); PG8_SCHED; PG8_LDA(At, 1, 0); PG8_STAGE(PG8_SA(0, 1), a2 + hstepA, voffA);
            PG8_WAIT_L(8); PG8_BAR; PG8_WAIT_L(0); PG8_MMA(0, 0, At, B0); PG8_BAR; PG8_SCHED;
            PG8_LDB(B1, 1, 1); PG8_STAGE(PG8_SB(1, 0), b3, voffB);
            PG8_BAR; PG8_WAIT_L(0); PG8_MMA(0, 1, At, B1); PG8_BAR;
            PG8_LDA(At, 1, 1); PG8_STAGE(PG8_SA(1, 0), a3, voffA);
            PG8_BAR; PG8_WAIT_L(0); PG8_MMA(1, 0, At, B0); PG8_BAR; PG8_SCHED;
            PG8_STAGE(PG8_SB(1, 1), b3 + hstepB, voffB);
            PG8_WAIT_V(6); PG8_BAR; PG8_MMA(1, 1, At, B1); PG8_BAR;
        }
        E(acc, cur, wr, wc, fr, fq);
        if (!has_next) break;
#pragma unroll
        for (int a = 0; a < 2; ++a)
#pragma unroll
            for (int b = 0; b < 2; ++b)
#pragma unroll
                for (int m = 0; m < 4; ++m)
#pragma unroll
                    for (int n = 0; n < 2; ++n) acc[a][b][m][n] = (f32x4){0.f, 0.f, 0.f, 0.f};
        cur = nxt; cA = nA; cB = nB; ++ui;
    }
    PG8_WAIT_V(0);
    if (wr == 0) PG8_BAR;
    PG8_BAR;
#undef PG8_SA
#undef PG8_SB
#undef PG8_STAGE
#undef PG8_LDA
#undef PG8_LDB
#undef PG8_MMA
#undef PG8_WAIT_V
#undef PG8_WAIT_L
#undef PG8_BAR
#undef PG8_SCHED
}

struct SchedPlain {
    const char* A; const char* B; int lda, ldb, nM, nN, G, c, pm0;
    DI bool next(int i, Unit& u) const { const long L = (long)i * G + c; if (L >= (long)nM * nN) return false; tile_of((int)L, nM, nN, u.pm, u.pn); u.pm += pm0; u.aux = 0; return true; }
    DI const char* abase(const Unit& u) const { return A + (size_t)u.pm * 256 * lda * 2; }
    DI const char* bbase(const Unit& u) const { return B + (size_t)u.pn * 256 * ldb * 2; }
};
struct SchedMerge {
    const char* Z; const char* Wb; int nM, G, c, pm0;
    DI bool next(int i, Unit& u) const { const long L = (long)(i >> 2) * G + c; if (L >= (long)nM * 4) return false; tile_of((int)L, nM, 4, u.pm, u.pn); u.pm += pm0; u.aux = i & 3; return true; }
    DI const char* abase(const Unit& u) const { const int co = u.aux == 0 ? ZA_Q : (u.aux == 1 ? ZB_Q : (u.aux == 2 ? ZC_Q : ZD_Q)); return Z + ((size_t)u.pm * 256 * NZ + co) * 2; }
    DI const char* bbase(const Unit& u) const { return Wb + ((size_t)u.aux * 1024 * 256 + (size_t)u.pn * 256 * 256) * 2; }
};
struct SchedMoe {
    const char* A; const char* B; int lda, ldb, nP, nN, G, c; size_t estride; const LAS unsigned char* pe;
    DI bool next(int i, Unit& u) const { const long L = (long)i * G + c; if (L >= (long)nP * nN) return false; u.pm = (int)(L / nN); u.pn = (int)(L % nN); u.aux = pe[u.pm]; return true; }
    DI const char* abase(const Unit& u) const { return A + (size_t)u.pm * 256 * lda * 2; }
    DI const char* bbase(const Unit& u) const { return B + (size_t)u.aux * estride + (size_t)u.pn * 256 * ldb * 2; }
};

#define EPI_ARGS const f32x4 (&acc)[2][2][4][2], const Unit& u, int wr, int wc, int fr, int fq
struct EpiZ { static constexpr bool PERM = true; bf16_t* Z;
    DI void operator()(EPI_ARGS) const {
        const int row0 = u.pm * 256 + wr * 64 + fr, col0 = u.pn * 256 + wc * 32 + 8 * fq;
#pragma unroll
        for (int ai = 0; ai < 2; ++ai)
#pragma unroll
            for (int m = 0; m < 4; ++m) { bf16_t* rp = Z + (size_t)(row0 + ai * 128 + m * 16) * NZ + col0;
#pragma unroll
                for (int bj = 0; bj < 2; ++bj) { const f32x4 v0 = acc[ai][bj][m][0], v1 = acc[ai][bj][m][1];
                    u32x4 w; w.x = pk2(v0[0], v0[1]); w.y = pk2(v0[2], v0[3]); w.z = pk2(v1[0], v1[1]); w.w = pk2(v1[2], v1[3]);
                    *(u32x4*)(rp + bj * 128) = w; } }
    } };
struct EpiMla { static constexpr bool PERM = true; bf16_t* QC; bf16_t* KC; bf16_t* CVt;
    DI void operator()(const f32x4 (&acc)[2][2][4][2], const Unit& u, int wr, int wc, int fr_in, int fq_in) const {
        int fr = fr_in, fq = fq_in; asm volatile("" : "+v"(fr), "+v"(fq));
#pragma unroll
        for (int ai = 0; ai < 2; ++ai)
#pragma unroll
            for (int m = 0; m < 4; ++m) {
                const int row = u.pm * 256 + wr * 64 + fr + ai * 128 + m * 16; int b, key; row_bk(row, b, key);
#pragma unroll
                for (int bj = 0; bj < 2; ++bj) {
                    const int c = u.pn * 256 + bj * 128 + wc * 32 + 8 * fq;
                    const f32x4 v0 = acc[ai][bj][m][0], v1 = acc[ai][bj][m][1];
                    float v[8] = {v0[0], v0[1], v0[2], v0[3], v1[0], v1[1], v1[2], v1[3]};
                    if (c < 384) {
                        u32x4 w; w.x = pk2(v[0], v[1]); w.y = pk2(v[2], v[3]); w.z = pk2(v[4], v[5]); w.w = pk2(v[6], v[7]);
                        *(u32x4*)(QC + (size_t)row * 384 + c) = w;
                    } else if (c < 896) {
                        const int c2 = c - 384, hh = c2 >> 7, j = c2 & 127;
                        if (j < 64) { u32x4 w; w.x = pk2(v[0], v[1]); w.y = pk2(v[2], v[3]); w.z = pk2(v[4], v[5]); w.w = pk2(v[6], v[7]);
                            *(u32x4*)(KC + ((size_t)(b * 4 + hh) * KEYS + key) * 96 + j) = w; }
                        else { bf16_t* vp = CVt + ((size_t)(b * 4 + hh) * 64 + (j - 64)) * KEYS + key;
#pragma unroll
                            for (int i = 0; i < 8; ++i) { *vp = f2bf(v[i]); vp += KEYS; asm volatile("" : "+v"(vp)); } }
                    }
                }
                __builtin_amdgcn_sched_barrier(0);
            }
    } };
struct EpiGate { static constexpr bool PERM = true; bf16_t* G; int row_base;
    DI void operator()(EPI_ARGS) const {
        const int row0 = u.pm * 256 + wr * 64 + fr - row_base, col0 = u.pn * 256 + wc * 32 + 8 * fq;
#pragma unroll
        for (int ai = 0; ai < 2; ++ai)
#pragma unroll
            for (int m = 0; m < 4; ++m) { bf16_t* rp = G + (size_t)(row0 + ai * 128 + m * 16) * 4096 + col0;
#pragma unroll
                for (int bj = 0; bj < 2; ++bj) { const f32x4 v0 = acc[ai][bj][m][0], v1 = acc[ai][bj][m][1];
                    u32x4 w; w.x = pk2(sigmoidf_(v0[0]), sigmoidf_(v0[1])); w.y = pk2(sigmoidf_(v0[2]), sigmoidf_(v0[3]));
                    w.z = pk2(sigmoidf_(v1[0]), sigmoidf_(v1[1])); w.w = pk2(sigmoidf_(v1[2]), sigmoidf_(v1[3]));
                    *(u32x4*)(rp + bj * 128) = w; } }
    } };
struct EpiMerge { static constexpr bool PERM = true; bf16_t* Z; const bf16_t* G; int row_base;
    DI void operator()(EPI_ARGS) const {
        const int row0 = u.pm * 256 + wr * 64 + fr, col0 = u.pn * 256 + wc * 32 + 8 * fq;
#pragma unroll
        for (int ai = 0; ai < 2; ++ai)
#pragma unroll
            for (int m = 0; m < 4; ++m) { const int row = row0 + ai * 128 + m * 16;
                bf16_t* yp = Z + (size_t)row * NZ + ZY + col0; const bf16_t* gp = G + (size_t)(row - row_base) * 4096 + u.aux * 1024 + col0;
#pragma unroll
                for (int bj = 0; bj < 2; ++bj) { const f32x4 v0 = acc[ai][bj][m][0], v1 = acc[ai][bj][m][1];
                    const u32x4 g = *(const u32x4*)(gp + bj * 128);
                    u32x4 y = (u32x4){0u, 0u, 0u, 0u}; if (u.aux != 0) y = *(const u32x4*)(yp + bj * 128);
                    u32x4 w;
                    w.x = pk2(bflo(y.x) + bflo(g.x) * v0[0], bfhi(y.x) + bfhi(g.x) * v0[1]); w.y = pk2(bflo(y.y) + bflo(g.y) * v0[2], bfhi(y.y) + bfhi(g.y) * v0[3]);
                    w.z = pk2(bflo(y.z) + bflo(g.z) * v1[0], bfhi(y.z) + bfhi(g.z) * v1[1]); w.w = pk2(bflo(y.w) + bflo(g.w) * v1[2], bfhi(y.w) + bfhi(g.w) * v1[3]);
                    *(u32x4*)(yp + bj * 128) = w; } }
    } };
struct EpiOut { static constexpr bool PERM = false; const float* res_l; const float* res_c; float* xs_l; float* xs_c; const float* modv_l;
    DI void operator()(EPI_ARGS) const {
        const int row0 = u.pm * 256 + wr * 64 + fr, col0 = u.pn * 256 + wc * 32 + 4 * fq;
#pragma unroll
        for (int ai = 0; ai < 2; ++ai)
#pragma unroll
            for (int m = 0; m < 4; ++m) { const int row = row0 + ai * 128 + m * 16; const bool lat = row < ML; const int bsel = lat ? (row >> 12) : 8;
                const size_t ro = lat ? (size_t)row * 1024 : (size_t)(row - ML) * 1024;
                const float* rp = (lat ? res_l : res_c) + ro + col0; float* xp = (lat ? xs_l : xs_c) + ro + col0; const float* gp = modv_l + (bsel * 6 + 2) * 1024 + col0;
#pragma unroll
                for (int bj = 0; bj < 2; ++bj)
#pragma unroll
                    for (int n = 0; n < 2; ++n) { const int o = bj * 128 + n * 16; const f32x4 r = *(const f32x4*)(rp + o), g = *(const f32x4*)(gp + o);
                        *(f32x4*)(xp + o) = r + g * acc[ai][bj][m][n]; } }
    } };
struct EpiMoeUp { static constexpr bool PERM = true; bf16_t* H;
    DI void operator()(EPI_ARGS) const {
        const int row0 = u.pm * 256 + wr * 64 + fr, h0 = (u.pn * 256 + wc * 32 + 8 * fq) >> 1;
#pragma unroll
        for (int ai = 0; ai < 2; ++ai)
#pragma unroll
            for (int m = 0; m < 4; ++m) { bf16_t* hp = H + (size_t)(row0 + ai * 128 + m * 16) * 256 + h0;
#pragma unroll
                for (int bj = 0; bj < 2; ++bj) { const f32x4 g = acc[ai][bj][m][0], up = acc[ai][bj][m][1];
                    u32x2 w; w.x = pk2(g[0] * sigmoidf_(g[0]) * up[0], g[1] * sigmoidf_(g[1]) * up[1]); w.y = pk2(g[2] * sigmoidf_(g[2]) * up[2], g[3] * sigmoidf_(g[3]) * up[3]);
                    *(u32x2*)(hp + bj * 64) = w; } }
    } };
struct EpiMoeDown { static constexpr bool PERM = true; bf16_t* Y; const int* rowi; const float* roww;
    DI void operator()(EPI_ARGS) const {
        const int row0 = u.pm * 256 + wr * 64 + fr, col0 = u.pn * 256 + wc * 32 + 8 * fq;
#pragma unroll
        for (int ai = 0; ai < 2; ++ai)
#pragma unroll
            for (int m = 0; m < 4; ++m) { const int row = row0 + ai * 128 + m * 16; const int ri = rowi[row];
                if (ri >= 0) { const float w8 = roww[row]; bf16_t* yp = Y + ((size_t)(ri & 1) * MT + (ri >> 1)) * 1024 + col0;
#pragma unroll
                    for (int bj = 0; bj < 2; ++bj) { const f32x4 v0 = acc[ai][bj][m][0] * w8, v1 = acc[ai][bj][m][1] * w8;
                        u32x4 w; w.x = pk2(v0[0], v0[1]); w.y = pk2(v0[2], v0[3]); w.z = pk2(v1[0], v1[1]); w.w = pk2(v1[2], v1[3]);
                        *(u32x4*)(yp + bj * 128) = w; } } }
    } };
}

DI void phase_pre(const Params& p, ldsp lds) {
    float* modv = (float*)(p.ws + WS_MODV);
    LAS float* sc = (LAS float*)lds;
    LAS float* red = (LAS float*)(lds + 9 * 1024 * 4);
    const int tid = threadIdx.x;
    for (int i = tid; i < 9 * 1024; i += 512) { const int r = i >> 10, k = i & 1023; const float v = r < 8 ? p.in[1][r * 1024 + k] : p.in[3][k]; sc[i] = v / (1.f + __expf(-v)); }
    __syncthreads();
    const int kg = tid >> 6, col = tid & 63;
    for (int u = blockIdx.x; u < 192; u += gridDim.x) {
        const int li = u / 96, j = (u % 96) * 64 + col;
        const float* w = p.in[4] + (size_t)li * 1024 * 6144 + j;
        float acc[9];
#pragma unroll
        for (int r = 0; r < 9; ++r) acc[r] = 0.f;
        for (int k = kg * 128; k < kg * 128 + 128; ++k) { const float wv = w[(size_t)k * 6144];
#pragma unroll
            for (int r = 0; r < 9; ++r) acc[r] += sc[r * 1024 + k] * wv; }
#pragma unroll
        for (int r = 0; r < 9; ++r) red[(kg * 9 + r) * 64 + col] = acc[r];
        __syncthreads();
        if (tid < 64) {
#pragma unroll
            for (int r = 0; r < 9; ++r) { float s = 0.f;
#pragma unroll
                for (int g = 0; g < 8; ++g) s += red[(g * 9 + r) * 64 + col];
                modv[(li * 9 + r) * 6144 + j] = s + p.in[5][li * 6144 + j]; } }
        __syncthreads();
    }
    if (blockIdx.x == gridDim.x - 1) {
        f32x2* cs16 = (f32x2*)(p.ws + WS_ROPE16); f32x2* cs8 = (f32x2*)(p.ws + WS_ROPE8);
        for (int i = tid; i < 64 * 16 + 64 * 8; i += 512) {
            const bool a = i < 1024; const int ii = a ? i : i - 1024; const int pos = a ? ii >> 4 : ii >> 3, f = a ? ii & 15 : ii & 7;
            const float inv = exp2f(-(float)f * (13.287712379549449f / (a ? 16.f : 8.f)));
            const float x = (float)pos * inv; const float n = rintf(x * 0.15915494309189535f);
            float r = fmaf(-n, 6.2831855f, x); r = fmaf(-n, -1.7484555e-7f, r);
            const f32x2 cs = {__cosf(r), __sinf(r)};
            if (a) cs16[ii] = cs; else cs8[ii] = cs;
        }
        if (tid < 2) { const float* lp = p.in[19] + tid * 128; float s1 = 0.f, s2 = 0.f;
            for (int i = 0; i < 32; ++i) { s1 += lp[i] * lp[32 + i]; s2 += lp[64 + i] * lp[96 + i]; }
            const float lam_init = 0.8f - 0.6f * expf(-0.3f * (float)tid);
            float* lamv = (float*)(p.ws + WS_LAM); lamv[tid * 2] = expf(s1) - expf(s2) + lam_init; lamv[tid * 2 + 1] = lam_init; }
    }
}

template <class F> DI void conv_t(bf16_t* Wt, const int N, const int K, F src, const long gtid, const long gstride) {
    const long items = (long)N * (K / 8);
    for (long it = gtid; it < items; it += gstride) {
        const int n = (int)(it % N), k0 = (int)(it / N) * 8; int ld = 0; const float* s = src(n, k0, ld);
        float v[8];
#pragma unroll
        for (int j = 0; j < 8; ++j) v[j] = s ? s[(size_t)j * ld] : 0.f;
        u32x4 w; w.x = pk2(v[0], v[1]); w.y = pk2(v[2], v[3]); w.z = pk2(v[4], v[5]); w.w = pk2(v[6], v[7]);
        *(u32x4*)(Wt + (size_t)n * K + k0) = w;
    }
}
DI void phase_wconv(const Params& p, const int li) {
    unsigned char* wt = p.ws + WS_WT;
    const long gtid = (long)blockIdx.x * 512 + threadIdx.x, gs = (long)gridDim.x * 512;
    { const float* W = p.in[8] + (size_t)li * 1024 * 2976;
      conv_t((bf16_t*)(wt + WT_IN), NZ, 1024, [=](int n, int k0, int& ld) -> const float* { ld = 2976; return n < 2976 ? W + (size_t)k0 * 2976 + n : nullptr; }, gtid, gs); }
    { const float* W = p.in[9] + (size_t)li * 1024 * 4096;
      conv_t((bf16_t*)(wt + WT_G), 4096, 1024, [=](int n, int k0, int& ld) -> const float* { ld = 4096; return W + (size_t)k0 * 4096 + n; }, gtid, gs); }
    { const float* W = p.in[10] + (size_t)li * 4 * 256 * 1024;
      conv_t((bf16_t*)(wt + WT_B), 4096, 256, [=](int n, int k0, int& ld) -> const float* { ld = 1024; return W + (size_t)(n >> 10) * 256 * 1024 + (size_t)k0 * 1024 + (n & 1023); }, gtid, gs); }
    { const float* W = p.in[11] + (size_t)li * 1024 * 1024;
      conv_t((bf16_t*)(wt + WT_O), 1024, 1024, [=](int n, int k0, int& ld) -> const float* { ld = 1024; return W + (size_t)k0 * 1024 + n; }, gtid, gs); }
    { const float* Wq = p.in[17] + (size_t)li * 256 * 384; const float* Wkv = p.in[18] + (size_t)li * 128 * 512;
      conv_t((bf16_t*)(wt + WT_MLA), 1024, 384, [=](int n, int k0, int& ld) -> const float* {
          if (n < 384) { ld = 384; return k0 < 256 ? Wq + (size_t)k0 * 384 + n : nullptr; }
          if (n < 896) { ld = 512; return k0 >= 256 ? Wkv + (size_t)(k0 - 256) * 512 + (n - 384) : nullptr; }
          ld = 0; return nullptr; }, gtid, gs); }
    { const float* Wg = p.in[25] + (size_t)li * 32 * 1024 * 256; const float* Wu = p.in[26] + (size_t)li * 32 * 1024 * 256;
      conv_t((bf16_t*)(wt + WT_E1), 32 * 512, 1024, [=](int n, int k0, int& ld) -> const float* { ld = 256; const int e = n >> 9, r = n & 511, t = r >> 3, j = r & 7;
          const float* W = (j < 4 ? Wg : Wu) + (size_t)e * 1024 * 256; return W + (size_t)k0 * 256 + 4 * t + (j & 3); }, gtid, gs); }
    { const float* W = p.in[27] + (size_t)li * 32 * 256 * 1024;
      conv_t((bf16_t*)(wt + WT_E2), 32 * 1024, 256, [=](int n, int k0, int& ld) -> const float* { ld = 1024; return W + (size_t)(n >> 10) * 256 * 1024 + (size_t)k0 * 1024 + (n & 1023); }, gtid, gs); }
}

template <int MODE> DI void phase_norm(const Params& p, const int li) {
    const int lane = threadIdx.x & 63, wave = threadIdx.x >> 6;
    const int nrows = MODE == 2 ? ML : MT;
    const float* modv = (const float*)(p.ws + WS_MODV);
    float* ctxs = (float*)(p.ws + WS_CTXS); bf16_t* HB = (bf16_t*)(p.ws + WS_HB); const bf16_t* Y = (const bf16_t*)(p.ws + WS_Y);
    const bool combine = (MODE == 2) || (li > 0);
    const int lprev = MODE == 2 ? 1 : li - 1;
    const float* gain = MODE == 2 ? p.in[28] : p.in[6] + li * 1024;
    for (int row = blockIdx.x * 8 + wave; row < nrows; row += gridDim.x * 8) {
        const bool lat = row < ML; const int bsel = lat ? (row >> 12) : 8;
        float* xs = lat ? p.out + (size_t)row * 1024 : ctxs + (size_t)(row - ML) * 1024;
        const float* src = combine ? xs : (lat ? p.in[0] + (size_t)row * 1024 : p.in[2] + (size_t)(row - ML) * 1024);
        f32x4 v[4];
#pragma unroll
        for (int i = 0; i < 4; ++i) v[i] = *(const f32x4*)(src + i * 256 + lane * 4);
        if (combine) {
            const float* g2 = modv + ((lprev * 9 + bsel) * 6 + 5) * 1024;
#pragma unroll
            for (int i = 0; i < 4; ++i) { const int col = i * 256 + lane * 4;
                const u32x2 y0 = *(const u32x2*)(Y + (size_t)row * 1024 + col), y1 = *(const u32x2*)(Y + ((size_t)MT + row) * 1024 + col);
                const f32x4 g = *(const f32x4*)(g2 + col);
                v[i][0] += g[0] * (bflo(y0.x) + bflo(y1.x)); v[i][1] += g[1] * (bfhi(y0.x) + bfhi(y1.x));
                v[i][2] += g[2] * (bflo(y0.y) + bflo(y1.y)); v[i][3] += g[3] * (bfhi(y0.y) + bfhi(y1.y));
                if (MODE == 0) *(f32x4*)(xs + col) = v[i]; }
        }
        float ss = 0.f;
#pragma unroll
        for (int i = 0; i < 4; ++i) ss += v[i][0] * v[i][0] + v[i][1] * v[i][1] + v[i][2] * v[i][2] + v[i][3] * v[i][3];
        ss = wave_sum(ss);
        const float rstd = rsqrtf(ss * (1.f / 1024.f) + NORM_EPS);
        if (MODE == 2) {
#pragma unroll
            for (int i = 0; i < 4; ++i) { const int col = i * 256 + lane * 4; const f32x4 g = *(const f32x4*)(gain + col); *(f32x4*)(xs + col) = v[i] * rstd * g; }
        } else {
            const float* sh = modv + ((li * 9 + bsel) * 6 + 0) * 1024; const float* scl = modv + ((li * 9 + bsel) * 6 + 1) * 1024;
#pragma unroll
            for (int i = 0; i < 4; ++i) { const int col = i * 256 + lane * 4; const f32x4 g = *(const f32x4*)(gain + col), s1 = *(const f32x4*)(scl + col), s0 = *(const f32x4*)(sh + col);
                const f32x4 h = v[i] * rstd * g * (s1 + 1.f) + s0;
                u32x2 w; w.x = pk2(h[0], h[1]); w.y = pk2(h[2], h[3]); *(u32x2*)(HB + (size_t)row * 1024 + col) = w; }
        }
    }
}

DI void phase_norm2(const Params& p, const int li, ldsp lds) {
    const int tid = threadIdx.x, lane = tid & 63, wave = tid >> 6;
    const int nrows = li == 0 ? MT : ML;
    const float* modv = (const float*)(p.ws + WS_MODV);
    const float* ctxs = (const float*)(p.ws + WS_CTXS); bf16_t* HB = (bf16_t*)(p.ws + WS_HB);
    unsigned* cnt = (unsigned*)(p.ws + WS_CTL + CTL_CNT) + li * 32;
    int4* toki = (int4*)(p.ws + WS_TOKI); int* rowi = (int*)(p.ws + WS_ROWI);
    LAS float* rw = (LAS float*)lds;
    const float* wrg = p.in[21] + (size_t)li * 1024 * 4; const float* wre = p.in[23] + (size_t)li * 1024 * 32;
    for (int i = tid; i < 36 * 1024; i += 512) { const int e = i >> 10, k = i & 1023; rw[i] = e < 4 ? wrg[k * 4 + e] : wre[k * 32 + (e - 4)]; }
    for (long i = (long)blockIdx.x * 512 + tid; i < MOE_MAXROWS; i += (long)gridDim.x * 512) rowi[i] = -1;
    __syncthreads();
    const float* gain = p.in[7] + li * 1024; const float* brg = p.in[22] + li * 4; const float* bre = p.in[24] + li * 32;
    for (int row = blockIdx.x * 8 + wave; row < nrows; row += gridDim.x * 8) {
        const bool lat = row < ML; const int bsel = lat ? (row >> 12) : 8;
        const float* xs = lat ? p.out + (size_t)row * 1024 : ctxs + (size_t)(row - ML) * 1024;
        f32x4 v[4];
#pragma unroll
        for (int i = 0; i < 4; ++i) v[i] = *(const f32x4*)(xs + i * 256 + lane * 4);
        float ss = 0.f;
#pragma unroll
        for (int i = 0; i < 4; ++i) ss += v[i][0] * v[i][0] + v[i][1] * v[i][1] + v[i][2] * v[i][2] + v[i][3] * v[i][3];
        ss = wave_sum(ss);
        const float rstd = rsqrtf(ss * (1.f / 1024.f) + NORM_EPS);
        const float* sh = modv + ((li * 9 + bsel) * 6 + 3) * 1024; const float* scl = modv + ((li * 9 + bsel) * 6 + 4) * 1024;
#pragma unroll
        for (int i = 0; i < 4; ++i) { const int col = i * 256 + lane * 4; const f32x4 g = *(const f32x4*)(gain + col), s1 = *(const f32x4*)(scl + col), s0 = *(const f32x4*)(sh + col);
            v[i] = v[i] * rstd * g * (s1 + 1.f) + s0;
            u32x2 w; w.x = pk2(v[i][0], v[i][1]); w.y = pk2(v[i][2], v[i][3]); *(u32x2*)(HB + (size_t)row * 1024 + col) = w; }
        float lg[4];
#pragma unroll
        for (int e = 0; e < 4; ++e) { float s = 0.f;
#pragma unroll
            for (int i = 0; i < 4; ++i) { const f32x4 w = *(const LAS f32x4*)(rw + e * 1024 + i * 256 + lane * 4); s += v[i][0] * w[0] + v[i][1] * w[1] + v[i][2] * w[2] + v[i][3] * w[3]; }
            lg[e] = wave_sum(s) + brg[e]; }
        int gi = 0; float gm = lg[0];
#pragma unroll
        for (int g = 1; g < 4; ++g) { if (lg[g] > gm) { gm = lg[g]; gi = g; } }
        gi = __builtin_amdgcn_readfirstlane(gi);
        float gden = 0.f;
#pragma unroll
        for (int g = 0; g < 4; ++g) gden += __expf(lg[g] - gm);
        const float gval = 1.f / gden;
        float el[8];
#pragma unroll
        for (int j = 0; j < 8; ++j) { float s = 0.f; const LAS float* wp = rw + (4 + gi * 8 + j) * 1024 + lane * 4;
#pragma unroll
            for (int i = 0; i < 4; ++i) { const f32x4 w = *(const LAS f32x4*)(wp + i * 256); s += v[i][0] * w[0] + v[i][1] * w[1] + v[i][2] * w[2] + v[i][3] * w[3]; }
            el[j] = wave_sum(s) + bre[gi * 8 + j]; }
        int i1 = 0; float m1 = el[0];
#pragma unroll
        for (int j = 1; j < 8; ++j) if (el[j] > m1) { m1 = el[j]; i1 = j; }
        int i2 = -1; float m2 = -3.0e38f;
#pragma unroll
        for (int j = 0; j < 8; ++j) if (j != i1 && el[j] > m2) { m2 = el[j]; i2 = j; }
        const float t = __expf(m2 - m1); const float w1 = gval / (1.f + t), w2 = gval * t / (1.f + t);
        if (lane == 0) {
            const int e1 = gi * 8 + i1, e2 = gi * 8 + i2;
            const unsigned p1 = atomicAdd(&cnt[e1], 1u), p2 = atomicAdd(&cnt[e2], 1u);
            toki[(size_t)row * 2 + 0] = make_int4(e1, (int)p1, __float_as_int(w1), 0);
            toki[(size_t)row * 2 + 1] = make_int4(e2, (int)p2, __float_as_int(w2), 0);
        }
    }
}

DI int moe_offsets(const unsigned* cnt, LAS unsigned* off, LAS unsigned char* pe) {
    if (threadIdx.x == 0) { unsigned o = 0; for (int e = 0; e < 32; ++e) { const unsigned c = __hip_atomic_load(cnt + e, __ATOMIC_RELAXED, __HIP_MEMORY_SCOPE_AGENT); const unsigned np = (c + 255u) >> 8; off[e] = o;
            for (unsigned q = 0; q < np; ++q) pe[(o >> 8) + q] = (unsigned char)e; o += np << 8; } off[32] = o; }
    __syncthreads();
    return (int)(off[32] >> 8);
}
DI void phase_scatter(const Params& p, const int li, ldsp lds) {
    const int lane = threadIdx.x & 63, wave = threadIdx.x >> 6;
    const int ntok = li == 0 ? MT : ML;
    LAS unsigned* off = (LAS unsigned*)(lds + 1024); LAS unsigned char* pe = (LAS unsigned char*)lds;
    moe_offsets((const unsigned*)(p.ws + WS_CTL + CTL_CNT) + li * 32, off, pe);
    const int4* toki = (const int4*)(p.ws + WS_TOKI); int* rowi = (int*)(p.ws + WS_ROWI); float* roww = (float*)(p.ws + WS_ROWW);
    const bf16_t* HB = (const bf16_t*)(p.ws + WS_HB); bf16_t* XG = (bf16_t*)(p.ws + WS_XG);
    for (int it = blockIdx.x * 8 + wave; it < ntok * 2; it += gridDim.x * 8) {
        const int4 ti = toki[it]; const int row = (int)off[ti.x] + ti.y;
        const u32x4* s = (const u32x4*)(HB + (size_t)(it >> 1) * 1024); u32x4* d = (u32x4*)(XG + (size_t)row * 1024);
        d[lane] = s[lane]; d[lane + 64] = s[lane + 64];
        if (lane == 0) { rowi[row] = it; roww[row] = __int_as_float(ti.z); }
    }
}

DI void hgrn_load(const bf16_t* Z, const float* lbl, const int li, const int row0, const int h, const int tid,
                  LAS float* AF, LAS float* AB, LAS float* KF, LAS float* KB, LAS float* V, LAS float* Q) {
    const int t = tid >> 3, d0 = (tid & 7) * 8; const bf16_t* zr = Z + (size_t)(row0 + t) * NZ + h * 64 + d0;
    const u32x4 zf = *(const u32x4*)(zr + ZB_FF), zb = *(const u32x4*)(zr + ZB_FB), zi = *(const u32x4*)(zr + ZB_I);
    const unsigned zfu[4] = {zf.x, zf.y, zf.z, zf.w}, zbu[4] = {zb.x, zb.y, zb.z, zb.w}, ziu[4] = {zi.x, zi.y, zi.z, zi.w};
    u32x4 zq = (u32x4){0u, 0u, 0u, 0u}; if (Q) zq = *(const u32x4*)(zr + ZB_Q);
    const unsigned zqu[4] = {zq.x, zq.y, zq.z, zq.w};
#pragma unroll
    for (int j = 0; j < 8; ++j) {
        const int d = d0 + j, hd = h * 64 + d;
        float lbf = 0.f, lbb = 0.f;
        if (li > 0) { lbf = sigmoidf_(lbl[(1 * 2 + 0) * 256 + hd] - lbl[(0 * 2 + 0) * 256 + hd]); lbb = sigmoidf_(lbl[(1 * 2 + 1) * 256 + hd] - lbl[(0 * 2 + 1) * 256 + hd]); }
        const float xf = (j & 1) ? bfhi(zfu[j >> 1]) : bflo(zfu[j >> 1]), xb = (j & 1) ? bfhi(zbu[j >> 1]) : bflo(zbu[j >> 1]);
        const float sf = sigmoidf_(xf), sb = sigmoidf_(xb);
        AF[t * 65 + d] = __logf(fmaxf(lbf + (1.f - lbf) * sf, 1e-30f)); KF[t * 65 + d] = (1.f - lbf) * (1.f - sf);
        AB[t * 65 + d] = __logf(fmaxf(lbb + (1.f - lbb) * sb, 1e-30f)); KB[t * 65 + d] = (1.f - lbb) * (1.f - sb);
        V[t * 65 + d] = (j & 1) ? bfhi(ziu[j >> 1]) : bflo(ziu[j >> 1]);
        if (Q) Q[t * 65 + d] = (j & 1) ? bfhi(zqu[j >> 1]) : bflo(zqu[j >> 1]);
    }
}
DI void hgrn_cumsum(const int tid, LAS float* AF, LAS float* AB) {
    if (tid < 64) { float s = 0.f; for (int t = 0; t < 64; ++t) { s += AF[t * 65 + tid]; AF[t * 65 + tid] = s; } }
    else if (tid < 128) { const int d = tid - 64; float s = 0.f; for (int t = 63; t >= 0; --t) { s += AB[t * 65 + d]; AB[t * 65 + d] = s; } }
}

DI void phase_prep(const Params& p, const int li, ldsp lds) {
    const int tid = threadIdx.x;
    bf16_t* Z = (bf16_t*)(p.ws + WS_Z);
    const f32x2* cs16 = (const f32x2*)(p.ws + WS_ROPE16); const f32x2* cs8 = (const f32x2*)(p.ws + WS_ROPE8);
    bf16_t* KC = (bf16_t*)(p.ws + WS_X + X_KC); bf16_t* AVt = (bf16_t*)(p.ws + WS_X + X_AVT); bf16_t* DVt = (bf16_t*)(p.ws + WS_X + X_DVT);
    bf16_t* U = (bf16_t*)(p.ws + WS_X + X_U); float* HE = (float*)(p.ws + WS_HE);
    const float* qn = p.in[15] + li * 256; const float* kvn = p.in[16] + li * 128; const float* lbl = p.in[13];
    LAS float* AF = (LAS float*)lds; LAS float* AB = AF + 64 * 65; LAS float* KF = AB + 64 * 65; LAS float* KB = KF + 64 * 65; LAS float* V = KB + 64 * 65;
    LAS bf16_t* TT = (LAS bf16_t*)(lds + 5 * 64 * 65 * 4);
    for (int cidx = blockIdx.x; cidx < NCHUNK; cidx += gridDim.x) {
        const int row0 = chunk_row0(cidx); const bool lat = cidx < 512;
        int b, key0; row_bk(row0, b, key0);
        if (lat) {
            for (int i = tid; i < 64 * 6 * 32; i += 512) { const int t = i / 192, r = i % 192, blk = r >> 5, pr = r & 31, half = pr >> 4, j = pr & 15;
                const int pos = half ? ((key0 + t) & 63) : ((key0 + t) >> 6); const f32x2 cs = cs16[pos * 16 + j];
                bf16_t* x = Z + (size_t)(row0 + t) * NZ + ZA_Q + blk * 64 + half * 32 + j; const float x1 = bf2f(x[0]), x2 = bf2f(x[16]);
                x[0] = f2bf(x1 * cs.x - x2 * cs.y); x[16] = f2bf(x2 * cs.x + x1 * cs.y); }
            for (int i = tid; i < 64 * 16 * 16; i += 512) { const int t = i >> 8, r = i & 255, blk = r >> 4, pr = r & 15, half = pr >> 3, j = pr & 7;
                const int pos = half ? ((key0 + t) & 63) : ((key0 + t) >> 6); const f32x2 cs = cs8[pos * 8 + j];
                bf16_t* x = Z + (size_t)(row0 + t) * NZ + ZD_Q + blk * 32 + half * 16 + j; const float x1 = bf2f(x[0]), x2 = bf2f(x[8]);
                x[0] = f2bf(x1 * cs.x - x2 * cs.y); x[8] = f2bf(x2 * cs.x + x1 * cs.y); }
        }
        { const int t = tid >> 3, s = tid & 7; bf16_t* zr = Z + (size_t)(row0 + t) * NZ;
          float xq[32], xk[16]; float sq = 0.f, sk = 0.f;
#pragma unroll
          for (int j = 0; j < 4; ++j) { const u32x4 w = *(const u32x4*)(zr + ZC_Q + s * 32 + j * 8); const unsigned wu[4] = {w.x, w.y, w.z, w.w};
#pragma unroll
              for (int q = 0; q < 4; ++q) { xq[j * 8 + 2 * q] = bflo(wu[q]); xq[j * 8 + 2 * q + 1] = bfhi(wu[q]); } }
#pragma unroll
          for (int j = 0; j < 2; ++j) { const u32x4 w = *(const u32x4*)(zr + ZC_KV + s * 16 + j * 8); const unsigned wu[4] = {w.x, w.y, w.z, w.w};
#pragma unroll
              for (int q = 0; q < 4; ++q) { xk[j * 8 + 2 * q] = bflo(wu[q]); xk[j * 8 + 2 * q + 1] = bfhi(wu[q]); } }
#pragma unroll
          for (int j = 0; j < 32; ++j) sq += xq[j] * xq[j];
#pragma unroll
          for (int j = 0; j < 16; ++j) sk += xk[j] * xk[j];
          sq += __shfl_xor(sq, 1); sq += __shfl_xor(sq, 2); sq += __shfl_xor(sq, 4); sk += __shfl_xor(sk, 1); sk += __shfl_xor(sk, 2); sk += __shfl_xor(sk, 4);
          const float rq = rsqrtf(sq * (1.f / 256.f) + NORM_EPS), rk = rsqrtf(sk * (1.f / 128.f) + NORM_EPS);
#pragma unroll
          for (int j = 0; j < 4; ++j) { u32x4 w; const float* g = qn + s * 32 + j * 8;
              w.x = pk2(xq[j * 8 + 0] * rq * g[0], xq[j * 8 + 1] * rq * g[1]); w.y = pk2(xq[j * 8 + 2] * rq * g[2], xq[j * 8 + 3] * rq * g[3]);
              w.z = pk2(xq[j * 8 + 4] * rq * g[4], xq[j * 8 + 5] * rq * g[5]); w.w = pk2(xq[j * 8 + 6] * rq * g[6], xq[j * 8 + 7] * rq * g[7]);
              *(u32x4*)(zr + ZC_Q + s * 32 + j * 8) = w; }
#pragma unroll
          for (int j = 0; j < 2; ++j) { u32x4 w; const float* g = kvn + s * 16 + j * 8;
              w.x = pk2(xk[j * 8 + 0] * rk * g[0], xk[j * 8 + 1] * rk * g[1]); w.y = pk2(xk[j * 8 + 2] * rk * g[2], xk[j * 8 + 3] * rk * g[3]);
              w.z = pk2(xk[j * 8 + 4] * rk * g[4], xk[j * 8 + 5] * rk * g[5]); w.w = pk2(xk[j * 8 + 6] * rk * g[6], xk[j * 8 + 7] * rk * g[7]);
              *(u32x4*)(zr + ZC_KV + s * 16 + j * 8) = w; } }
        for (int i = tid; i < 64 * 16; i += 512) { const int t = i >> 4, pr = i & 15, half = pr >> 3, j = pr & 7;
            const bf16_t* x = Z + (size_t)(row0 + t) * NZ + ZC_KR + half * 16 + j; float x1 = bf2f(x[0]), x2 = bf2f(x[8]);
            if (lat) { const int pos = half ? ((key0 + t) & 63) : ((key0 + t) >> 6); const f32x2 cs = cs8[pos * 8 + j]; const float a = x1 * cs.x - x2 * cs.y, c = x2 * cs.x + x1 * cs.y; x1 = a; x2 = c; }
            const bf16_t o1 = f2bf(x1), o2 = f2bf(x2);
#pragma unroll
            for (int hh = 0; hh < 4; ++hh) { bf16_t* kp = KC + ((size_t)(b * 4 + hh) * KEYS + key0 + t) * 96 + 64 + half * 16 + j; kp[0] = o1; kp[8] = o2; } }
        for (int tile = 0; tile < 6; ++tile) {
            const int zc = tile < 2 ? ZA_V + tile * 64 : ZD_V + (tile - 2) * 64;
            { const int t = tid >> 3, c8 = (tid & 7) * 8; const u32x4 w = *(const u32x4*)(Z + (size_t)(row0 + t) * NZ + zc + c8);
              *(LAS u32x2*)(TT + t * 72 + c8) = (u32x2){w.x, w.y}; *(LAS u32x2*)(TT + t * 72 + c8 + 4) = (u32x2){w.z, w.w}; }
            __syncthreads();
            { const int dv = tid >> 3, k8 = (tid & 7) * 8; unsigned short e[8];
#pragma unroll
              for (int j = 0; j < 8; ++j) e[j] = TT[(k8 + j) * 72 + dv];
              u32x4 w; w.x = e[0] | ((unsigned)e[1] << 16); w.y = e[2] | ((unsigned)e[3] << 16); w.z = e[4] | ((unsigned)e[5] << 16); w.w = e[6] | ((unsigned)e[7] << 16);
              bf16_t* dst = tile < 2 ? AVt + ((size_t)(b * 2 + tile) * 64 + dv) * KEYS + key0 + k8 : DVt + ((size_t)(b * 4 + tile - 2) * 64 + dv) * KEYS + key0 + k8;
              *(u32x4*)dst = w; }
            __syncthreads();
        }
        for (int h = 0; h < 4; ++h) {
            hgrn_load(Z, lbl, li, row0, h, tid, AF, AB, KF, KB, V, (LAS float*)nullptr);
            __syncthreads();
            hgrn_cumsum(tid, AF, AB);
            __syncthreads();
            if (tid < 64) HE[((size_t)(cidx * 4 + h) * 2 + 0) * 64 + tid] = __expf(AF[63 * 65 + tid]);
            else if (tid < 128) HE[((size_t)(cidx * 4 + h) * 2 + 1) * 64 + tid - 64] = __expf(AB[tid - 64]);
            for (int i = tid; i < 4096; i += 512) { const int s = i >> 6, d = i & 63;
                KF[s * 65 + d] *= __expf(AF[63 * 65 + d] - AF[s * 65 + d]); KB[s * 65 + d] *= __expf(AB[d] - AB[s * 65 + d]); }
            __syncthreads();
            { const int d = tid >> 3, e0 = (tid & 7) * 8; float uf[8], ub[8];
#pragma unroll
              for (int j = 0; j < 8; ++j) { uf[j] = 0.f; ub[j] = 0.f; }
              for (int s = 0; s < 64; ++s) { const float kf = KF[s * 65 + d], kb = KB[s * 65 + d];
#pragma unroll
                  for (int j = 0; j < 8; ++j) { const float vv = V[s * 65 + e0 + j]; uf[j] += kf * vv; ub[j] += kb * vv; } }
              u32x4 w; w.x = pk2(uf[0], uf[1]); w.y = pk2(uf[2], uf[3]); w.z = pk2(uf[4], uf[5]); w.w = pk2(uf[6], uf[7]);
              *(u32x4*)(U + ((size_t)(cidx * 4 + h) * 2 + 0) * 4096 + d * 64 + e0) = w;
              w.x = pk2(ub[0], ub[1]); w.y = pk2(ub[2], ub[3]); w.z = pk2(ub[4], ub[5]); w.w = pk2(ub[6], ub[7]);
              *(u32x4*)(U + ((size_t)(cidx * 4 + h) * 2 + 1) * 4096 + d * 64 + e0) = w; }
            __syncthreads();
        }
    }
}

DI void phase_hscan(const Params& p) {
    bf16_t* U = (bf16_t*)(p.ws + WS_X + X_U); const float* HE = (const float*)(p.ws + WS_HE);
    for (int g = blockIdx.x * 512 + threadIdx.x; g < 64 * 4096; g += gridDim.x * 512) {
        const int chain = g >> 12, el = g & 4095, d = el >> 6; const int b = chain >> 3, h = (chain >> 1) & 3, dir = chain & 1;
        float S = 0.f;
        for (int k0 = 0; k0 < 68; k0 += 4) {
            float u[4], e[4]; size_t ad[4];
#pragma unroll
            for (int q = 0; q < 4; ++q) { const int k = k0 + q; int cidx;
                if (dir == 0) cidx = k < 4 ? 512 + b * 4 + k : b * 64 + (k - 4); else cidx = k < 4 ? 512 + b * 4 + (3 - k) : b * 64 + (67 - k);
                const size_t ch = (size_t)(cidx * 4 + h) * 2 + dir; ad[q] = ch * 4096 + el; u[q] = bf2f(U[ad[q]]); e[q] = HE[ch * 64 + d]; }
#pragma unroll
            for (int q = 0; q < 4; ++q) { U[ad[q]] = f2bf(S); S = e[q] * S + u[q]; }
        }
    }
}

DI void hgrn_out_unit(const Params& p, const int li, const int cidx, ldsp lds) {
    const int tid = threadIdx.x;
    bf16_t* Z = (bf16_t*)(p.ws + WS_Z); const bf16_t* U = (const bf16_t*)(p.ws + WS_X + X_U);
    const float* lbl = p.in[13]; const float* gn = p.in[14] + li * 64;
    LAS float* AF = (LAS float*)lds; LAS float* AB = AF + 64 * 65; LAS float* KF = AB + 64 * 65; LAS float* KB = KF + 64 * 65; LAS float* V = KB + 64 * 65;
    LAS float* Q = V + 64 * 65; LAS float* W = Q + 64 * 65; LAS bf16_t* SF = (LAS bf16_t*)(W + 64 * 65); LAS bf16_t* SB = SF + 4096;
    const int row0 = chunk_row0(cidx);
    for (int h = 0; h < 4; ++h) {
        hgrn_load(Z, lbl, li, row0, h, tid, AF, AB, KF, KB, V, Q);
        { const u32x4 a = *(const u32x4*)(U + ((size_t)(cidx * 4 + h) * 2 + 0) * 4096 + tid * 8), c = *(const u32x4*)(U + ((size_t)(cidx * 4 + h) * 2 + 1) * 4096 + tid * 8);
          *(LAS u32x4*)(SF + tid * 8) = a; *(LAS u32x4*)(SB + tid * 8) = c; }
        __syncthreads();
        hgrn_cumsum(tid, AF, AB);
        __syncthreads();
        {
            const int t = tid >> 3, s0 = (tid & 7) * 8; float w[8];
#pragma unroll
            for (int j = 0; j < 8; ++j) w[j] = 0.f;
            for (int d = 0; d < 64; ++d) { const float q = Q[t * 65 + d], af = AF[t * 65 + d], ab = AB[t * 65 + d];
#pragma unroll
                for (int j = 0; j < 8; ++j) { const int s = s0 + j;
                    const float kf = KF[s * 65 + d], kb = KB[s * 65 + d], asf = AF[s * 65 + d], asb = AB[s * 65 + d];
                    float c;
                    if (s < t) c = kf * __expf(af - asf); else if (s > t) c = kb * __expf(ab - asb); else c = kf + kb;
                    w[j] += q * c; } }
#pragma unroll
            for (int j = 0; j < 8; ++j) W[t * 65 + s0 + j] = w[j];
        }
        __syncthreads();
        {
            const int t = tid >> 3, e0 = (tid & 7) * 8; float o[8];
#pragma unroll
            for (int j = 0; j < 8; ++j) o[j] = 0.f;
            for (int s = 0; s < 64; ++s) { const float w = W[t * 65 + s];
#pragma unroll
                for (int j = 0; j < 8; ++j) o[j] += w * V[s * 65 + e0 + j]; }
            for (int d = 0; d < 64; ++d) { const float q = Q[t * 65 + d]; const float qf = q * __expf(AF[t * 65 + d]), qb = q * __expf(AB[t * 65 + d]);
#pragma unroll
                for (int j = 0; j < 8; ++j) o[j] += qf * bf2f(SF[d * 64 + e0 + j]) + qb * bf2f(SB[d * 64 + e0 + j]); }
            float ss = 0.f;
#pragma unroll
            for (int j = 0; j < 8; ++j) ss += o[j] * o[j];
            ss += __shfl_xor(ss, 1); ss += __shfl_xor(ss, 2); ss += __shfl_xor(ss, 4);
            const float rstd = rsqrtf(ss * (1.f / 64.f) + NORM_EPS);
            bf16_t* zr = Z + (size_t)(row0 + t) * NZ + h * 64 + e0;
            const u32x4 gw = *(const u32x4*)(zr + ZB_G); const unsigned gu[4] = {gw.x, gw.y, gw.z, gw.w};
            float r[8];
#pragma unroll
            for (int j = 0; j < 8; ++j) { const float g = (j & 1) ? bfhi(gu[j >> 1]) : bflo(gu[j >> 1]); r[j] = o[j] * rstd * gn[e0 + j] * g * sigmoidf_(g); }
            u32x4 w; w.x = pk2(r[0], r[1]); w.y = pk2(r[2], r[3]); w.z = pk2(r[4], r[5]); w.w = pk2(r[6], r[7]);
            *(u32x4*)(zr + ZB_Q) = w;
        }
        __syncthreads();
    }
}

template <int DQK, int NMAP, int MODE>
struct AttnCfg { static constexpr int KW = DQK * NMAP, RSK = KW * 2 + 16, RSV = 136, KBYTES = 64 * RSK, BUF = KBYTES + 64 * RSV, CPR = KW / 8, NCK = 64 * CPR; };

template <int DQK, int NMAP, int MODE, class TileFn>
DI void attn_unit(ldsp lds, const bf16_t* qrow  , const int ntiles, TileFn tile,
                  const float scl2  , const float m_init, const float l_init, const int qpos  ,
                  bf16_t* orow, const float lam, const float post, const float* subln, const int qtok = -1, const f32x2* cs8 = nullptr) {
    typedef AttnCfg<DQK, NMAP, MODE> C;
    const int tid = threadIdx.x, lane = tid & 63, r = lane & 31, hh = lane >> 5;
    bf16x8 qf[NMAP][DQK / 16];
#pragma unroll
    for (int mp = 0; mp < NMAP; ++mp)
#pragma unroll
        for (int kk = 0; kk < DQK / 16; ++kk) qf[mp][kk] = *(const bf16x8*)(qrow + mp * DQK + kk * 16 + hh * 8);
    if (MODE == 0 && qtok >= 0) {
#pragma unroll
        for (int kk = 4; kk < 6; ++kk) { const int pos = kk == 4 ? (qtok >> 6) : (qtok & 63);
            const u32x4 w = __builtin_bit_cast(u32x4, qf[0][kk]); const unsigned wu[4] = {w.x, w.y, w.z, w.w}; unsigned ou[4];
#pragma unroll
            for (int q2 = 0; q2 < 4; ++q2) { const unsigned pw = __shfl_xor(wu[q2], 32);
                const f32x2 c0 = cs8[pos * 8 + 2 * q2], c1 = cs8[pos * 8 + 2 * q2 + 1];
                const float a0 = bflo(wu[q2]), a1 = bfhi(wu[q2]), b0 = bflo(pw), b1 = bfhi(pw);
                const float r0 = hh ? a0 * c0.x + b0 * c0.y : a0 * c0.x - b0 * c0.y, r1 = hh ? a1 * c1.x + b1 * c1.y : a1 * c1.x - b1 * c1.y;
                ou[q2] = pk2(r0, r1); }
            const u32x4 o4 = {ou[0], ou[1], ou[2], ou[3]}; qf[0][kk] = __builtin_bit_cast(bf16x8, o4); }
    }
    f32x16 O[NMAP][2];
    float m[NMAP], l[NMAP];
#pragma unroll
    for (int mp = 0; mp < NMAP; ++mp) { m[mp] = m_init; l[mp] = l_init;
#pragma unroll
        for (int dv = 0; dv < 2; ++dv)
#pragma unroll
            for (int i = 0; i < 16; ++i) O[mp][dv][i] = 0.f; }
    const int kr0 = tid / C::CPR, kc0 = tid % C::CPR; const int kr1 = (tid + 512) / C::CPR, kc1 = (tid + 512) % C::CPR;
    const int vr = tid >> 3, vc = tid & 7;
    u32x4 kreg0, kreg1 = (u32x4){0u, 0u, 0u, 0u}, vreg;
    const bf16_t* kp; const bf16_t* vp; int ldk, kpos0, masked;
    tile(0, kp, ldk, vp, kpos0, masked);
    kreg0 = *(const u32x4*)(kp + (size_t)kr0 * ldk + kc0 * 8);
    if (C::NCK > 512 && tid + 512 < C::NCK) kreg1 = *(const u32x4*)(kp + (size_t)kr1 * ldk + kc1 * 8);
    vreg = *(const u32x4*)(vp + (size_t)vr * KEYS + vc * 8);
    __syncthreads();
    *(LAS u32x4*)(lds + kr0 * C::RSK + kc0 * 16) = kreg0;
    if (C::NCK > 512 && tid + 512 < C::NCK) *(LAS u32x4*)(lds + kr1 * C::RSK + kc1 * 16) = kreg1;
    *(LAS u32x4*)(lds + C::KBYTES + vr * C::RSV + vc * 16) = vreg;
    __syncthreads();
#pragma unroll 1
    for (int j = 0; j < ntiles; ++j) {
        const int cur_kpos0 = kpos0, cur_masked = masked;
        const bool more = j + 1 < ntiles;
        if (more) { tile(j + 1, kp, ldk, vp, kpos0, masked);
            kreg0 = *(const u32x4*)(kp + (size_t)kr0 * ldk + kc0 * 8);
            if (C::NCK > 512 && tid + 512 < C::NCK) kreg1 = *(const u32x4*)(kp + (size_t)kr1 * ldk + kc1 * 8);
            vreg = *(const u32x4*)(vp + (size_t)vr * KEYS + vc * 8); }
        ldsp kb = lds + (j & 1) * C::BUF; ldsp vb = kb + C::KBYTES;
        bf16x8 pf[NMAP][2][2];
#pragma unroll
        for (int mp = 0; mp < NMAP; ++mp) {
            f32x16 s[2];
#pragma unroll
            for (int ks = 0; ks < 2; ++ks) {
#pragma unroll
                for (int i = 0; i < 16; ++i) s[ks][i] = 0.f;
#pragma unroll
                for (int kk = 0; kk < DQK / 16; ++kk) { const bf16x8 kf = *(const LAS bf16x8*)(kb + (32 * ks + r) * C::RSK + (mp * DQK + kk * 16 + hh * 8) * 2);
                    s[ks] = __builtin_amdgcn_mfma_f32_32x32x16_bf16(kf, qf[mp][kk], s[ks], 0, 0, 0); } }
            float mx = -3.0e38f;
#pragma unroll
            for (int ks = 0; ks < 2; ++ks)
#pragma unroll
                for (int i = 0; i < 16; ++i) { float x = s[ks][i] * scl2;
                    if (MODE == 2) { const int rel = cur_kpos0 + 32 * ks + (i & 3) + 8 * (i >> 2) + 4 * hh - qpos; if (cur_masked && (rel > 128 || rel < -128)) x = -1.0e30f; }
                    s[ks][i] = x; mx = fmaxf(mx, x); }
            mx = fmaxf(mx, __shfl_xor(mx, 32));
            const float mn = fmaxf(m[mp], mx), alpha = __builtin_amdgcn_exp2f(m[mp] - mn); m[mp] = mn;
            float ps = 0.f;
#pragma unroll
            for (int ks = 0; ks < 2; ++ks)
#pragma unroll
                for (int i = 0; i < 16; ++i) { const float pv = __builtin_amdgcn_exp2f(s[ks][i] - mn); s[ks][i] = pv; ps += pv; }
            l[mp] = l[mp] * alpha + ps;
#pragma unroll
            for (int dv = 0; dv < 2; ++dv)
#pragma unroll
                for (int i = 0; i < 16; ++i) O[mp][dv][i] *= alpha;
#pragma unroll
            for (int ks = 0; ks < 2; ++ks)
#pragma unroll
                for (int s2 = 0; s2 < 2; ++s2) { u32x4 w; w.x = pk2(s[ks][8 * s2 + 0], s[ks][8 * s2 + 1]); w.y = pk2(s[ks][8 * s2 + 2], s[ks][8 * s2 + 3]);
                    w.z = pk2(s[ks][8 * s2 + 4], s[ks][8 * s2 + 5]); w.w = pk2(s[ks][8 * s2 + 6], s[ks][8 * s2 + 7]);
                    pf[mp][ks][s2] = __builtin_bit_cast(bf16x8, w); }
        }
#pragma unroll
        for (int dv = 0; dv < 2; ++dv)
#pragma unroll
            for (int ks = 0; ks < 2; ++ks)
#pragma unroll
                for (int s2 = 0; s2 < 2; ++s2) {
                    const LAS unsigned char* va = vb + (32 * dv + r) * C::RSV + (32 * ks + 16 * s2 + 4 * hh) * 2;
                    const u32x2 lo = *(const LAS u32x2*)va, hi = *(const LAS u32x2*)(va + 16);
                    const u32x4 vw = {lo.x, lo.y, hi.x, hi.y}; const bf16x8 vf = __builtin_bit_cast(bf16x8, vw);
#pragma unroll
                    for (int mp = 0; mp < NMAP; ++mp) O[mp][dv] = __builtin_amdgcn_mfma_f32_32x32x16_bf16(vf, pf[mp][ks][s2], O[mp][dv], 0, 0, 0);
                }
        if (more) { ldsp nb = lds + ((j + 1) & 1) * C::BUF;
            *(LAS u32x4*)(nb + kr0 * C::RSK + kc0 * 16) = kreg0;
            if (C::NCK > 512 && tid + 512 < C::NCK) *(LAS u32x4*)(nb + kr1 * C::RSK + kc1 * 16) = kreg1;
            *(LAS u32x4*)(nb + C::KBYTES + vr * C::RSV + vc * 16) = vreg; }
        __syncthreads();
    }
    asm volatile("" ::: "memory");
    float inv[NMAP];
#pragma unroll
    for (int mp = 0; mp < NMAP; ++mp) { const float lt = l[mp] + __shfl_xor(l[mp], 32); inv[mp] = 1.f / lt; }
    float o[2][16];
#pragma unroll
    for (int dv = 0; dv < 2; ++dv)
#pragma unroll
        for (int i = 0; i < 16; ++i) { if (MODE == 1) o[dv][i] = O[0][dv][i] * inv[0] - lam * O[NMAP - 1][dv][i] * inv[NMAP - 1]; else o[dv][i] = O[0][dv][i] * inv[0]; }
    if (MODE == 1) {
        float ss = 0.f;
#pragma unroll
        for (int dv = 0; dv < 2; ++dv)
#pragma unroll
            for (int i = 0; i < 16; ++i) ss += o[dv][i] * o[dv][i];
        ss += __shfl_xor(ss, 32);
        const float rstd = rsqrtf(ss * (1.f / 64.f) + NORM_EPS) * post;
#pragma unroll
        for (int dv = 0; dv < 2; ++dv)
#pragma unroll
            for (int i = 0; i < 16; ++i) o[dv][i] *= rstd * subln[32 * dv + (i & 3) + 8 * (i >> 2) + 4 * hh];
    }
#pragma unroll
    for (int dv = 0; dv < 2; ++dv)
#pragma unroll
        for (int g = 0; g < 4; ++g) { u32x2 w; w.x = pk2(o[dv][4 * g + 0], o[dv][4 * g + 1]); w.y = pk2(o[dv][4 * g + 2], o[dv][4 * g + 3]);
            *(u32x2*)(orow + 32 * dv + 8 * g + 4 * hh) = w; }
}

DI void attn_c_unit(const Params& p, const int u, ldsp lds) {
    const int wave = threadIdx.x >> 6, r = threadIdx.x & 31;
    const bf16_t* QC = (const bf16_t*)(p.ws + WS_X + X_QC); const bf16_t* KC = (const bf16_t*)(p.ws + WS_X + X_KC); const bf16_t* CVt = (const bf16_t*)(p.ws + WS_X + X_CVT);
    bf16_t* Z = (bf16_t*)(p.ws + WS_Z);
    int b, h, row, nt, t0;
    if (u < 512) { b = u >> 6; h = (u >> 4) & 3; row = b * SEQ + (u & 15) * 256 + wave * 32 + r; nt = 68; t0 = 0; }
    else { const int v = u - 512; b = v >> 2; h = v & 3; row = ML + b * CTXL + wave * 32 + r; nt = 4; t0 = 64; }
    const bf16_t* kbase = KC + (size_t)(b * 4 + h) * KEYS * 96; const bf16_t* vbase = CVt + (size_t)(b * 4 + h) * 64 * KEYS;
    attn_unit<96, 1, 0>(lds, QC + (size_t)row * 384 + h * 96, nt,
        [=](int j, const bf16_t*& kp, int& ldk, const bf16_t*& vp, int& kpos0, int& masked) { const int key0 = (t0 + j) * 64; kp = kbase + (size_t)key0 * 96; ldk = 96; vp = vbase + key0; kpos0 = 0; masked = 0; },
        0.10206207261596577f * 1.4426950408889634f, -1.0e30f, 0.f, 0, Z + (size_t)row * NZ + ZC_Q + h * 64, 0.f, 0.f, nullptr,
        u < 512 ? (row & 4095) : -1, (const f32x2*)(p.ws + WS_ROPE8));
}
DI void attn_d_unit(const Params& p, const int li, const int u, ldsp lds) {
    const int wave = threadIdx.x >> 6, r = threadIdx.x & 31;
    bf16_t* Z = (bf16_t*)(p.ws + WS_Z); const bf16_t* DVt = (const bf16_t*)(p.ws + WS_X + X_DVT);
    int b, h, row, nt, t0;
    if (u < 512) { b = u >> 6; h = (u >> 4) & 3; row = b * SEQ + (u & 15) * 256 + wave * 32 + r; nt = 68; t0 = 0; }
    else { const int v = u - 512; b = v >> 2; h = v & 3; row = ML + b * CTXL + wave * 32 + r; nt = 4; t0 = 64; }
    const float* lamv = (const float*)(p.ws + WS_LAM); const float lam = lamv[li * 2], lam_init = lamv[li * 2 + 1];
    const bf16_t* vbase = DVt + (size_t)(b * 4 + h) * 64 * KEYS; const bf16_t* zk = Z + ZD_K + h * 64;
    attn_unit<32, 2, 1>(lds, Z + (size_t)row * NZ + ZD_Q + h * 64, nt,
        [=](int j, const bf16_t*& kp, int& ldk, const bf16_t*& vp, int& kpos0, int& masked) { const int key0 = (t0 + j) * 64; kp = zk + (size_t)key_row(b, key0) * NZ; ldk = NZ; vp = vbase + key0; kpos0 = 0; masked = 0; },
        0.17677669529663687f * 1.4426950408889634f, -1.0e30f, 0.f, 0, Z + (size_t)row * NZ + ZD_Q + h * 64, lam, 1.f - lam_init, p.in[20] + li * 64);
}
DI void attn_a_unit(const Params& p, const int li, const int u, ldsp lds) {
    const int wave = threadIdx.x >> 6, r = threadIdx.x & 31;
    bf16_t* Z = (bf16_t*)(p.ws + WS_Z); const bf16_t* AVt = (const bf16_t*)(p.ws + WS_X + X_AVT);
    int b, kvh, row, qpos, nt, tlo;
    const bool latq = u < 512;
    if (latq) { b = u >> 6; kvh = (u >> 5) & 1; const int qb = u & 31; qpos = qb * 128 + (wave & 3) * 32 + r; row = b * SEQ + qpos;
        const int lo = qb > 0 ? (qb - 1) * 2 : 0, hi = qb < 31 ? (qb + 2) * 2 : 64; tlo = lo; nt = (hi - lo) + 4; }
    else { const int v = u - 512; b = v >> 2; kvh = (v >> 1) & 1; qpos = 0; row = ML + b * CTXL + (v & 1) * 128 + (wave & 3) * 32 + r; tlo = 64; nt = 4; }
    const int head = 2 * kvh + (wave >> 2);
    const int nband = latq ? nt - 4 : 0;
    const bf16_t* vbase = AVt + (size_t)(b * 2 + kvh) * 64 * KEYS; const bf16_t* zk = Z + ZA_K + kvh * 64;
    const float sink = p.in[12][li * 4 + head] * 1.4426950408889634f;
    attn_unit<64, 1, 2>(lds, Z + (size_t)row * NZ + ZA_Q + head * 64, nt,
        [=](int j, const bf16_t*& kp, int& ldk, const bf16_t*& vp, int& kpos0, int& masked) {
            const int key0 = j < nband ? (tlo + j) * 64 : SEQ + (j - nband) * 64;
            kp = zk + (size_t)key_row(b, key0) * NZ; ldk = NZ; vp = vbase + key0; kpos0 = key0; masked = j < nband; },
        0.125f * 1.4426950408889634f, sink, (threadIdx.x & 32) ? 0.f : 1.f, qpos, Z + (size_t)row * NZ + ZA_Q + head * 64, 0.f, 0.f, nullptr);
}

enum { PH_PRE = 0, PH_WN1, PH_IN, PH_PREP, PH_MLA, PH_MIX, PH_GATE0, PH_MERGE0, PH_GATE1, PH_MERGE1, PH_OUT, PH_NORM2, PH_SCAT, PH_MOE1, PH_MOE2, PH_FINAL, PH_COUNT };

template <int PH> DI void run_phase(const Params& p, const int li, ldsp lds) {
    unsigned char* ws = p.ws; const char* wt = (const char*)(ws + WS_WT);
    const int G = gridDim.x, c = blockIdx.x;
    if constexpr (PH == PH_PRE) phase_pre(p, lds);
    if constexpr (PH == PH_WN1) { phase_wconv(p, li); phase_norm<0>(p, li); }
    if constexpr (PH == PH_IN) {
        pg8::SchedPlain S{(const char*)(ws + WS_HB), wt + WT_IN, 1024, 1024, MT / 256, NZ / 256, G, c, 0};
        pg8::EpiZ E{(bf16_t*)(ws + WS_Z)};
        pg8::gemm_phase(lds, 1024, 1024, 1024, S, E);
    }
    if constexpr (PH == PH_PREP) phase_prep(p, li, lds);
    if constexpr (PH == PH_MLA) {
        pg8::SchedPlain S{(const char*)(ws + WS_Z) + ZC_Q * 2, wt + WT_MLA, NZ, 384, MT / 256, 4, G, c, 0};
        pg8::EpiMla E{(bf16_t*)(ws + WS_X + X_QC), (bf16_t*)(ws + WS_X + X_KC), (bf16_t*)(ws + WS_X + X_CVT)};
        phase_hscan(p);
        pg8::gemm_phase(lds, NZ, 384, 384, S, E);
    }
    if constexpr (PH == PH_MIX) {
        const int nq = li == 0 ? 544 : 512;
        for (int u = c; u < nq; u += G) attn_c_unit(p, u, lds);
        for (int u = c; u < nq; u += G) attn_d_unit(p, li, u, lds);
        for (int u = c; u < nq; u += G) attn_a_unit(p, li, u, lds);
        __syncthreads();
        const int nch = li == 0 ? NCHUNK : 512;
        for (int u = c; u < nch; u += G) hgrn_out_unit(p, li, u, lds);
    }
    if constexpr (PH == PH_GATE0 || PH == PH_GATE1) {
        constexpr int half = PH == PH_GATE1;
        const int nM = li == 0 ? 68 : 64;
        pg8::SchedPlain S{(const char*)(ws + WS_HB), wt + WT_G, 1024, 1024, nM, 16, G, c, half * nM};
        pg8::EpiGate E{(bf16_t*)(ws + WS_X), half * nM * 256};
        pg8::gemm_phase(lds, 1024, 1024, 1024, S, E);
    }
    if constexpr (PH == PH_MERGE0 || PH == PH_MERGE1) {
        constexpr int half = PH == PH_MERGE1;
        const int nM = li == 0 ? 68 : 64;
        pg8::SchedMerge S{(const char*)(ws + WS_Z), wt + WT_B, nM, G, c, half * nM};
        pg8::EpiMerge E{(bf16_t*)(ws + WS_Z), (const bf16_t*)(ws + WS_X), half * nM * 256};
        pg8::gemm_phase(lds, NZ, 256, 256, S, E);
    }
    if constexpr (PH == PH_OUT) {
        const int nM = li == 0 ? 136 : 128;
        pg8::SchedPlain S{(const char*)(ws + WS_Z) + ZY * 2, wt + WT_O, NZ, 1024, nM, 4, G, c, 0};
        float* ctxs = (float*)(ws + WS_CTXS);
        pg8::EpiOut E{li == 0 ? p.in[0] : p.out, li == 0 ? p.in[2] : ctxs, p.out, ctxs, (const float*)(ws + WS_MODV) + li * 9 * 6144};
        pg8::gemm_phase(lds, NZ, 1024, 1024, S, E);
    }
    if constexpr (PH == PH_NORM2) phase_norm2(p, li, lds);
    if constexpr (PH == PH_SCAT) phase_scatter(p, li, lds);
    if constexpr (PH == PH_MOE1 || PH == PH_MOE2) {
        LAS unsigned* off = (LAS unsigned*)(lds + pg8::STAGE_BYTES + 1024); LAS unsigned char* pe = (LAS unsigned char*)(lds + pg8::STAGE_BYTES);
        const int nP = moe_offsets((const unsigned*)(ws + WS_CTL + CTL_CNT) + li * 32, off, pe);
        if constexpr (PH == PH_MOE1) {
            pg8::SchedMoe S{(const char*)(ws + WS_XG), wt + WT_E1, 1024, 1024, nP, 2, G, c, (size_t)512 * 1024 * 2, pe};
            pg8::EpiMoeUp E{(bf16_t*)(ws + WS_HMID)};
            pg8::gemm_phase(lds, 1024, 1024, 1024, S, E);
        } else {
            pg8::SchedMoe S{(const char*)(ws + WS_HMID), wt + WT_E2, 256, 256, nP, 4, G, c, (size_t)1024 * 256 * 2, pe};
            pg8::EpiMoeDown E{(bf16_t*)(ws + WS_Y), (const int*)(ws + WS_ROWI), (const float*)(ws + WS_ROWW)};
            pg8::gemm_phase(lds, 256, 256, 256, S, E);
        }
        __syncthreads();
    }
    if constexpr (PH == PH_FINAL) phase_norm<2>(p, 1);
}

#if N_LAUNCH_MODE == 1
template <int PH> __global__ __launch_bounds__(512, 2) void k_phase(Params p, int li) {
    extern __shared__ __attribute__((aligned(16))) unsigned char shm[];
    run_phase<PH>(p, li, (ldsp)shm);
}
#else
__global__ __launch_bounds__(512, 2) void k_mega(Params p) {
    extern __shared__ __attribute__((aligned(16))) unsigned char shm[];
    ldsp lds = (ldsp)shm;
    volatile LAS unsigned* st = (volatile LAS unsigned*)(lds + LDS_BYTES - 16);
    if (threadIdx.x == 0) { st[0] = 0u; st[1] = 0u; st[2] = 0u; st[3] = 0u; }
    __syncthreads();
    XcdBarrier bar = xcd_barrier_post((unsigned*)(p.ws + WS_CTL), st);
    run_phase<PH_PRE>(p, 0, lds); xcd_barrier(bar);
    for (int li = 0; li < 2; ++li) {
        run_phase<PH_WN1>(p, li, lds); xcd_barrier(bar);
        run_phase<PH_IN>(p, li, lds); xcd_barrier(bar);
        run_phase<PH_PREP>(p, li, lds); xcd_barrier(bar);
        run_phase<PH_MLA>(p, li, lds); xcd_barrier(bar);
        run_phase<PH_MIX>(p, li, lds); xcd_barrier(bar);
        run_phase<PH_GATE0>(p, li, lds); xcd_barrier(bar);
        run_phase<PH_MERGE0>(p, li, lds); xcd_barrier(bar);
        run_phase<PH_GATE1>(p, li, lds); xcd_barrier(bar);
        run_phase<PH_MERGE1>(p, li, lds); xcd_barrier(bar);
        run_phase<PH_OUT>(p, li, lds); xcd_barrier(bar);
        run_phase<PH_NORM2>(p, li, lds); xcd_barrier(bar);
        run_phase<PH_SCAT>(p, li, lds); xcd_barrier(bar);
        run_phase<PH_MOE1>(p, li, lds); xcd_barrier(bar);
        run_phase<PH_MOE2>(p, li, lds); xcd_barrier(bar);
    }
    run_phase<PH_FINAL>(p, 1, lds);
}
#endif

extern "C" void kernel_launch(void* const* d_in, const int* in_sizes, int n_in, void* d_out, int out_size, void* d_ws, size_t ws_size, hipStream_t stream) {
    if (n_in != 29 || ws_size < WS_END || out_size != ML * D) { fprintf(stderr, "kernel_launch: unexpected shapes (n_in %d, ws %zu need %zu, out %d)\n", n_in, ws_size, (size_t)WS_END, out_size); return; }
    Params p{};
    for (int i = 0; i < 29; ++i) p.in[i] = (const float*)d_in[i];
    p.out = (float*)d_out; p.ws = (unsigned char*)d_ws;
    hipMemsetAsync((char*)d_ws + WS_CTL, 0, 65536, stream);
    const int grid = 256;
#if N_LAUNCH_MODE == 1
    static bool init = false;
#define SETLDS(PH) hipFuncSetAttribute((const void*)k_phase<PH>, hipFuncAttributeMaxDynamicSharedMemorySize, LDS_BYTES)
    if (!init) { SETLDS(PH_PRE); SETLDS(PH_WN1); SETLDS(PH_IN); SETLDS(PH_PREP); SETLDS(PH_MLA); SETLDS(PH_MIX); SETLDS(PH_GATE0); SETLDS(PH_MERGE0); SETLDS(PH_GATE1); SETLDS(PH_MERGE1);
        SETLDS(PH_OUT); SETLDS(PH_NORM2); SETLDS(PH_SCAT); SETLDS(PH_MOE1); SETLDS(PH_MOE2); SETLDS(PH_FINAL); init = true; }
#define LAUNCH(PH, li) hipLaunchKernelGGL(k_phase<PH>, dim3(grid), dim3(512), LDS_BYTES, stream, p, li)
    LAUNCH(PH_PRE, 0);
    for (int li = 0; li < 2; ++li) {
        LAUNCH(PH_WN1, li); LAUNCH(PH_IN, li); LAUNCH(PH_PREP, li); LAUNCH(PH_MLA, li); LAUNCH(PH_MIX, li);
        LAUNCH(PH_GATE0, li); LAUNCH(PH_MERGE0, li); LAUNCH(PH_GATE1, li); LAUNCH(PH_MERGE1, li); LAUNCH(PH_OUT, li);
        LAUNCH(PH_NORM2, li); LAUNCH(PH_SCAT, li); LAUNCH(PH_MOE1, li); LAUNCH(PH_MOE2, li);
    }
    LAUNCH(PH_FINAL, 1);
#else
    static bool init = false;
    if (!init) { hipFuncSetAttribute((const void*)k_mega, hipFuncAttributeMaxDynamicSharedMemorySize, LDS_BYTES); init = true; }
    hipLaunchKernelGGL(k_mega, dim3(grid), dim3(512), LDS_BYTES, stream, p);
#endif
}
```

```cpp
#include <hip/hip_runtime.h>
#include <stdint.h>
#include <stdio.h>

#ifndef N_LAUNCH_MODE
#define N_LAUNCH_MODE 0
#endif

#define LAS __attribute__((address_space(3)))
#define GAS __attribute__((address_space(1)))
typedef LAS unsigned char* ldsp;
typedef unsigned short bf16_t;
typedef short bf16x8 __attribute__((ext_vector_type(8)));
typedef short s16x4 __attribute__((ext_vector_type(4)));
typedef float f32x2 __attribute__((ext_vector_type(2)));
typedef float f32x4 __attribute__((ext_vector_type(4)));
typedef float f32x16 __attribute__((ext_vector_type(16)));
typedef unsigned u32x2 __attribute__((ext_vector_type(2)));
typedef unsigned u32x4 __attribute__((ext_vector_type(4)));
typedef __bf16 bf16x2_t __attribute__((ext_vector_type(2)));
#define DI __device__ __forceinline__

constexpr int D = 1024, NBAT = 8, SEQ = 4096, CTXL = 256;
constexpr int ML = NBAT * SEQ, MC = NBAT * CTXL, MT = ML + MC;
constexpr int NZ = 3072, KEYS = SEQ + CTXL;
constexpr int ZA_Q = 0, ZA_K = 256, ZA_V = 384, ZB_Q = 512, ZB_FF = 768, ZB_FB = 1024, ZB_I = 1280, ZB_G = 1536,
              ZC_Q = 1792, ZC_KV = 2048, ZC_KR = 2176, ZD_Q = 2208, ZD_K = 2464, ZD_V = 2720;
constexpr int ZY = 768;
constexpr int NCHUNK = MT / 64;
constexpr int MOE_MAXROWS = 77824;
constexpr float NORM_EPS = 1e-6f;
constexpr int LDS_BYTES = 155648;
constexpr int HALF_ROWS = MT / 2;

constexpr size_t WS_CTL = 0;
constexpr size_t CTL_CNT = 16384;
constexpr size_t WS_MODV = 65536;
constexpr size_t WS_ROPE16 = 524288;
constexpr size_t WS_ROPE8 = WS_ROPE16 + 8192;
constexpr size_t WS_TAB = WS_ROPE8 + 8192;
constexpr size_t WS_LAM = WS_ROPE8 + 4096;
constexpr size_t WS_TOKI = 1048576;
constexpr size_t WS_ROWI = WS_TOKI + (size_t)MT * 32;
constexpr size_t WS_ROWW = WS_ROWI + (size_t)MOE_MAXROWS * 4;
constexpr size_t WS_HE = WS_ROWW + (size_t)MOE_MAXROWS * 4;
constexpr size_t WS_WT = 4u << 20;
constexpr size_t WT_IN = 0, WT_G = WT_IN + (size_t)NZ * 1024 * 2, WT_B = WT_G + (size_t)4096 * 1024 * 2, WT_O = WT_B + (size_t)4 * 1024 * 256 * 2,
                 WT_MLA = WT_O + (size_t)1024 * 1024 * 2, WT_E1 = WT_MLA + (size_t)1024 * 384 * 2, WT_E2 = WT_E1 + (size_t)32 * 512 * 1024 * 2,
                 WT_END = WT_E2 + (size_t)32 * 1024 * 256 * 2;
constexpr size_t WS_CTXS = WS_WT + WT_END;
constexpr size_t WS_HB = WS_CTXS + (size_t)MC * 1024 * 4;
constexpr size_t WS_Z = WS_HB + (size_t)MT * 1024 * 2;
constexpr size_t WS_X = WS_Z + (size_t)MT * NZ * 2;
constexpr size_t X_QC = 0, X_KC = X_QC + (size_t)MT * 384 * 2, X_CVT = X_KC + (size_t)NBAT * 4 * KEYS * 96 * 2, X_AVT = X_CVT + (size_t)NBAT * 4 * 64 * KEYS * 2,
                 X_DVT = X_AVT + (size_t)NBAT * 2 * 64 * KEYS * 2, X_U = X_DVT + (size_t)NBAT * 4 * 64 * KEYS * 2, X_END_MIX = X_U + (size_t)NCHUNK * 4 * 2 * 4096 * 2;
constexpr size_t X_SIZE = (size_t)HALF_ROWS * 4096 * 2;
static_assert(X_END_MIX <= X_SIZE, "mixer extras must fit the gate region");
constexpr size_t WS_END = WS_X + X_SIZE;
constexpr size_t WS_XG = WS_Z;
constexpr size_t WS_HMID = WS_XG + (size_t)MOE_MAXROWS * 1024 * 2;
constexpr size_t WS_Y = WS_HMID + (size_t)MOE_MAXROWS * 256 * 2;
static_assert(WS_Y + (size_t)2 * MT * 1024 * 2 <= WS_END, "MoE buffers must fit");

struct Params { const float* in[29]; float* out; unsigned char* ws; };
struct Inp { const unsigned long long GAS* tab; DI const float* operator[](int i) const { return (const float*)(const float GAS*)tab[i]; } };
struct Ctx { Inp in; float* out; unsigned char* ws; };
struct CtxRaw { unsigned long long tab, out, ws; };
DI Ctx fresh(CtxRaw c) { asm volatile("" : "+s"(c.tab), "+s"(c.out), "+s"(c.ws)); Ctx q; q.in.tab = (const unsigned long long GAS*)c.tab; q.out = (float*)(float GAS*)c.out; q.ws = (unsigned char*)(unsigned char GAS*)c.ws; return q; }

DI int bid_now() { int t = (int)__builtin_amdgcn_workgroup_id_x(); asm volatile("" : "+s"(t)); return t; }
DI int gdim_now() { int t = (int)__builtin_amdgcn_grid_size_x() / 512; asm volatile("" : "+s"(t)); return t; }
DI int tid_now() { int t = (int)__builtin_amdgcn_workitem_id_x(); asm volatile("" : "+v"(t)); return t; }
DI unsigned pk2(float a, float b) { f32x2 v = {a, b}; bf16x2_t r = __builtin_convertvector(v, bf16x2_t); return __builtin_bit_cast(unsigned, r); }
DI float bflo(unsigned u) { return __uint_as_float(u << 16); }
DI float bfhi(unsigned u) { return __uint_as_float(u & 0xffff0000u); }
DI float bf2f(bf16_t v) { return __uint_as_float((unsigned)v << 16); }
DI bf16_t f2bf(float f) { return (bf16_t)(pk2(f, 0.f) & 0xffffu); }
DI float sigmoidf_(float v) { return __builtin_amdgcn_rcpf(1.f + __expf(-v)); }
DI float wave_sum(float v) { for (int o = 32; o >= 1; o >>= 1) v += __shfl_xor(v, o); return v; }
DI void row_bk(int row, int& b, int& key) { if (row < ML) { b = row >> 12; key = row & 4095; } else { const int r = row - ML; b = r >> 8; key = SEQ + (r & 255); } }
DI int key_row(int b, int key) { return key < SEQ ? b * SEQ + key : ML + b * CTXL + (key - SEQ); }
DI int chunk_row0(int cidx) { return cidx < 512 ? cidx * 64 : ML + (cidx - 512) * 64; }

#define XB_TMO      128
#define XB_XCNT(j)  (256  + 64 * (j))
#define XB_XSUB(j)  (1280 + 64 * (j))
#define XB_XGEN(j)  (2304 + 64 * (j))
#define XB_TOP      3328
#define XB_TOPGEN   3392
#define XCD_BAR_WORDS 3456
#define XB_SPIN_CAP (1u << 22)
DI unsigned xb_ld(unsigned* p)              { return __hip_atomic_load(p, __ATOMIC_RELAXED, __HIP_MEMORY_SCOPE_AGENT); }
DI unsigned xb_add(unsigned* p, unsigned v) { return __hip_atomic_fetch_add(p, v, __ATOMIC_RELAXED, __HIP_MEMORY_SCOPE_AGENT); }
DI unsigned xb_xcc_id() { return (unsigned)__builtin_amdgcn_s_getreg((3 << 11) | 20) & 0xFu; }
#define XB_SPIN(cond, bar) do { unsigned _sp = 0; while (cond) { __builtin_amdgcn_s_sleep(1); \
    if ((++_sp & 255u) == 0u) { if (xb_ld(&(bar)[XB_TMO])) break; if (_sp > XB_SPIN_CAP) { atomicAdd(&(bar)[XB_TMO], 1u); break; } } } } while (0)
struct XcdBarrier { unsigned* bar; unsigned x; volatile LAS unsigned* st; };
DI XcdBarrier xcd_barrier_post(unsigned* bar, volatile LAS unsigned* st) {
    XcdBarrier b; b.bar = bar; b.x = xb_xcc_id(); b.st = st;
    if (tid_now() == 0) (void)xb_add(&bar[XB_XCNT(b.x)], 1u);
    return b;
}
DI void xcd_barrier_complete(unsigned* bar, unsigned x, unsigned& nloc, unsigned& nx) {
    const unsigned G = (unsigned)gdim_now();
    unsigned sum, cnt, mine, sp = 0u;
    for (;;) {
        sum = 0u; cnt = 0u;
#pragma unroll 1
        for (unsigned j = 0; j < 16; ++j) { const unsigned c = xb_ld(&bar[XB_XCNT(j)]); sum += c; cnt += (c > 0u) ? 1u : 0u; }
        if (sum == G) break;
        __builtin_amdgcn_s_sleep(1);
        if ((++sp & 255u) == 0u) { if (xb_ld(&bar[XB_TMO])) break; if (sp > XB_SPIN_CAP) { atomicAdd(&bar[XB_TMO], 1u); break; } }
    }
    mine = xb_ld(&bar[XB_XCNT(x)]);
    nloc = mine > 0u ? mine : 1u; nx = cnt > 0u ? cnt : 1u;
}
DI void xcd_barrier(const XcdBarrier& b) {
    asm volatile("s_waitcnt vmcnt(0)" ::: "memory");
    __syncthreads();
    if (tid_now() == 0) {
        unsigned long long ba = (unsigned long long)b.bar; unsigned bx = b.x; asm volatile("" : "+s"(ba), "+s"(bx));
        unsigned* bar = (unsigned*)(unsigned GAS*)ba;
        __builtin_amdgcn_s_waitcnt(0);
        unsigned nloc = b.st[0], nx = b.st[1];
        if (nloc == 0u) { xcd_barrier_complete(bar, bx, nloc, nx); b.st[0] = nloc; b.st[1] = nx; }
        const unsigned old = xb_add(&bar[XB_XSUB(bx)], 1u);
        const unsigned gen = old / nloc;
        if (old + 1u == (gen + 1u) * nloc) {
            __builtin_amdgcn_fence(__ATOMIC_RELEASE, "agent");
            asm volatile("s_waitcnt vmcnt(0)" ::: "memory");
            const unsigned og = xb_add(&bar[XB_TOP], 1u);
            const unsigned tg = og / nx;
            if (og + 1u == (tg + 1u) * nx) xb_add(&bar[XB_TOPGEN], 1u);
            else XB_SPIN(xb_ld(&bar[XB_TOPGEN]) == tg, bar);
            __builtin_amdgcn_fence(__ATOMIC_ACQUIRE, "agent");
            xb_add(&bar[XB_XGEN(bx)], 1u);
            asm volatile("s_waitcnt vmcnt(0)" ::: "memory");
        } else {
            XB_SPIN(xb_ld(&bar[XB_XGEN(bx)]) == gen, bar);
            __builtin_amdgcn_fence(__ATOMIC_ACQUIRE, "agent");
            asm volatile("s_waitcnt vmcnt(0)" ::: "memory");
        }
    }
    __syncthreads();
}

namespace pg8 {
constexpr int BM = 256, BK = 64, HALF = 128, HTB = HALF * BK * 2, STAGE_BYTES = 8 * HTB, NXCD = 8, WGM = 8;
DI int lds_byte(int r, int c) { const int st = (r >> 4) * 2 + (c >> 5), rr = r & 15, cc = c & 31, ob = rr * 64 + cc * 2; return st * 1024 + (ob ^ (((ob >> 9) & 1) << 5)); }
DI void stage_rc(int b, int& R, int& C) { const int st = b / 1024, sb = b % 1024, swz = sb ^ (((sb >> 9) & 1) << 5); R = (st >> 1) * 16 + swz / 64; C = (st & 1) * 32 + (swz % 64) / 2; }
DI int perm32(int rho) { const int n = rho >> 4, i = rho & 15; return 8 * (i >> 2) + 4 * n + (i & 3); }
struct Unit { int pm, pn, aux; };
DI void tile_of(int L, int nM, int nN, int& pm, int& pn) {
    const int nwg = nM * nN; int wgid = L;
    { const int q = nwg / NXCD, r = nwg % NXCD, xcd = wgid % NXCD, off = wgid / NXCD; wgid = (xcd < r ? xcd * (q + 1) : r * (q + 1) + (xcd - r) * q) + off; }
    const int nig = WGM * nN, gid = wgid / nig, fm = gid * WGM, gsz = (nM - fm) < WGM ? (nM - fm) : WGM;
    pm = fm + ((wgid % nig) % gsz); pn = (wgid % nig) / gsz;
}

template <class Epi, class Sched>
DI void gemm_phase(ldsp lds, const int lda, const int ldb, const int K, const Sched& S, const Epi& E) {
    const int tid = tid_now(), wid = __builtin_amdgcn_readfirstlane(tid >> 6), lane = tid & 63, wr = wid >> 2, wc = wid & 3, fr = lane & 15, fq = lane >> 4;
    const int nt = K / BK;
    unsigned voffA[2], voffB[2];
#pragma unroll
    for (int i = 0; i < 2; ++i) { int R, C; stage_rc(tid * 16 + i * 8192, R, C); const int Rb = Epi::PERM ? ((R & ~31) + perm32(R & 31)) : R;
        voffA[i] = (unsigned)(R * lda + C) * 2u; voffB[i] = (unsigned)(Rb * ldb + C) * 2u; }
    const size_t kstep = (size_t)(BK * 2);
    const size_t hstepA = (size_t)HALF * lda * 2, hstepB = (size_t)HALF * ldb * 2;
    const unsigned ldsw = (unsigned)wid * 1024u;
    const int aoff = lds_byte(wr * 64 + fr, fq * 8), boff = lds_byte(wc * 32 + fr, fq * 8);
#define PG8_SA(b, h) (((b) * 2 + (h)) * HTB)
#define PG8_SB(b, h) ((4 + (b) * 2 + (h)) * HTB)
#define PG8_STAGE(bufoff, gbase, voff) do { _Pragma("unroll") for (int _i = 0; _i < 2; ++_i) \
        __builtin_amdgcn_global_load_lds((const unsigned*)((const char*)(gbase) + (voff)[_i]), (LAS unsigned*)(lds + (bufoff) + ldsw + _i * 8192), 16, 0, 0); } while (0)
#define PG8_LDA(dst, b, h) do { _Pragma("unroll") for (int m = 0; m < 4; ++m) _Pragma("unroll") for (int k = 0; k < 2; ++k) dst[m][k] = *(const LAS bf16x8*)(lds + PG8_SA(b, h) + aoff + m * 2048 + k * 1024); } while (0)
#define PG8_LDB(dst, b, h) do { _Pragma("unroll") for (int n = 0; n < 2; ++n) _Pragma("unroll") for (int k = 0; k < 2; ++k) dst[n][k] = *(const LAS bf16x8*)(lds + PG8_SB(b, h) + boff + n * 2048 + k * 1024); } while (0)
#define PG8_MMA(ai, bj, At, Bt) do { __builtin_amdgcn_s_setprio(1); _Pragma("unroll") for (int m = 0; m < 4; ++m) _Pragma("unroll") for (int n = 0; n < 2; ++n) _Pragma("unroll") for (int k = 0; k < 2; ++k) \
        acc[ai][bj][m][n] = __builtin_amdgcn_mfma_f32_16x16x32_bf16(Bt[n][k], At[m][k], acc[ai][bj][m][n], 0, 0, 0); __builtin_amdgcn_s_setprio(0); } while (0)
#define PG8_WAIT_V(n) asm volatile("s_waitcnt vmcnt(" #n ")" ::: "memory")
#define PG8_WAIT_L(n) asm volatile("s_waitcnt lgkmcnt(" #n ")" ::: "memory")
#define PG8_BAR __builtin_amdgcn_s_barrier()
#define PG8_SCHED __builtin_amdgcn_sched_barrier(0)
    Unit cur, nxt; int ui = 0;
    if (!S.next(0, cur)) return;
    f32x4 acc[2][2][4][2];
#pragma unroll
    for (int a = 0; a < 2; ++a)
#pragma unroll
        for (int b = 0; b < 2; ++b)
#pragma unroll
            for (int m = 0; m < 4; ++m)
#pragma unroll
                for (int n = 0; n < 2; ++n) acc[a][b][m][n] = (f32x4){0.f, 0.f, 0.f, 0.f};
    bf16x8 At[4][2], B0[2][2], B1[2][2];
    const char* cA = S.abase(cur); const char* cB = S.bbase(cur);
    PG8_STAGE(PG8_SB(0, 0), cB, voffB); PG8_STAGE(PG8_SA(0, 0), cA, voffA); PG8_STAGE(PG8_SB(0, 1), cB + hstepB, voffB); PG8_STAGE(PG8_SA(0, 1), cA + hstepA, voffA);
    if (wr == 1) PG8_BAR;
    PG8_WAIT_V(4); PG8_BAR;
    PG8_STAGE(PG8_SB(1, 0), cB + kstep, voffB); PG8_STAGE(PG8_SA(1, 0), cA + kstep, voffA); PG8_STAGE(PG8_SB(1, 1), cB + hstepB + kstep, voffB);
    PG8_WAIT_V(6); PG8_BAR;
    for (;;) {
        const bool has_next = S.next(ui + 1, nxt);
        const char* nA = has_next ? S.abase(nxt) : cA; const char* nB = has_next ? S.bbase(nxt) : cB;
#pragma unroll 1
        for (int t = 0; t < nt; t += 2) {
            const bool last = (t == nt - 2);
            const char* a1 = cA + (size_t)(t + 1) * kstep;
            const char* a2 = last ? nA : cA + (size_t)(t + 2) * kstep; const char* b2 = last ? nB : cB + (size_t)(t + 2) * kstep;
            const char* a3 = a2 + kstep; const char* b3 = b2 + kstep;
            PG8_LDB(B0, 0, 0); PG8_SCHED; PG8_LDA(At, 0, 0); PG8_STAGE(PG8_SA(1, 1), a1 + hstepA, voffA);
            PG8_WAIT_L(8); PG8_BAR; PG8_WAIT_L(0); PG8_MMA(0, 0, At, B0); PG8_BAR; PG8_SCHED;
            PG8_LDB(B1, 0, 1); PG8_STAGE(PG8_SB(0, 0), b2, voffB);
            PG8_BAR; PG8_WAIT_L(0); PG8_MMA(0, 1, At, B1); PG8_BAR;
            PG8_LDA(At, 0, 1); PG8_STAGE(PG8_SA(0, 0), a2, voffA);
            PG8_BAR; PG8_WAIT_L(0); PG8_MMA(1, 0, At, B0); PG8_BAR; PG8_SCHED;
            PG8_STAGE(PG8_SB(0, 1), b2 + hstepB, voffB);
            PG8_WAIT_V(6); PG8_BAR; PG8_MMA(1, 1, At, B1); PG8_BAR;
            PG8_LDB(B0, 1, 0); PG8_SCHED; PG8_LDA(At, 1, 0); PG8_STAGE(PG8_SA(0, 1), a2 + hstepA, voffA);
            PG8_WAIT_L(8); PG8_BAR; PG8_WAIT_L(0); PG8_MMA(0, 0, At, B0); PG8_BAR; PG8_SCHED;
            PG8_LDB(B1, 1, 1); PG8_STAGE(PG8_SB(1, 0), b3, voffB);
            PG8_BAR; PG8_WAIT_L(0); PG8_MMA(0, 1, At, B1); PG8_BAR;
            PG8_LDA(At, 1, 1); PG8_STAGE(PG8_SA(1, 0), a3, voffA);
            PG8_BAR; PG8_WAIT_L(0); PG8_MMA(1, 0, At, B0); PG8_BAR; PG8_SCHED;
            PG8_STAGE(PG8_SB(1, 1), b3 + hstepB, voffB);
            PG8_WAIT_V(6); PG8_BAR; PG8_MMA(1, 1, At, B1); PG8_BAR;
        }
        { int fr2 = fr, fq2 = fq; asm volatile("" : "+v"(fr2), "+v"(fq2));
          E(acc, cur, wr, wc, fr2, fq2); }
        if (!has_next) break;
#pragma unroll
        for (int a = 0; a < 2; ++a)
#pragma unroll
            for (int b = 0; b < 2; ++b)
#pragma unroll
                for (int m = 0; m < 4; ++m)
#pragma unroll
                    for (int n = 0; n < 2; ++n) acc[a][b][m][n] = (f32x4){0.f, 0.f, 0.f, 0.f};
        cur = nxt; cA = nA; cB = nB; ++ui;
    }
    PG8_WAIT_V(0);
    if (wr == 0) PG8_BAR;
    PG8_BAR;
#undef PG8_SA
#undef PG8_SB
#undef PG8_STAGE
#undef PG8_LDA
#undef PG8_LDB
#undef PG8_MMA
#undef PG8_WAIT_V
#undef PG8_WAIT_L
#undef PG8_BAR
#undef PG8_SCHED
}

struct SchedPlain {
    const char* A; const char* B; int lda, ldb, nM, nN, G, c, pm0;
    DI bool next(int i, Unit& u) const { const long L = (long)i * G + c; if (L >= (long)nM * nN) return false; tile_of((int)L, nM, nN, u.pm, u.pn); u.pm += pm0; u.aux = 0; return true; }
    DI const char* abase(const Unit& u) const { return A + (size_t)u.pm * 256 * lda * 2; }
    DI const char* bbase(const Unit& u) const { return B + (size_t)u.pn * 256 * ldb * 2; }
};
struct SchedMerge {
    const char* Z; const char* Wb; int nM, G, c, pm0;
    DI bool next(int i, Unit& u) const { const long L = (long)(i >> 2) * G + c; if (L >= (long)nM * 4) return false; tile_of((int)L, nM, 4, u.pm, u.pn); u.pm += pm0; u.aux = i & 3; return true; }
    DI const char* abase(const Unit& u) const { const int co = u.aux == 0 ? ZA_Q : (u.aux == 1 ? ZB_Q : (u.aux == 2 ? ZC_Q : ZD_Q)); return Z + ((size_t)u.pm * 256 * NZ + co) * 2; }
    DI const char* bbase(const Unit& u) const { return Wb + ((size_t)u.aux * 1024 * 256 + (size_t)u.pn * 256 * 256) * 2; }
};
struct SchedMoe {
    const char* A; const char* B; int lda, ldb, nP, nN, G, c; size_t estride; const LAS unsigned char* pe;
    DI bool next(int i, Unit& u) const { const long L = (long)i * G + c; if (L >= (long)nP * nN) return false; u.pm = (int)(L / nN); u.pn = (int)(L % nN); u.aux = pe[u.pm]; return true; }
    DI const char* abase(const Unit& u) const { return A + (size_t)u.pm * 256 * lda * 2; }
    DI const char* bbase(const Unit& u) const { return B + (size_t)u.aux * estride + (size_t)u.pn * 256 * ldb * 2; }
};

#define EPI_ARGS const f32x4 (&acc)[2][2][4][2], const Unit& u, int wr, int wc, int fr, int fq
struct EpiZ { static constexpr bool PERM = true; bf16_t* Z;
    DI void operator()(EPI_ARGS) const {
        const int row0 = u.pm * 256 + wr * 64 + fr, col0 = u.pn * 256 + wc * 32 + 8 * fq;
#pragma unroll
        for (int ai = 0; ai < 2; ++ai)
#pragma unroll
            for (int m = 0; m < 4; ++m) { bf16_t* rp = Z + (size_t)(row0 + ai * 128 + m * 16) * NZ + col0;
#pragma unroll
                for (int bj = 0; bj < 2; ++bj) { const f32x4 v0 = acc[ai][bj][m][0], v1 = acc[ai][bj][m][1];
                    u32x4 w; w.x = pk2(v0[0], v0[1]); w.y = pk2(v0[2], v0[3]); w.z = pk2(v1[0], v1[1]); w.w = pk2(v1[2], v1[3]);
                    *(u32x4*)(rp + bj * 128) = w; } }
    } };
struct EpiMla { static constexpr bool PERM = true; bf16_t* QC; bf16_t* KC; bf16_t* CVt;
    DI void operator()(const f32x4 (&acc)[2][2][4][2], const Unit& u, int wr, int wc, int fr_in, int fq_in) const {
        int fr = fr_in, fq = fq_in; asm volatile("" : "+v"(fr), "+v"(fq));
#pragma unroll
        for (int ai = 0; ai < 2; ++ai)
#pragma unroll
            for (int m = 0; m < 4; ++m) {
                const int row = u.pm * 256 + wr * 64 + fr + ai * 128 + m * 16; int b, key; row_bk(row, b, key);
#pragma unroll
                for (int bj = 0; bj < 2; ++bj) {
                    const int c = u.pn * 256 + bj * 128 + wc * 32 + 8 * fq;
                    const f32x4 v0 = acc[ai][bj][m][0], v1 = acc[ai][bj][m][1];
                    float v[8] = {v0[0], v0[1], v0[2], v0[3], v1[0], v1[1], v1[2], v1[3]};
                    if (c < 384) {
                        u32x4 w; w.x = pk2(v[0], v[1]); w.y = pk2(v[2], v[3]); w.z = pk2(v[4], v[5]); w.w = pk2(v[6], v[7]);
                        *(u32x4*)(QC + (size_t)row * 384 + c) = w;
                    } else if (c < 896) {
                        const int c2 = c - 384, hh = c2 >> 7, j = c2 & 127;
                        if (j < 64) { u32x4 w; w.x = pk2(v[0], v[1]); w.y = pk2(v[2], v[3]); w.z = pk2(v[4], v[5]); w.w = pk2(v[6], v[7]);
                            *(u32x4*)(KC + ((size_t)(b * 4 + hh) * KEYS + key) * 96 + j) = w; }
                        else { bf16_t* vp = CVt + ((size_t)(b * 4 + hh) * 64 + (j - 64)) * KEYS + key;
#pragma unroll
                            for (int i = 0; i < 8; ++i) vp[(size_t)i * KEYS] = f2bf(v[i]); }
                    }
                }
                __builtin_amdgcn_sched_barrier(0);
            }
    } };
struct EpiGate { static constexpr bool PERM = true; bf16_t* G; int row_base;
    DI void operator()(EPI_ARGS) const {
        const int row0 = u.pm * 256 + wr * 64 + fr - row_base, col0 = u.pn * 256 + wc * 32 + 8 * fq;
#pragma unroll
        for (int ai = 0; ai < 2; ++ai)
#pragma unroll
            for (int m = 0; m < 4; ++m) { bf16_t* rp = G + (size_t)(row0 + ai * 128 + m * 16) * 4096 + col0;
#pragma unroll
                for (int bj = 0; bj < 2; ++bj) { const f32x4 v0 = acc[ai][bj][m][0], v1 = acc[ai][bj][m][1];
                    u32x4 w; w.x = pk2(sigmoidf_(v0[0]), sigmoidf_(v0[1])); w.y = pk2(sigmoidf_(v0[2]), sigmoidf_(v0[3]));
                    w.z = pk2(sigmoidf_(v1[0]), sigmoidf_(v1[1])); w.w = pk2(sigmoidf_(v1[2]), sigmoidf_(v1[3]));
                    *(u32x4*)(rp + bj * 128) = w; } }
    } };
struct EpiMerge { static constexpr bool PERM = true; bf16_t* Z; const bf16_t* G; int row_base;
    DI void operator()(EPI_ARGS) const {
        const int row0 = u.pm * 256 + wr * 64 + fr, col0 = u.pn * 256 + wc * 32 + 8 * fq;
#pragma unroll
        for (int ai = 0; ai < 2; ++ai)
#pragma unroll
            for (int m = 0; m < 4; ++m) { const int row = row0 + ai * 128 + m * 16;
                bf16_t* yp = Z + (size_t)row * NZ + ZY + col0; const bf16_t* gp = G + (size_t)(row - row_base) * 4096 + u.aux * 1024 + col0;
#pragma unroll
                for (int bj = 0; bj < 2; ++bj) { const f32x4 v0 = acc[ai][bj][m][0], v1 = acc[ai][bj][m][1];
                    const u32x4 g = *(const u32x4*)(gp + bj * 128);
                    u32x4 y = (u32x4){0u, 0u, 0u, 0u}; if (u.aux != 0) y = *(const u32x4*)(yp + bj * 128);
                    u32x4 w;
                    w.x = pk2(bflo(y.x) + bflo(g.x) * v0[0], bfhi(y.x) + bfhi(g.x) * v0[1]); w.y = pk2(bflo(y.y) + bflo(g.y) * v0[2], bfhi(y.y) + bfhi(g.y) * v0[3]);
                    w.z = pk2(bflo(y.z) + bflo(g.z) * v1[0], bfhi(y.z) + bfhi(g.z) * v1[1]); w.w = pk2(bflo(y.w) + bflo(g.w) * v1[2], bfhi(y.w) + bfhi(g.w) * v1[3]);
                    *(u32x4*)(yp + bj * 128) = w; } }
    } };
struct EpiOut { static constexpr bool PERM = false; const float* res_l; const float* res_c; float* xs_l; float* xs_c; const float* modv_l;
    DI void operator()(EPI_ARGS) const {
        const int row0 = u.pm * 256 + wr * 64 + fr, col0 = u.pn * 256 + wc * 32 + 4 * fq;
#pragma unroll
        for (int ai = 0; ai < 2; ++ai)
#pragma unroll
            for (int m = 0; m < 4; ++m) { const int row = row0 + ai * 128 + m * 16; const bool lat = row < ML; const int bsel = lat ? (row >> 12) : 8;
                const size_t ro = lat ? (size_t)row * 1024 : (size_t)(row - ML) * 1024;
                const float* rp = (lat ? res_l : res_c) + ro + col0; float* xp = (lat ? xs_l : xs_c) + ro + col0; const float* gp = modv_l + (bsel * 6 + 2) * 1024 + col0;
#pragma unroll
                for (int bj = 0; bj < 2; ++bj)
#pragma unroll
                    for (int n = 0; n < 2; ++n) { const int o = bj * 128 + n * 16; const f32x4 r = *(const f32x4*)(rp + o), g = *(const f32x4*)(gp + o);
                        *(f32x4*)(xp + o) = r + g * acc[ai][bj][m][n]; } }
    } };
struct EpiMoeUp { static constexpr bool PERM = true; bf16_t* H;
    DI void operator()(EPI_ARGS) const {
        const int row0 = u.pm * 256 + wr * 64 + fr, h0 = (u.pn * 256 + wc * 32 + 8 * fq) >> 1;
#pragma unroll
        for (int ai = 0; ai < 2; ++ai)
#pragma unroll
            for (int m = 0; m < 4; ++m) { bf16_t* hp = H + (size_t)(row0 + ai * 128 + m * 16) * 256 + h0;
#pragma unroll
                for (int bj = 0; bj < 2; ++bj) { const f32x4 g = acc[ai][bj][m][0], up = acc[ai][bj][m][1];
                    u32x2 w; w.x = pk2(g[0] * sigmoidf_(g[0]) * up[0], g[1] * sigmoidf_(g[1]) * up[1]); w.y = pk2(g[2] * sigmoidf_(g[2]) * up[2], g[3] * sigmoidf_(g[3]) * up[3]);
                    *(u32x2*)(hp + bj * 64) = w; } }
    } };
struct EpiMoeDown { static constexpr bool PERM = true; bf16_t* Y; const int* rowi; const float* roww;
    DI void operator()(EPI_ARGS) const {
        const int row0 = u.pm * 256 + wr * 64 + fr, col0 = u.pn * 256 + wc * 32 + 8 * fq;
#pragma unroll
        for (int ai = 0; ai < 2; ++ai)
#pragma unroll
            for (int m = 0; m < 4; ++m) { const int row = row0 + ai * 128 + m * 16; const int ri = rowi[row];
                if (ri >= 0) { const float w8 = roww[row]; bf16_t* yp = Y + ((size_t)(ri & 1) * MT + (ri >> 1)) * 1024 + col0;
#pragma unroll
                    for (int bj = 0; bj < 2; ++bj) { const f32x4 v0 = acc[ai][bj][m][0] * w8, v1 = acc[ai][bj][m][1] * w8;
                        u32x4 w; w.x = pk2(v0[0], v0[1]); w.y = pk2(v0[2], v0[3]); w.z = pk2(v1[0], v1[1]); w.w = pk2(v1[2], v1[3]);
                        *(u32x4*)(yp + bj * 128) = w; } } }
    } };
}

DI void phase_pre(const Params& p, ldsp lds) {
    float* modv = (float*)(p.ws + WS_MODV);
    LAS float* sc = (LAS float*)lds;
    LAS float* red = (LAS float*)(lds + 9 * 1024 * 4);
    const int tid = tid_now();
    for (int i = tid; i < 9 * 1024; i += 512) { const int r = i >> 10, k = i & 1023; const float v = r < 8 ? p.in[1][r * 1024 + k] : p.in[3][k]; sc[i] = v / (1.f + __expf(-v)); }
    __syncthreads();
    const int kg = tid >> 6, col = tid & 63;
    for (int u = bid_now(); u < 192; u += gdim_now()) {
        const int li = u / 96, j = (u % 96) * 64 + col;
        const float* w = p.in[4] + (size_t)li * 1024 * 6144 + j;
        float acc[9];
#pragma unroll
        for (int r = 0; r < 9; ++r) acc[r] = 0.f;
        for (int k = kg * 128; k < kg * 128 + 128; ++k) { const float wv = w[(size_t)k * 6144];
#pragma unroll
            for (int r = 0; r < 9; ++r) acc[r] += sc[r * 1024 + k] * wv; }
#pragma unroll
        for (int r = 0; r < 9; ++r) red[(kg * 9 + r) * 64 + col] = acc[r];
        __syncthreads();
        if (tid < 64) {
#pragma unroll
            for (int r = 0; r < 9; ++r) { float s = 0.f;
#pragma unroll
                for (int g = 0; g < 8; ++g) s += red[(g * 9 + r) * 64 + col];
                modv[(li * 9 + r) * 6144 + j] = s + p.in[5][li * 6144 + j]; } }
        __syncthreads();
    }
    if (bid_now() == gdim_now() - 1) {
        f32x2* cs16 = (f32x2*)(p.ws + WS_ROPE16); f32x2* cs8 = (f32x2*)(p.ws + WS_ROPE8);
        for (int i = tid; i < 64 * 16 + 64 * 8; i += 512) {
            const bool a = i < 1024; const int ii = a ? i : i - 1024; const int pos = a ? ii >> 4 : ii >> 3, f = a ? ii & 15 : ii & 7;
            const float inv = exp2f(-(float)f * (13.287712379549449f / (a ? 16.f : 8.f)));
            const float x = (float)pos * inv; const float n = rintf(x * 0.15915494309189535f);
            float r = fmaf(-n, 6.2831855f, x); r = fmaf(-n, -1.7484555e-7f, r);
            const f32x2 cs = {__cosf(r), __sinf(r)};
            if (a) cs16[ii] = cs; else cs8[ii] = cs;
        }
        if (tid == 64) { const float** tab = (const float**)(p.ws + WS_TAB);
#pragma unroll
            for (int i = 0; i < 29; ++i) tab[i] = p.in[i]; }
        if (tid < 2) { const float* lp = p.in[19] + tid * 128; float s1 = 0.f, s2 = 0.f;
            for (int i = 0; i < 32; ++i) { s1 += lp[i] * lp[32 + i]; s2 += lp[64 + i] * lp[96 + i]; }
            const float lam_init = 0.8f - 0.6f * expf(-0.3f * (float)tid);
            float* lamv = (float*)(p.ws + WS_LAM); lamv[tid * 2] = expf(s1) - expf(s2) + lam_init; lamv[tid * 2 + 1] = lam_init; }
    }
}

template <class F, class DM> DI void conv_t(bf16_t* Wt, const int N, const int K, F src, DM dmap, const long gtid, const long gstride) {
    const long items = (long)N * (K / 8);
    for (long it = gtid; it < items; it += gstride) {
        const int n = (int)(it % N), k0 = (int)(it / N) * 8; int ld = 0; const float* s = src(n, k0, ld);
        float v[8];
#pragma unroll
        for (int j = 0; j < 8; ++j) v[j] = s ? s[(size_t)j * ld] : 0.f;
        u32x4 w; w.x = pk2(v[0], v[1]); w.y = pk2(v[2], v[3]); w.z = pk2(v[4], v[5]); w.w = pk2(v[6], v[7]);
        *(u32x4*)(Wt + (size_t)dmap(n) * K + k0) = w;
    }
}
DI void phase_wconv(const Ctx& p, const int li) {
    unsigned char* wt = p.ws + WS_WT;
    const long gtid = (long)bid_now() * 512 + tid_now(), gs = (long)gdim_now() * 512;
    { const float* W = p.in[8] + (size_t)li * 1024 * 2976;
      conv_t((bf16_t*)(wt + WT_IN), NZ, 1024, [=](int n, int k0, int& ld) -> const float* { ld = 2976; return n < 2976 ? W + (size_t)k0 * 2976 + n : nullptr; }, [](int n) { return n; }, gtid, gs); }
    { const float* W = p.in[9] + (size_t)li * 1024 * 4096;
      conv_t((bf16_t*)(wt + WT_G), 4096, 1024, [=](int n, int k0, int& ld) -> const float* { ld = 4096; return W + (size_t)k0 * 4096 + n; }, [](int n) { return n; }, gtid, gs); }
    { const float* W = p.in[10] + (size_t)li * 4 * 256 * 1024;
      conv_t((bf16_t*)(wt + WT_B), 4096, 256, [=](int n, int k0, int& ld) -> const float* { ld = 1024; return W + (size_t)(n >> 10) * 256 * 1024 + (size_t)k0 * 1024 + (n & 1023); }, [](int n) { return n; }, gtid, gs); }
    { const float* W = p.in[11] + (size_t)li * 1024 * 1024;
      conv_t((bf16_t*)(wt + WT_O), 1024, 1024, [=](int n, int k0, int& ld) -> const float* { ld = 1024; return W + (size_t)k0 * 1024 + n; }, [](int n) { return n; }, gtid, gs); }
    { const float* Wq = p.in[17] + (size_t)li * 256 * 384; const float* Wkv = p.in[18] + (size_t)li * 128 * 512;
      conv_t((bf16_t*)(wt + WT_MLA), 1024, 384, [=](int n, int k0, int& ld) -> const float* {
          if (n < 384) { ld = 384; return k0 < 256 ? Wq + (size_t)k0 * 384 + n : nullptr; }
          if (n < 896) { ld = 512; return k0 >= 256 ? Wkv + (size_t)(k0 - 256) * 512 + (n - 384) : nullptr; }
          ld = 0; return nullptr; }, [](int n) { return n; }, gtid, gs); }
    { const float* Wg = p.in[25] + (size_t)li * 32 * 1024 * 256; const float* Wu = p.in[26] + (size_t)li * 32 * 1024 * 256;
      conv_t((bf16_t*)(wt + WT_E1), 32 * 256, 1024, [=](int n, int k0, int& ld) -> const float* { ld = 256; return Wg + (size_t)(n >> 8) * 1024 * 256 + (size_t)k0 * 256 + (n & 255); },
             [](int n) { const int e = n >> 8, hc = n & 255; return e * 512 + (hc >> 2) * 8 + (hc & 3); }, gtid, gs);
      conv_t((bf16_t*)(wt + WT_E1), 32 * 256, 1024, [=](int n, int k0, int& ld) -> const float* { ld = 256; return Wu + (size_t)(n >> 8) * 1024 * 256 + (size_t)k0 * 256 + (n & 255); },
             [](int n) { const int e = n >> 8, hc = n & 255; return e * 512 + (hc >> 2) * 8 + 4 + (hc & 3); }, gtid, gs); }
    { const float* W = p.in[27] + (size_t)li * 32 * 256 * 1024;
      conv_t((bf16_t*)(wt + WT_E2), 32 * 1024, 256, [=](int n, int k0, int& ld) -> const float* { ld = 1024; return W + (size_t)(n >> 10) * 256 * 1024 + (size_t)k0 * 1024 + (n & 1023); }, [](int n) { return n; }, gtid, gs); }
}

template <int MODE> DI void phase_norm(const Ctx& p, const int li) {
    const int lane = tid_now() & 63, wave = tid_now() >> 6;
    const int nrows = MODE == 2 ? ML : MT;
    const float* modv = (const float*)(p.ws + WS_MODV);
    float* ctxs = (float*)(p.ws + WS_CTXS); bf16_t* HB = (bf16_t*)(p.ws + WS_HB); const bf16_t* Y = (const bf16_t*)(p.ws + WS_Y);
    const bool combine = (MODE == 2) || (li > 0);
    const int lprev = MODE == 2 ? 1 : li - 1;
    const float* gain = MODE == 2 ? p.in[28] : p.in[6] + li * 1024;
    for (int row = bid_now() * 8 + wave; row < nrows; row += gdim_now() * 8) {
        const bool lat = row < ML; const int bsel = lat ? (row >> 12) : 8;
        float* xs = lat ? p.out + (size_t)row * 1024 : ctxs + (size_t)(row - ML) * 1024;
        const float* src = combine ? xs : (lat ? p.in[0] + (size_t)row * 1024 : p.in[2] + (size_t)(row - ML) * 1024);
        f32x4 v[4];
#pragma unroll
        for (int i = 0; i < 4; ++i) v[i] = *(const f32x4*)(src + i * 256 + lane * 4);
        if (combine) {
            const float* g2 = modv + ((lprev * 9 + bsel) * 6 + 5) * 1024;
#pragma unroll
            for (int i = 0; i < 4; ++i) { const int col = i * 256 + lane * 4;
                const u32x2 y0 = *(const u32x2*)(Y + (size_t)row * 1024 + col), y1 = *(const u32x2*)(Y + ((size_t)MT + row) * 1024 + col);
                const f32x4 g = *(const f32x4*)(g2 + col);
                v[i][0] += g[0] * (bflo(y0.x) + bflo(y1.x)); v[i][1] += g[1] * (bfhi(y0.x) + bfhi(y1.x));
                v[i][2] += g[2] * (bflo(y0.y) + bflo(y1.y)); v[i][3] += g[3] * (bfhi(y0.y) + bfhi(y1.y));
                if (MODE == 0) *(f32x4*)(xs + col) = v[i]; }
        }
        float ss = 0.f;
#pragma unroll
        for (int i = 0; i < 4; ++i) ss += v[i][0] * v[i][0] + v[i][1] * v[i][1] + v[i][2] * v[i][2] + v[i][3] * v[i][3];
        ss = wave_sum(ss);
        const float rstd = rsqrtf(ss * (1.f / 1024.f) + NORM_EPS);
        if (MODE == 2) {
#pragma unroll
            for (int i = 0; i < 4; ++i) { const int col = i * 256 + lane * 4; const f32x4 g = *(const f32x4*)(gain + col); *(f32x4*)(xs + col) = v[i] * rstd * g; }
        } else {
            const float* sh = modv + ((li * 9 + bsel) * 6 + 0) * 1024; const float* scl = modv + ((li * 9 + bsel) * 6 + 1) * 1024;
#pragma unroll
            for (int i = 0; i < 4; ++i) { const int col = i * 256 + lane * 4; const f32x4 g = *(const f32x4*)(gain + col), s1 = *(const f32x4*)(scl + col), s0 = *(const f32x4*)(sh + col);
                const f32x4 h = v[i] * rstd * g * (s1 + 1.f) + s0;
                u32x2 w; w.x = pk2(h[0], h[1]); w.y = pk2(h[2], h[3]); *(u32x2*)(HB + (size_t)row * 1024 + col) = w; }
        }
    }
}

DI void phase_norm2(const Ctx& p, const int li, ldsp lds) {
    const int tid = tid_now(), lane = tid & 63, wave = tid >> 6;
    const int nrows = li == 0 ? MT : ML;
    const float* modv = (const float*)(p.ws + WS_MODV);
    const float* ctxs = (const float*)(p.ws + WS_CTXS); bf16_t* HB = (bf16_t*)(p.ws + WS_HB);
    unsigned* cnt = (unsigned*)(p.ws + WS_CTL + CTL_CNT) + li * 32;
    int4* toki = (int4*)(p.ws + WS_TOKI); int* rowi = (int*)(p.ws + WS_ROWI);
    LAS float* rw = (LAS float*)lds;
    const float* wrg = p.in[21] + (size_t)li * 1024 * 4; const float* wre = p.in[23] + (size_t)li * 1024 * 32;
    for (int i = tid; i < 36 * 1024; i += 512) { const int e = i >> 10, k = i & 1023; rw[i] = e < 4 ? wrg[k * 4 + e] : wre[k * 32 + (e - 4)]; }
    for (long i = (long)bid_now() * 512 + tid; i < MOE_MAXROWS; i += (long)gdim_now() * 512) rowi[i] = -1;
    __syncthreads();
    const float* gain = p.in[7] + li * 1024; const float* brg = p.in[22] + li * 4; const float* bre = p.in[24] + li * 32;
    for (int row = bid_now() * 8 + wave; row < nrows; row += gdim_now() * 8) {
        const bool lat = row < ML; const int bsel = lat ? (row >> 12) : 8;
        const float* xs = lat ? p.out + (size_t)row * 1024 : ctxs + (size_t)(row - ML) * 1024;
        f32x4 v[4];
#pragma unroll
        for (int i = 0; i < 4; ++i) v[i] = *(const f32x4*)(xs + i * 256 + lane * 4);
        float ss = 0.f;
#pragma unroll
        for (int i = 0; i < 4; ++i) ss += v[i][0] * v[i][0] + v[i][1] * v[i][1] + v[i][2] * v[i][2] + v[i][3] * v[i][3];
        ss = wave_sum(ss);
        const float rstd = rsqrtf(ss * (1.f / 1024.f) + NORM_EPS);
        const float* sh = modv + ((li * 9 + bsel) * 6 + 3) * 1024; const float* scl = modv + ((li * 9 + bsel) * 6 + 4) * 1024;
#pragma unroll
        for (int i = 0; i < 4; ++i) { const int col = i * 256 + lane * 4; const f32x4 g = *(const f32x4*)(gain + col), s1 = *(const f32x4*)(scl + col), s0 = *(const f32x4*)(sh + col);
            v[i] = v[i] * rstd * g * (s1 + 1.f) + s0;
            u32x2 w; w.x = pk2(v[i][0], v[i][1]); w.y = pk2(v[i][2], v[i][3]); *(u32x2*)(HB + (size_t)row * 1024 + col) = w; }
        float lg[4];
#pragma unroll
        for (int e = 0; e < 4; ++e) { float s = 0.f;
#pragma unroll
            for (int i = 0; i < 4; ++i) { const f32x4 w = *(const LAS f32x4*)(rw + e * 1024 + i * 256 + lane * 4); s += v[i][0] * w[0] + v[i][1] * w[1] + v[i][2] * w[2] + v[i][3] * w[3]; }
            lg[e] = wave_sum(s) + brg[e]; }
        int gi = 0; float gm = lg[0];
#pragma unroll
        for (int g = 1; g < 4; ++g) { if (lg[g] > gm) { gm = lg[g]; gi = g; } }
        gi = __builtin_amdgcn_readfirstlane(gi);
        float gden = 0.f;
#pragma unroll
        for (int g = 0; g < 4; ++g) gden += __expf(lg[g] - gm);
        const float gval = 1.f / gden;
        float el[8];
#pragma unroll
        for (int j = 0; j < 8; ++j) { float s = 0.f; const LAS float* wp = rw + (4 + gi * 8 + j) * 1024 + lane * 4;
#pragma unroll
            for (int i = 0; i < 4; ++i) { const f32x4 w = *(const LAS f32x4*)(wp + i * 256); s += v[i][0] * w[0] + v[i][1] * w[1] + v[i][2] * w[2] + v[i][3] * w[3]; }
            el[j] = wave_sum(s) + bre[gi * 8 + j]; }
        int i1 = 0; float m1 = el[0];
#pragma unroll
        for (int j = 1; j < 8; ++j) if (el[j] > m1) { m1 = el[j]; i1 = j; }
        int i2 = -1; float m2 = -3.0e38f;
#pragma unroll
        for (int j = 0; j < 8; ++j) if (j != i1 && el[j] > m2) { m2 = el[j]; i2 = j; }
        const float t = __expf(m2 - m1); const float w1 = gval / (1.f + t), w2 = gval * t / (1.f + t);
        if (lane == 0) {
            const int e1 = gi * 8 + i1, e2 = gi * 8 + i2;
            const unsigned p1 = atomicAdd(&cnt[e1], 1u), p2 = atomicAdd(&cnt[e2], 1u);
            toki[(size_t)row * 2 + 0] = make_int4(e1, (int)p1, __float_as_int(w1), 0);
            toki[(size_t)row * 2 + 1] = make_int4(e2, (int)p2, __float_as_int(w2), 0);
        }
    }
}

DI int moe_offsets(const unsigned* cnt, LAS unsigned* off, LAS unsigned char* pe) {
    if (tid_now() == 0) { unsigned o = 0;
#pragma unroll 1
        for (int e = 0; e < 32; ++e) { const unsigned c = __hip_atomic_load(cnt + e, __ATOMIC_RELAXED, __HIP_MEMORY_SCOPE_AGENT); const unsigned np = (c + 255u) >> 8; off[e] = o;
#pragma unroll 1
            for (unsigned q = 0; q < np; ++q) pe[(o >> 8) + q] = (unsigned char)e;
            o += np << 8; } off[32] = o; }
    __syncthreads();
    return (int)(off[32] >> 8);
}
DI void phase_scatter(const Ctx& p, const int li, ldsp lds) {
    const int lane = tid_now() & 63, wave = tid_now() >> 6;
    const int ntok = li == 0 ? MT : ML;
    LAS unsigned* off = (LAS unsigned*)(lds + 1024); LAS unsigned char* pe = (LAS unsigned char*)lds;
    moe_offsets((const unsigned*)(p.ws + WS_CTL + CTL_CNT) + li * 32, off, pe);
    const int4* toki = (const int4*)(p.ws + WS_TOKI); int* rowi = (int*)(p.ws + WS_ROWI); float* roww = (float*)(p.ws + WS_ROWW);
    const bf16_t* HB = (const bf16_t*)(p.ws + WS_HB); bf16_t* XG = (bf16_t*)(p.ws + WS_XG);
    for (int it = bid_now() * 8 + wave; it < ntok * 2; it += gdim_now() * 8) {
        const int4 ti = toki[it]; const int row = (int)off[ti.x] + ti.y;
        const u32x4* s = (const u32x4*)(HB + (size_t)(it >> 1) * 1024); u32x4* d = (u32x4*)(XG + (size_t)row * 1024);
        d[lane] = s[lane]; d[lane + 64] = s[lane + 64];
        if (lane == 0) { rowi[row] = it; roww[row] = __int_as_float(ti.z); }
    }
}

DI void hgrn_load(const bf16_t* Z, const float* lbl, const int li, const int row0, const int h, const int tid,
                  LAS float* AF, LAS float* AB, LAS float* KF, LAS float* KB, LAS float* V, LAS float* Q) {
    const int t = tid >> 3, d0 = (tid & 7) * 8; const bf16_t* zr = Z + (size_t)(row0 + t) * NZ + h * 64 + d0;
    const u32x4 zf = *(const u32x4*)(zr + ZB_FF), zb = *(const u32x4*)(zr + ZB_FB), zi = *(const u32x4*)(zr + ZB_I);
    const unsigned zfu[4] = {zf.x, zf.y, zf.z, zf.w}, zbu[4] = {zb.x, zb.y, zb.z, zb.w}, ziu[4] = {zi.x, zi.y, zi.z, zi.w};
    u32x4 zq = (u32x4){0u, 0u, 0u, 0u}; if (Q) zq = *(const u32x4*)(zr + ZB_Q);
    const unsigned zqu[4] = {zq.x, zq.y, zq.z, zq.w};
#pragma unroll
    for (int j = 0; j < 8; ++j) {
        const int d = d0 + j, hd = h * 64 + d;
        float lbf = 0.f, lbb = 0.f;
        if (li > 0) { lbf = sigmoidf_(lbl[(1 * 2 + 0) * 256 + hd] - lbl[(0 * 2 + 0) * 256 + hd]); lbb = sigmoidf_(lbl[(1 * 2 + 1) * 256 + hd] - lbl[(0 * 2 + 1) * 256 + hd]); }
        const float xf = (j & 1) ? bfhi(zfu[j >> 1]) : bflo(zfu[j >> 1]), xb = (j & 1) ? bfhi(zbu[j >> 1]) : bflo(zbu[j >> 1]);
        const float sf = sigmoidf_(xf), sb = sigmoidf_(xb);
        AF[t * 65 + d] = __logf(fmaxf(lbf + (1.f - lbf) * sf, 1e-30f)); KF[t * 65 + d] = (1.f - lbf) * (1.f - sf);
        AB[t * 65 + d] = __logf(fmaxf(lbb + (1.f - lbb) * sb, 1e-30f)); KB[t * 65 + d] = (1.f - lbb) * (1.f - sb);
        V[t * 65 + d] = (j & 1) ? bfhi(ziu[j >> 1]) : bflo(ziu[j >> 1]);
        if (Q) Q[t * 65 + d] = (j & 1) ? bfhi(zqu[j >> 1]) : bflo(zqu[j >> 1]);
    }
}
DI void hgrn_cumsum(const int tid, LAS float* AF, LAS float* AB) {
    if (tid < 64) { float s = 0.f; for (int t = 0; t < 64; ++t) { s += AF[t * 65 + tid]; AF[t * 65 + tid] = s; } }
    else if (tid < 128) { const int d = tid - 64; float s = 0.f; for (int t = 63; t >= 0; --t) { s += AB[t * 65 + d]; AB[t * 65 + d] = s; } }
}

DI void phase_prep(const Ctx& p, const int li, ldsp lds) {
    const int tid = tid_now();
    bf16_t* Z = (bf16_t*)(p.ws + WS_Z);
    const f32x2* cs16 = (const f32x2*)(p.ws + WS_ROPE16); const f32x2* cs8 = (const f32x2*)(p.ws + WS_ROPE8);
    bf16_t* KC = (bf16_t*)(p.ws + WS_X + X_KC); bf16_t* AVt = (bf16_t*)(p.ws + WS_X + X_AVT); bf16_t* DVt = (bf16_t*)(p.ws + WS_X + X_DVT);
    bf16_t* U = (bf16_t*)(p.ws + WS_X + X_U); float* HE = (float*)(p.ws + WS_HE);
    const float* qn = p.in[15] + li * 256; const float* kvn = p.in[16] + li * 128; const float* lbl = p.in[13];
    LAS float* AF = (LAS float*)lds; LAS float* AB = AF + 64 * 65; LAS float* KF = AB + 64 * 65; LAS float* KB = KF + 64 * 65; LAS float* V = KB + 64 * 65;
    LAS bf16_t* TT = (LAS bf16_t*)(lds + 5 * 64 * 65 * 4);
    for (int cidx = bid_now(); cidx < NCHUNK; cidx += gdim_now()) {
        const int row0 = chunk_row0(cidx); const bool lat = cidx < 512;
        int b, key0; row_bk(row0, b, key0);
        if (lat) {
            for (int i = tid; i < 64 * 6 * 32; i += 512) { const int t = i / 192, r = i % 192, blk = r >> 5, pr = r & 31, half = pr >> 4, j = pr & 15;
                const int pos = half ? ((key0 + t) & 63) : ((key0 + t) >> 6); const f32x2 cs = cs16[pos * 16 + j];
                bf16_t* x = Z + (size_t)(row0 + t) * NZ + ZA_Q + blk * 64 + half * 32 + j; const float x1 = bf2f(x[0]), x2 = bf2f(x[16]);
                x[0] = f2bf(x1 * cs.x - x2 * cs.y); x[16] = f2bf(x2 * cs.x + x1 * cs.y); }
            for (int i = tid; i < 64 * 16 * 16; i += 512) { const int t = i >> 8, r = i & 255, blk = r >> 4, pr = r & 15, half = pr >> 3, j = pr & 7;
                const int pos = half ? ((key0 + t) & 63) : ((key0 + t) >> 6); const f32x2 cs = cs8[pos * 8 + j];
                bf16_t* x = Z + (size_t)(row0 + t) * NZ + ZD_Q + blk * 32 + half * 16 + j; const float x1 = bf2f(x[0]), x2 = bf2f(x[8]);
                x[0] = f2bf(x1 * cs.x - x2 * cs.y); x[8] = f2bf(x2 * cs.x + x1 * cs.y); }
        }
        { const int t = tid >> 3, s = tid & 7; bf16_t* zr = Z + (size_t)(row0 + t) * NZ;
          float xq[32], xk[16]; float sq = 0.f, sk = 0.f;
#pragma unroll
          for (int j = 0; j < 4; ++j) { const u32x4 w = *(const u32x4*)(zr + ZC_Q + s * 32 + j * 8); const unsigned wu[4] = {w.x, w.y, w.z, w.w};
#pragma unroll
              for (int q = 0; q < 4; ++q) { xq[j * 8 + 2 * q] = bflo(wu[q]); xq[j * 8 + 2 * q + 1] = bfhi(wu[q]); } }
#pragma unroll
          for (int j = 0; j < 2; ++j) { const u32x4 w = *(const u32x4*)(zr + ZC_KV + s * 16 + j * 8); const unsigned wu[4] = {w.x, w.y, w.z, w.w};
#pragma unroll
              for (int q = 0; q < 4; ++q) { xk[j * 8 + 2 * q] = bflo(wu[q]); xk[j * 8 + 2 * q + 1] = bfhi(wu[q]); } }
#pragma unroll
          for (int j = 0; j < 32; ++j) sq += xq[j] * xq[j];
#pragma unroll
          for (int j = 0; j < 16; ++j) sk += xk[j] * xk[j];
          sq += __shfl_xor(sq, 1); sq += __shfl_xor(sq, 2); sq += __shfl_xor(sq, 4); sk += __shfl_xor(sk, 1); sk += __shfl_xor(sk, 2); sk += __shfl_xor(sk, 4);
          const float rq = rsqrtf(sq * (1.f / 256.f) + NORM_EPS), rk = rsqrtf(sk * (1.f / 128.f) + NORM_EPS);
#pragma unroll
          for (int j = 0; j < 4; ++j) { u32x4 w; const float* g = qn + s * 32 + j * 8;
              w.x = pk2(xq[j * 8 + 0] * rq * g[0], xq[j * 8 + 1] * rq * g[1]); w.y = pk2(xq[j * 8 + 2] * rq * g[2], xq[j * 8 + 3] * rq * g[3]);
              w.z = pk2(xq[j * 8 + 4] * rq * g[4], xq[j * 8 + 5] * rq * g[5]); w.w = pk2(xq[j * 8 + 6] * rq * g[6], xq[j * 8 + 7] * rq * g[7]);
              *(u32x4*)(zr + ZC_Q + s * 32 + j * 8) = w; }
#pragma unroll
          for (int j = 0; j < 2; ++j) { u32x4 w; const float* g = kvn + s * 16 + j * 8;
              w.x = pk2(xk[j * 8 + 0] * rk * g[0], xk[j * 8 + 1] * rk * g[1]); w.y = pk2(xk[j * 8 + 2] * rk * g[2], xk[j * 8 + 3] * rk * g[3]);
              w.z = pk2(xk[j * 8 + 4] * rk * g[4], xk[j * 8 + 5] * rk * g[5]); w.w = pk2(xk[j * 8 + 6] * rk * g[6], xk[j * 8 + 7] * rk * g[7]);
              *(u32x4*)(zr + ZC_KV + s * 16 + j * 8) = w; } }
        for (int i = tid; i < 64 * 16; i += 512) { const int t = i >> 4, pr = i & 15, half = pr >> 3, j = pr & 7;
            const bf16_t* x = Z + (size_t)(row0 + t) * NZ + ZC_KR + half * 16 + j; float x1 = bf2f(x[0]), x2 = bf2f(x[8]);
            if (lat) { const int pos = half ? ((key0 + t) & 63) : ((key0 + t) >> 6); const f32x2 cs = cs8[pos * 8 + j]; const float a = x1 * cs.x - x2 * cs.y, c = x2 * cs.x + x1 * cs.y; x1 = a; x2 = c; }
            const bf16_t o1 = f2bf(x1), o2 = f2bf(x2);
#pragma unroll
            for (int hh = 0; hh < 4; ++hh) { bf16_t* kp = KC + ((size_t)(b * 4 + hh) * KEYS + key0 + t) * 96 + 64 + half * 16 + j; kp[0] = o1; kp[8] = o2; } }
        for (int tile = 0; tile < 6; ++tile) {
            const int zc = tile < 2 ? ZA_V + tile * 64 : ZD_V + (tile - 2) * 64;
            { const int t = tid >> 3, c8 = (tid & 7) * 8; const u32x4 w = *(const u32x4*)(Z + (size_t)(row0 + t) * NZ + zc + c8);
              *(LAS u32x2*)(TT + t * 72 + c8) = (u32x2){w.x, w.y}; *(LAS u32x2*)(TT + t * 72 + c8 + 4) = (u32x2){w.z, w.w}; }
            __syncthreads();
            { const int dv = tid >> 3, k8 = (tid & 7) * 8; unsigned short e[8];
#pragma unroll
              for (int j = 0; j < 8; ++j) e[j] = TT[(k8 + j) * 72 + dv];
              u32x4 w; w.x = e[0] | ((unsigned)e[1] << 16); w.y = e[2] | ((unsigned)e[3] << 16); w.z = e[4] | ((unsigned)e[5] << 16); w.w = e[6] | ((unsigned)e[7] << 16);
              bf16_t* dst = tile < 2 ? AVt + ((size_t)(b * 2 + tile) * 64 + dv) * KEYS + key0 + k8 : DVt + ((size_t)(b * 4 + tile - 2) * 64 + dv) * KEYS + key0 + k8;
              *(u32x4*)dst = w; }
            __syncthreads();
        }
        for (int h = 0; h < 4; ++h) {
            hgrn_load(Z, lbl, li, row0, h, tid, AF, AB, KF, KB, V, (LAS float*)nullptr);
            __syncthreads();
            hgrn_cumsum(tid, AF, AB);
            __syncthreads();
            if (tid < 64) HE[((size_t)(cidx * 4 + h) * 2 + 0) * 64 + tid] = __expf(AF[63 * 65 + tid]);
            else if (tid < 128) HE[((size_t)(cidx * 4 + h) * 2 + 1) * 64 + tid - 64] = __expf(AB[tid - 64]);
            for (int i = tid; i < 4096; i += 512) { const int s = i >> 6, d = i & 63;
                KF[s * 65 + d] *= __expf(AF[63 * 65 + d] - AF[s * 65 + d]); KB[s * 65 + d] *= __expf(AB[d] - AB[s * 65 + d]); }
            __syncthreads();
            { const int d = tid >> 3, e0 = (tid & 7) * 8; float uf[8], ub[8];
#pragma unroll
              for (int j = 0; j < 8; ++j) { uf[j] = 0.f; ub[j] = 0.f; }
              for (int s = 0; s < 64; ++s) { const float kf = KF[s * 65 + d], kb = KB[s * 65 + d];
#pragma unroll
                  for (int j = 0; j < 8; ++j) { const float vv = V[s * 65 + e0 + j]; uf[j] += kf * vv; ub[j] += kb * vv; } }
              u32x4 w; w.x = pk2(uf[0], uf[1]); w.y = pk2(uf[2], uf[3]); w.z = pk2(uf[4], uf[5]); w.w = pk2(uf[6], uf[7]);
              *(u32x4*)(U + ((size_t)(cidx * 4 + h) * 2 + 0) * 4096 + d * 64 + e0) = w;
              w.x = pk2(ub[0], ub[1]); w.y = pk2(ub[2], ub[3]); w.z = pk2(ub[4], ub[5]); w.w = pk2(ub[6], ub[7]);
              *(u32x4*)(U + ((size_t)(cidx * 4 + h) * 2 + 1) * 4096 + d * 64 + e0) = w; }
            __syncthreads();
        }
    }
}

DI void phase_hscan(const Ctx& p) {
    bf16_t* U = (bf16_t*)(p.ws + WS_X + X_U); const float* HE = (const float*)(p.ws + WS_HE);
    for (int g = bid_now() * 512 + tid_now(); g < 64 * 4096; g += gdim_now() * 512) {
        const int chain = g >> 12, el = g & 4095, d = el >> 6; const int b = chain >> 3, h = (chain >> 1) & 3, dir = chain & 1;
        float S = 0.f;
        for (int k0 = 0; k0 < 68; k0 += 4) {
            float u[4], e[4]; size_t ad[4];
#pragma unroll
            for (int q = 0; q < 4; ++q) { const int k = k0 + q; int cidx;
                if (dir == 0) cidx = k < 4 ? 512 + b * 4 + k : b * 64 + (k - 4); else cidx = k < 4 ? 512 + b * 4 + (3 - k) : b * 64 + (67 - k);
                const size_t ch = (size_t)(cidx * 4 + h) * 2 + dir; ad[q] = ch * 4096 + el; u[q] = bf2f(U[ad[q]]); e[q] = HE[ch * 64 + d]; }
#pragma unroll
            for (int q = 0; q < 4; ++q) { U[ad[q]] = f2bf(S); S = e[q] * S + u[q]; }
        }
    }
}

DI void hgrn_out_unit(const Ctx& p, const int li, const int cidx, ldsp lds) {
    const int tid = tid_now();
    bf16_t* Z = (bf16_t*)(p.ws + WS_Z); const bf16_t* U = (const bf16_t*)(p.ws + WS_X + X_U);
    const float* lbl = p.in[13]; const float* gn = p.in[14] + li * 64;
    LAS float* AF = (LAS float*)lds; LAS float* AB = AF + 64 * 65; LAS float* KF = AB + 64 * 65; LAS float* KB = KF + 64 * 65; LAS float* V = KB + 64 * 65;
    LAS float* Q = V + 64 * 65; LAS float* W = Q + 64 * 65; LAS bf16_t* SF = (LAS bf16_t*)(W + 64 * 65); LAS bf16_t* SB = SF + 4096;
    const int row0 = chunk_row0(cidx);
    for (int h = 0; h < 4; ++h) {
        hgrn_load(Z, lbl, li, row0, h, tid, AF, AB, KF, KB, V, Q);
        { const u32x4 a = *(const u32x4*)(U + ((size_t)(cidx * 4 + h) * 2 + 0) * 4096 + tid * 8), c = *(const u32x4*)(U + ((size_t)(cidx * 4 + h) * 2 + 1) * 4096 + tid * 8);
          *(LAS u32x4*)(SF + tid * 8) = a; *(LAS u32x4*)(SB + tid * 8) = c; }
        __syncthreads();
        hgrn_cumsum(tid, AF, AB);
        __syncthreads();
        {
            const int t = tid >> 3, s0 = (tid & 7) * 8; float w[8];
#pragma unroll
            for (int j = 0; j < 8; ++j) w[j] = 0.f;
            for (int d = 0; d < 64; ++d) { const float q = Q[t * 65 + d], af = AF[t * 65 + d], ab = AB[t * 65 + d];
#pragma unroll
                for (int j = 0; j < 8; ++j) { const int s = s0 + j;
                    const float kf = KF[s * 65 + d], kb = KB[s * 65 + d], asf = AF[s * 65 + d], asb = AB[s * 65 + d];
                    float c;
                    if (s < t) c = kf * __expf(af - asf); else if (s > t) c = kb * __expf(ab - asb); else c = kf + kb;
                    w[j] += q * c; } }
#pragma unroll
            for (int j = 0; j < 8; ++j) W[t * 65 + s0 + j] = w[j];
        }
        __syncthreads();
        {
            const int t = tid >> 3, e0 = (tid & 7) * 8; float o[8];
#pragma unroll
            for (int j = 0; j < 8; ++j) o[j] = 0.f;
            for (int s = 0; s < 64; ++s) { const float w = W[t * 65 + s];
#pragma unroll
                for (int j = 0; j < 8; ++j) o[j] += w * V[s * 65 + e0 + j]; }
            for (int d = 0; d < 64; ++d) { const float q = Q[t * 65 + d]; const float qf = q * __expf(AF[t * 65 + d]), qb = q * __expf(AB[t * 65 + d]);
#pragma unroll
                for (int j = 0; j < 8; ++j) o[j] += qf * bf2f(SF[d * 64 + e0 + j]) + qb * bf2f(SB[d * 64 + e0 + j]); }
            float ss = 0.f;
#pragma unroll
            for (int j = 0; j < 8; ++j) ss += o[j] * o[j];
            ss += __shfl_xor(ss, 1); ss += __shfl_xor(ss, 2); ss += __shfl_xor(ss, 4);
            const float rstd = rsqrtf(ss * (1.f / 64.f) + NORM_EPS);
            bf16_t* zr = Z + (size_t)(row0 + t) * NZ + h * 64 + e0;
            const u32x4 gw = *(const u32x4*)(zr + ZB_G); const unsigned gu[4] = {gw.x, gw.y, gw.z, gw.w};
            float r[8];
#pragma unroll
            for (int j = 0; j < 8; ++j) { const float g = (j & 1) ? bfhi(gu[j >> 1]) : bflo(gu[j >> 1]); r[j] = o[j] * rstd * gn[e0 + j] * g * sigmoidf_(g); }
            u32x4 w; w.x = pk2(r[0], r[1]); w.y = pk2(r[2], r[3]); w.z = pk2(r[4], r[5]); w.w = pk2(r[6], r[7]);
            *(u32x4*)(zr + ZB_Q) = w;
        }
        __syncthreads();
    }
}

template <int DQK, int NMAP, int MODE>
struct AttnCfg { static constexpr int KW = DQK * NMAP, RSK = KW * 2 + 16, RSV = 136, KBYTES = 64 * RSK, BUF = KBYTES + 64 * RSV, CPR = KW / 8, NCK = 64 * CPR; };

template <int DQK, int NMAP, int MODE, class TileFn>
DI void attn_unit(ldsp lds, const bf16_t* qrow  , const int ntiles, TileFn tile,
                  const float scl2  , const float m_init, const float l_init, const int qpos  ,
                  bf16_t* orow, const float lam, const float post, const float* subln, const int qtok = -1, const f32x2* cs8 = nullptr) {
    typedef AttnCfg<DQK, NMAP, MODE> C;
    const int tid = tid_now(), lane = tid & 63, r = lane & 31, hh = lane >> 5;
    bf16x8 qf[NMAP][DQK / 16];
#pragma unroll
    for (int mp = 0; mp < NMAP; ++mp)
#pragma unroll
        for (int kk = 0; kk < DQK / 16; ++kk) qf[mp][kk] = *(const bf16x8*)(qrow + mp * DQK + kk * 16 + hh * 8);
    if (MODE == 0 && qtok >= 0) {
#pragma unroll
        for (int kk = 4; kk < 6; ++kk) { const int pos = kk == 4 ? (qtok >> 6) : (qtok & 63);
            const u32x4 w = __builtin_bit_cast(u32x4, qf[0][kk]); const unsigned wu[4] = {w.x, w.y, w.z, w.w}; unsigned ou[4];
#pragma unroll
            for (int q2 = 0; q2 < 4; ++q2) { const unsigned pw = __shfl_xor(wu[q2], 32);
                const f32x2 c0 = cs8[pos * 8 + 2 * q2], c1 = cs8[pos * 8 + 2 * q2 + 1];
                const float a0 = bflo(wu[q2]), a1 = bfhi(wu[q2]), b0 = bflo(pw), b1 = bfhi(pw);
                const float r0 = hh ? a0 * c0.x + b0 * c0.y : a0 * c0.x - b0 * c0.y, r1 = hh ? a1 * c1.x + b1 * c1.y : a1 * c1.x - b1 * c1.y;
                ou[q2] = pk2(r0, r1); }
            const u32x4 o4 = {ou[0], ou[1], ou[2], ou[3]}; qf[0][kk] = __builtin_bit_cast(bf16x8, o4); }
    }
    f32x16 O[NMAP][2];
    float m[NMAP], l[NMAP];
#pragma unroll
    for (int mp = 0; mp < NMAP; ++mp) { m[mp] = m_init; l[mp] = l_init;
#pragma unroll
        for (int dv = 0; dv < 2; ++dv)
#pragma unroll
            for (int i = 0; i < 16; ++i) O[mp][dv][i] = 0.f; }
    const int kr0 = tid / C::CPR, kc0 = tid % C::CPR; const int kr1 = (tid + 512) / C::CPR, kc1 = (tid + 512) % C::CPR;
    const int vr = tid >> 3, vc = tid & 7;
    u32x4 kreg0, kreg1 = (u32x4){0u, 0u, 0u, 0u}, vreg;
    const bf16_t* kp; const bf16_t* vp; int ldk, kpos0, masked;
    tile(0, kp, ldk, vp, kpos0, masked);
    kreg0 = *(const u32x4*)(kp + (size_t)kr0 * ldk + kc0 * 8);
    if (C::NCK > 512 && tid + 512 < C::NCK) kreg1 = *(const u32x4*)(kp + (size_t)kr1 * ldk + kc1 * 8);
    vreg = *(const u32x4*)(vp + (size_t)vr * KEYS + vc * 8);
    __syncthreads();
    *(LAS u32x4*)(lds + kr0 * C::RSK + kc0 * 16) = kreg0;
    if (C::NCK > 512 && tid + 512 < C::NCK) *(LAS u32x4*)(lds + kr1 * C::RSK + kc1 * 16) = kreg1;
    *(LAS u32x4*)(lds + C::KBYTES + vr * C::RSV + vc * 16) = vreg;
    __syncthreads();
#pragma unroll 1
    for (int j = 0; j < ntiles; ++j) {
        const int cur_kpos0 = kpos0, cur_masked = masked;
        const bool more = j + 1 < ntiles;
        if (more) { tile(j + 1, kp, ldk, vp, kpos0, masked);
            kreg0 = *(const u32x4*)(kp + (size_t)kr0 * ldk + kc0 * 8);
            if (C::NCK > 512 && tid + 512 < C::NCK) kreg1 = *(const u32x4*)(kp + (size_t)kr1 * ldk + kc1 * 8);
            vreg = *(const u32x4*)(vp + (size_t)vr * KEYS + vc * 8); }
        ldsp kb = lds + (j & 1) * C::BUF; ldsp vb = kb + C::KBYTES;
        bf16x8 pf[NMAP][2][2];
#pragma unroll
        for (int mp = 0; mp < NMAP; ++mp) {
            f32x16 s[2];
#pragma unroll
            for (int ks = 0; ks < 2; ++ks) {
#pragma unroll
                for (int i = 0; i < 16; ++i) s[ks][i] = 0.f;
#pragma unroll
                for (int kk = 0; kk < DQK / 16; ++kk) { const bf16x8 kf = *(const LAS bf16x8*)(kb + (32 * ks + r) * C::RSK + (mp * DQK + kk * 16 + hh * 8) * 2);
                    s[ks] = __builtin_amdgcn_mfma_f32_32x32x16_bf16(kf, qf[mp][kk], s[ks], 0, 0, 0); } }
            float mx = -3.0e38f;
#pragma unroll
            for (int ks = 0; ks < 2; ++ks)
#pragma unroll
                for (int i = 0; i < 16; ++i) { float x = s[ks][i] * scl2;
                    if (MODE == 2) { const int rel = cur_kpos0 + 32 * ks + (i & 3) + 8 * (i >> 2) + 4 * hh - qpos; if (cur_masked && (rel > 128 || rel < -128)) x = -1.0e30f; }
                    s[ks][i] = x; mx = fmaxf(mx, x); }
            mx = fmaxf(mx, __shfl_xor(mx, 32));
            const float mn = fmaxf(m[mp], mx), alpha = __builtin_amdgcn_exp2f(m[mp] - mn); m[mp] = mn;
            float ps = 0.f;
#pragma unroll
            for (int ks = 0; ks < 2; ++ks)
#pragma unroll
                for (int i = 0; i < 16; ++i) { const float pv = __builtin_amdgcn_exp2f(s[ks][i] - mn); s[ks][i] = pv; ps += pv; }
            l[mp] = l[mp] * alpha + ps;
#pragma unroll
            for (int dv = 0; dv < 2; ++dv)
#pragma unroll
                for (int i = 0; i < 16; ++i) O[mp][dv][i] *= alpha;
#pragma unroll
            for (int ks = 0; ks < 2; ++ks)
#pragma unroll
                for (int s2 = 0; s2 < 2; ++s2) { u32x4 w; w.x = pk2(s[ks][8 * s2 + 0], s[ks][8 * s2 + 1]); w.y = pk2(s[ks][8 * s2 + 2], s[ks][8 * s2 + 3]);
                    w.z = pk2(s[ks][8 * s2 + 4], s[ks][8 * s2 + 5]); w.w = pk2(s[ks][8 * s2 + 6], s[ks][8 * s2 + 7]);
                    pf[mp][ks][s2] = __builtin_bit_cast(bf16x8, w); }
        }
#pragma unroll
        for (int dv = 0; dv < 2; ++dv)
#pragma unroll
            for (int ks = 0; ks < 2; ++ks)
#pragma unroll
                for (int s2 = 0; s2 < 2; ++s2) {
                    const LAS unsigned char* va = vb + (32 * dv + r) * C::RSV + (32 * ks + 16 * s2 + 4 * hh) * 2;
                    const u32x2 lo = *(const LAS u32x2*)va, hi = *(const LAS u32x2*)(va + 16);
                    const u32x4 vw = {lo.x, lo.y, hi.x, hi.y}; const bf16x8 vf = __builtin_bit_cast(bf16x8, vw);
#pragma unroll
                    for (int mp = 0; mp < NMAP; ++mp) O[mp][dv] = __builtin_amdgcn_mfma_f32_32x32x16_bf16(vf, pf[mp][ks][s2], O[mp][dv], 0, 0, 0);
                }
        if (more) { ldsp nb = lds + ((j + 1) & 1) * C::BUF;
            *(LAS u32x4*)(nb + kr0 * C::RSK + kc0 * 16) = kreg0;
            if (C::NCK > 512 && tid + 512 < C::NCK) *(LAS u32x4*)(nb + kr1 * C::RSK + kc1 * 16) = kreg1;
            *(LAS u32x4*)(nb + C::KBYTES + vr * C::RSV + vc * 16) = vreg; }
        __syncthreads();
    }
    asm volatile("" ::: "memory");
    float inv[NMAP];
#pragma unroll
    for (int mp = 0; mp < NMAP; ++mp) { const float lt = l[mp] + __shfl_xor(l[mp], 32); inv[mp] = 1.f / lt; }
    float o[2][16];
#pragma unroll
    for (int dv = 0; dv < 2; ++dv)
#pragma unroll
        for (int i = 0; i < 16; ++i) { if (MODE == 1) o[dv][i] = O[0][dv][i] * inv[0] - lam * O[NMAP - 1][dv][i] * inv[NMAP - 1]; else o[dv][i] = O[0][dv][i] * inv[0]; }
    if (MODE == 1) {
        float ss = 0.f;
#pragma unroll
        for (int dv = 0; dv < 2; ++dv)
#pragma unroll
            for (int i = 0; i < 16; ++i) ss += o[dv][i] * o[dv][i];
        ss += __shfl_xor(ss, 32);
        const float rstd = rsqrtf(ss * (1.f / 64.f) + NORM_EPS) * post;
#pragma unroll
        for (int dv = 0; dv < 2; ++dv)
#pragma unroll
            for (int i = 0; i < 16; ++i) o[dv][i] *= rstd * subln[32 * dv + (i & 3) + 8 * (i >> 2) + 4 * hh];
    }
#pragma unroll
    for (int dv = 0; dv < 2; ++dv)
#pragma unroll
        for (int g = 0; g < 4; ++g) { u32x2 w; w.x = pk2(o[dv][4 * g + 0], o[dv][4 * g + 1]); w.y = pk2(o[dv][4 * g + 2], o[dv][4 * g + 3]);
            *(u32x2*)(orow + 32 * dv + 8 * g + 4 * hh) = w; }
}

DI void attn_c_unit(const Ctx& p, const int u, ldsp lds) {
    const int wave = tid_now() >> 6, r = tid_now() & 31;
    const bf16_t* QC = (const bf16_t*)(p.ws + WS_X + X_QC); const bf16_t* KC = (const bf16_t*)(p.ws + WS_X + X_KC); const bf16_t* CVt = (const bf16_t*)(p.ws + WS_X + X_CVT);
    bf16_t* Z = (bf16_t*)(p.ws + WS_Z);
    int b, h, row, nt, t0;
    if (u < 512) { b = u >> 6; h = (u >> 4) & 3; row = b * SEQ + (u & 15) * 256 + wave * 32 + r; nt = 68; t0 = 0; }
    else { const int v = u - 512; b = v >> 2; h = v & 3; row = ML + b * CTXL + wave * 32 + r; nt = 4; t0 = 64; }
    const bf16_t* kbase = KC + (size_t)(b * 4 + h) * KEYS * 96; const bf16_t* vbase = CVt + (size_t)(b * 4 + h) * 64 * KEYS;
    attn_unit<96, 1, 0>(lds, QC + (size_t)row * 384 + h * 96, nt,
        [=](int j, const bf16_t*& kp, int& ldk, const bf16_t*& vp, int& kpos0, int& masked) { const int key0 = (t0 + j) * 64; kp = kbase + (size_t)key0 * 96; ldk = 96; vp = vbase + key0; kpos0 = 0; masked = 0; },
        0.10206207261596577f * 1.4426950408889634f, -1.0e30f, 0.f, 0, Z + (size_t)row * NZ + ZC_Q + h * 64, 0.f, 0.f, nullptr,
        u < 512 ? (row & 4095) : -1, (const f32x2*)(p.ws + WS_ROPE8));
}
DI void attn_d_unit(const Ctx& p, const int li, const int u, ldsp lds) {
    const int wave = tid_now() >> 6, r = tid_now() & 31;
    bf16_t* Z = (bf16_t*)(p.ws + WS_Z); const bf16_t* DVt = (const bf16_t*)(p.ws + WS_X + X_DVT);
    int b, h, row, nt, t0;
    if (u < 512) { b = u >> 6; h = (u >> 4) & 3; row = b * SEQ + (u & 15) * 256 + wave * 32 + r; nt = 68; t0 = 0; }
    else { const int v = u - 512; b = v >> 2; h = v & 3; row = ML + b * CTXL + wave * 32 + r; nt = 4; t0 = 64; }
    const float* lamv = (const float*)(p.ws + WS_LAM); const float lam = lamv[li * 2], lam_init = lamv[li * 2 + 1];
    const bf16_t* vbase = DVt + (size_t)(b * 4 + h) * 64 * KEYS; const bf16_t* zk = Z + ZD_K + h * 64;
    attn_unit<32, 2, 1>(lds, Z + (size_t)row * NZ + ZD_Q + h * 64, nt,
        [=](int j, const bf16_t*& kp, int& ldk, const bf16_t*& vp, int& kpos0, int& masked) { const int key0 = (t0 + j) * 64; kp = zk + (size_t)key_row(b, key0) * NZ; ldk = NZ; vp = vbase + key0; kpos0 = 0; masked = 0; },
        0.17677669529663687f * 1.4426950408889634f, -1.0e30f, 0.f, 0, Z + (size_t)row * NZ + ZD_Q + h * 64, lam, 1.f - lam_init, p.in[20] + li * 64);
}
DI void attn_a_unit(const Ctx& p, const int li, const int u, ldsp lds) {
    const int wave = tid_now() >> 6, r = tid_now() & 31;
    bf16_t* Z = (bf16_t*)(p.ws + WS_Z); const bf16_t* AVt = (const bf16_t*)(p.ws + WS_X + X_AVT);
    int b, kvh, row, qpos, nt, tlo;
    const bool latq = u < 512;
    if (latq) { b = u >> 6; kvh = (u >> 5) & 1; const int qb = u & 31; qpos = qb * 128 + (wave & 3) * 32 + r; row = b * SEQ + qpos;
        const int lo = qb > 0 ? (qb - 1) * 2 : 0, hi = qb < 31 ? (qb + 2) * 2 : 64; tlo = lo; nt = (hi - lo) + 4; }
    else { const int v = u - 512; b = v >> 2; kvh = (v >> 1) & 1; qpos = 0; row = ML + b * CTXL + (v & 1) * 128 + (wave & 3) * 32 + r; tlo = 64; nt = 4; }
    const int head = 2 * kvh + (wave >> 2);
    const int nband = latq ? nt - 4 : 0;
    const bf16_t* vbase = AVt + (size_t)(b * 2 + kvh) * 64 * KEYS; const bf16_t* zk = Z + ZA_K + kvh * 64;
    const float sink = p.in[12][li * 4 + head] * 1.4426950408889634f;
    attn_unit<64, 1, 2>(lds, Z + (size_t)row * NZ + ZA_Q + head * 64, nt,
        [=](int j, const bf16_t*& kp, int& ldk, const bf16_t*& vp, int& kpos0, int& masked) {
            const int key0 = j < nband ? (tlo + j) * 64 : SEQ + (j - nband) * 64;
            kp = zk + (size_t)key_row(b, key0) * NZ; ldk = NZ; vp = vbase + key0; kpos0 = key0; masked = j < nband; },
        0.125f * 1.4426950408889634f, sink, (tid_now() & 32) ? 0.f : 1.f, qpos, Z + (size_t)row * NZ + ZA_Q + head * 64, 0.f, 0.f, nullptr);
}

enum { PH_PRE = 0, PH_WN1, PH_IN, PH_PREP, PH_MLA, PH_MIX, PH_GATE0, PH_MERGE0, PH_GATE1, PH_MERGE1, PH_OUT, PH_NORM2, PH_SCAT, PH_MOE1, PH_MOE2, PH_FINAL, PH_COUNT };

template <int PH> DI void run_phase(const Params& P, const CtxRaw& pc, const int li, ldsp lds) {
    const Ctx p = fresh(pc);
    unsigned char* ws = p.ws; const char* wt = (const char*)(ws + WS_WT);
    const int G = gdim_now(), c = bid_now();
    if constexpr (PH == PH_PRE) phase_pre(P, lds);
    if constexpr (PH == PH_WN1) { phase_wconv(p, li); phase_norm<0>(p, li); }
    if constexpr (PH == PH_IN) {
        pg8::SchedPlain S{(const char*)(ws + WS_HB), wt + WT_IN, 1024, 1024, MT / 256, NZ / 256, G, c, 0};
        pg8::EpiZ E{(bf16_t*)(ws + WS_Z)};
        pg8::gemm_phase(lds, 1024, 1024, 1024, S, E);
    }
    if constexpr (PH == PH_PREP) phase_prep(p, li, lds);
    if constexpr (PH == PH_MLA) {
        pg8::SchedPlain S{(const char*)(ws + WS_Z) + ZC_Q * 2, wt + WT_MLA, NZ, 384, MT / 256, 4, G, c, 0};
        pg8::EpiMla E{(bf16_t*)(ws + WS_X + X_QC), (bf16_t*)(ws + WS_X + X_KC), (bf16_t*)(ws + WS_X + X_CVT)};
        phase_hscan(p);
        pg8::gemm_phase(lds, NZ, 384, 384, S, E);
    }
    if constexpr (PH == PH_MIX) {
        const int nq = li == 0 ? 544 : 512;
        for (int u = c; u < nq; u += G) attn_c_unit(p, u, lds);
        for (int u = c; u < nq; u += G) attn_d_unit(p, li, u, lds);
        for (int u = c; u < nq; u += G) attn_a_unit(p, li, u, lds);
        __syncthreads();
        const int nch = li == 0 ? NCHUNK : 512;
        for (int u = c; u < nch; u += G) hgrn_out_unit(p, li, u, lds);
    }
    if constexpr (PH == PH_GATE0 || PH == PH_GATE1) {
        constexpr int half = PH == PH_GATE1;
        const int nM = li == 0 ? 68 : 64;
        pg8::SchedPlain S{(const char*)(ws + WS_HB), wt + WT_G, 1024, 1024, nM, 16, G, c, half * nM};
        pg8::EpiGate E{(bf16_t*)(ws + WS_X), half * nM * 256};
        pg8::gemm_phase(lds, 1024, 1024, 1024, S, E);
    }
    if constexpr (PH == PH_MERGE0 || PH == PH_MERGE1) {
        constexpr int half = PH == PH_MERGE1;
        const int nM = li == 0 ? 68 : 64;
        pg8::SchedMerge S{(const char*)(ws + WS_Z), wt + WT_B, nM, G, c, half * nM};
        pg8::EpiMerge E{(bf16_t*)(ws + WS_Z), (const bf16_t*)(ws + WS_X), half * nM * 256};
        pg8::gemm_phase(lds, NZ, 256, 256, S, E);
    }
    if constexpr (PH == PH_OUT) {
        const int nM = li == 0 ? 136 : 128;
        pg8::SchedPlain S{(const char*)(ws + WS_Z) + ZY * 2, wt + WT_O, NZ, 1024, nM, 4, G, c, 0};
        float* ctxs = (float*)(ws + WS_CTXS);
        pg8::EpiOut E{li == 0 ? p.in[0] : p.out, li == 0 ? p.in[2] : ctxs, p.out, ctxs, (const float*)(ws + WS_MODV) + li * 9 * 6144};
        pg8::gemm_phase(lds, NZ, 1024, 1024, S, E);
    }
    if constexpr (PH == PH_NORM2) phase_norm2(p, li, lds);
    if constexpr (PH == PH_SCAT) phase_scatter(p, li, lds);
    if constexpr (PH == PH_MOE1 || PH == PH_MOE2) {
        LAS unsigned* off = (LAS unsigned*)(lds + pg8::STAGE_BYTES + 1024); LAS unsigned char* pe = (LAS unsigned char*)(lds + pg8::STAGE_BYTES);
        const int nP = moe_offsets((const unsigned*)(ws + WS_CTL + CTL_CNT) + li * 32, off, pe);
        if constexpr (PH == PH_MOE1) {
            pg8::SchedMoe S{(const char*)(ws + WS_XG), wt + WT_E1, 1024, 1024, nP, 2, G, c, (size_t)512 * 1024 * 2, pe};
            pg8::EpiMoeUp E{(bf16_t*)(ws + WS_HMID)};
            pg8::gemm_phase(lds, 1024, 1024, 1024, S, E);
        } else {
            pg8::SchedMoe S{(const char*)(ws + WS_HMID), wt + WT_E2, 256, 256, nP, 4, G, c, (size_t)1024 * 256 * 2, pe};
            pg8::EpiMoeDown E{(bf16_t*)(ws + WS_Y), (const int*)(ws + WS_ROWI), (const float*)(ws + WS_ROWW)};
            pg8::gemm_phase(lds, 256, 256, 256, S, E);
        }
        __syncthreads();
    }
    if constexpr (PH == PH_FINAL) phase_norm<2>(p, 1);
}

#if N_LAUNCH_MODE == 1
template <int PH> __global__ __launch_bounds__(512, 2) void k_phase(Params p, int li) {
    extern __shared__ __attribute__((aligned(16))) unsigned char shm[];
    CtxRaw c; c.tab = (unsigned long long)(p.ws + WS_TAB); c.out = (unsigned long long)p.out; c.ws = (unsigned long long)p.ws;
    run_phase<PH>(p, c, li, (ldsp)shm);
}
#else
__global__ __launch_bounds__(512, 2) void k_mega(Params p) {
    extern __shared__ __attribute__((aligned(16))) unsigned char shm[];
    ldsp lds = (ldsp)shm;
    volatile LAS unsigned* st = (volatile LAS unsigned*)(lds + LDS_BYTES - 16);
    if (tid_now() == 0) { st[0] = 0u; st[1] = 0u; st[2] = 0u; st[3] = 0u; }
    __syncthreads();
    XcdBarrier bar = xcd_barrier_post((unsigned*)(p.ws + WS_CTL), st);
    CtxRaw c; c.tab = (unsigned long long)(p.ws + WS_TAB); c.out = (unsigned long long)p.out; c.ws = (unsigned long long)p.ws;
    run_phase<PH_PRE>(p, c, 0, lds); xcd_barrier(bar);
    for (int li = 0; li < 2; ++li) {
        run_phase<PH_WN1>(p, c, li, lds); xcd_barrier(bar);
        run_phase<PH_IN>(p, c, li, lds); xcd_barrier(bar);
        run_phase<PH_PREP>(p, c, li, lds); xcd_barrier(bar);
        run_phase<PH_MLA>(p, c, li, lds); xcd_barrier(bar);
        run_phase<PH_MIX>(p, c, li, lds); xcd_barrier(bar);
        run_phase<PH_GATE0>(p, c, li, lds); xcd_barrier(bar);
        run_phase<PH_MERGE0>(p, c, li, lds); xcd_barrier(bar);
        run_phase<PH_GATE1>(p, c, li, lds); xcd_barrier(bar);
        run_phase<PH_MERGE1>(p, c, li, lds); xcd_barrier(bar);
        run_phase<PH_OUT>(p, c, li, lds); xcd_barrier(bar);
        run_phase<PH_NORM2>(p, c, li, lds); xcd_barrier(bar);
        run_phase<PH_SCAT>(p, c, li, lds); xcd_barrier(bar);
        run_phase<PH_MOE1>(p, c, li, lds); xcd_barrier(bar);
        run_phase<PH_MOE2>(p, c, li, lds); xcd_barrier(bar);
    }
    run_phase<PH_FINAL>(p, c, 1, lds);
}
#endif

extern "C" void kernel_launch(void* const* d_in, const int* in_sizes, int n_in, void* d_out, int out_size, void* d_ws, size_t ws_size, hipStream_t stream) {
    if (n_in != 29 || ws_size < WS_END || out_size != ML * D) { fprintf(stderr, "kernel_launch: unexpected shapes (n_in %d, ws %zu need %zu, out %d)\n", n_in, ws_size, (size_t)WS_END, out_size); return; }
    Params p{};
    for (int i = 0; i < 29; ++i) p.in[i] = (const float*)d_in[i];
    p.out = (float*)d_out; p.ws = (unsigned char*)d_ws;
    hipMemsetAsync((char*)d_ws + WS_CTL, 0, 65536, stream);
    const int grid = 256;
#if N_LAUNCH_MODE == 1
    static bool init = false;
#define SETLDS(PH) hipFuncSetAttribute((const void*)k_phase<PH>, hipFuncAttributeMaxDynamicSharedMemorySize, LDS_BYTES)
    if (!init) { SETLDS(PH_PRE); SETLDS(PH_WN1); SETLDS(PH_IN); SETLDS(PH_PREP); SETLDS(PH_MLA); SETLDS(PH_MIX); SETLDS(PH_GATE0); SETLDS(PH_MERGE0); SETLDS(PH_GATE1); SETLDS(PH_MERGE1);
        SETLDS(PH_OUT); SETLDS(PH_NORM2); SETLDS(PH_SCAT); SETLDS(PH_MOE1); SETLDS(PH_MOE2); SETLDS(PH_FINAL); init = true; }
#define LAUNCH(PH, li) hipLaunchKernelGGL(k_phase<PH>, dim3(grid), dim3(512), LDS_BYTES, stream, p, li)
    LAUNCH(PH_PRE, 0);
    for (int li = 0; li < 2; ++li) {
        LAUNCH(PH_WN1, li); LAUNCH(PH_IN, li); LAUNCH(PH_PREP, li); LAUNCH(PH_MLA, li); LAUNCH(PH_MIX, li);
        LAUNCH(PH_GATE0, li); LAUNCH(PH_MERGE0, li); LAUNCH(PH_GATE1, li); LAUNCH(PH_MERGE1, li); LAUNCH(PH_OUT, li);
        LAUNCH(PH_NORM2, li); LAUNCH(PH_SCAT, li); LAUNCH(PH_MOE1, li); LAUNCH(PH_MOE2, li);
    }
    LAUNCH(PH_FINAL, 1);
#else
    static bool init = false;
    if (!init) { hipFuncSetAttribute((const void*)k_mega, hipFuncAttributeMaxDynamicSharedMemorySize, LDS_BYTES); init = true; }
    hipLaunchKernelGGL(k_mega, dim3(grid), dim3(512), LDS_BYTES, stream, p);
#endif
}
```

```cpp
#include <hip/hip_runtime.h>
#include <stdint.h>
#include <stdio.h>

#ifndef N_LAUNCH_MODE
#define N_LAUNCH_MODE 0
#endif

#define LAS __attribute__((address_space(3)))
#define GAS __attribute__((address_space(1)))
typedef LAS unsigned char* ldsp;
typedef unsigned short bf16_t;
typedef short bf16x8 __attribute__((ext_vector_type(8)));
typedef short s16x4 __attribute__((ext_vector_type(4)));
typedef float f32x2 __attribute__((ext_vector_type(2)));
typedef float f32x4 __attribute__((ext_vector_type(4)));
typedef float f32x16 __attribute__((ext_vector_type(16)));
typedef unsigned u32x2 __attribute__((ext_vector_type(2)));
typedef unsigned u32x4 __attribute__((ext_vector_type(4)));
typedef __bf16 bf16x2_t __attribute__((ext_vector_type(2)));
#define DI __device__ __forceinline__

constexpr int D = 1024, NBAT = 8, SEQ = 4096, CTXL = 256;
constexpr int ML = NBAT * SEQ, MC = NBAT * CTXL, MT = ML + MC;
constexpr int NZ = 3072, KEYS = SEQ + CTXL;
constexpr int ZA_Q = 0, ZA_K = 256, ZA_V = 384, ZB_Q = 512, ZB_FF = 768, ZB_FB = 1024, ZB_I = 1280, ZB_G = 1536,
              ZC_Q = 1792, ZC_KV = 2048, ZC_KR = 2176, ZD_Q = 2208, ZD_K = 2464, ZD_V = 2720;
constexpr int ZY = 768;
constexpr int NCHUNK = MT / 64;
constexpr int MOE_MAXROWS = 77824;
constexpr int MOE_CAP = 2 * MT;
constexpr float NORM_EPS = 1e-6f;
constexpr int LDS_BYTES = 155648;
constexpr int HALF_ROWS = MT / 2;

constexpr size_t WS_CTL = 0;
constexpr size_t CTL_CNT = 16384;
constexpr size_t WS_MODV = 65536;
constexpr size_t WS_ROPE16 = 524288;
constexpr size_t WS_ROPE8 = WS_ROPE16 + 8192;
constexpr size_t WS_TAB = WS_ROPE8 + 8192;
constexpr size_t WS_LAM = WS_ROPE8 + 4096;
constexpr size_t WS_TOKI = 1048576;
constexpr size_t WS_ROWI = WS_TOKI + (size_t)MT * 32;
constexpr size_t WS_ROWW = WS_ROWI + (size_t)MOE_MAXROWS * 4;
constexpr size_t WS_HE = WS_ROWW + (size_t)MOE_MAXROWS * 4;
constexpr size_t WS_WT = 4u << 20;
constexpr size_t WT_IN = 0, WT_G = WT_IN + (size_t)NZ * 1024 * 2, WT_B = WT_G + (size_t)4096 * 1024 * 2, WT_O = WT_B + (size_t)4 * 1024 * 256 * 2,
                 WT_MLA = WT_O + (size_t)1024 * 1024 * 2, WT_E1 = WT_MLA + (size_t)1024 * 384 * 2, WT_E2 = WT_E1 + (size_t)32 * 512 * 1024 * 2,
                 WT_END = WT_E2 + (size_t)32 * 1024 * 256 * 2;
constexpr size_t WS_CTXS = WS_WT + WT_END;
constexpr size_t WS_HB = WS_CTXS + (size_t)MC * 1024 * 4;
constexpr size_t WS_Z = WS_HB + (size_t)MT * 1024 * 2;
constexpr size_t WS_X = WS_Z + (size_t)MT * NZ * 2;
constexpr size_t X_QC = 0, X_KC = X_QC + (size_t)MT * 384 * 2, X_CVT = X_KC + (size_t)NBAT * 4 * KEYS * 96 * 2, X_AVT = X_CVT + (size_t)NBAT * 4 * 64 * KEYS * 2,
                 X_DVT = X_AVT + (size_t)NBAT * 2 * 64 * KEYS * 2, X_U = X_DVT + (size_t)NBAT * 4 * 64 * KEYS * 2, X_END_MIX = X_U + (size_t)NCHUNK * 4 * 2 * 4096 * 2;
constexpr size_t X_SIZE = (size_t)MT * 4096;
static_assert(X_END_MIX <= X_SIZE, "mixer extras must fit the gate region");
constexpr size_t WS_END = WS_X + X_SIZE;
constexpr size_t WS_XG = WS_Z;
constexpr size_t WS_HMID = WS_XG + (size_t)MOE_MAXROWS * 1024 * 2;
constexpr size_t WS_Y = WS_HMID + (size_t)MOE_MAXROWS * 256 * 2;
static_assert(WS_Y + (size_t)2 * MT * 1024 * 2 <= WS_END, "MoE buffers must fit");

struct Params { const float* in[29]; float* out; unsigned char* ws; };
struct Inp { const unsigned long long GAS* tab; DI const float* operator[](int i) const { return (const float*)(const float GAS*)tab[i]; } };
struct Ctx { Inp in; float* out; unsigned char* ws; };
struct CtxRaw { unsigned long long tab, out, ws; };
DI Ctx fresh(CtxRaw c) { asm volatile("" : "+s"(c.tab), "+s"(c.out), "+s"(c.ws)); Ctx q; q.in.tab = (const unsigned long long GAS*)c.tab; q.out = (float*)(float GAS*)c.out; q.ws = (unsigned char*)(unsigned char GAS*)c.ws; return q; }

DI int bid_now() { int t = (int)__builtin_amdgcn_workgroup_id_x(); asm volatile("" : "+s"(t)); return t; }
DI int gdim_now() { int t = (int)__builtin_amdgcn_grid_size_x() / 512; asm volatile("" : "+s"(t)); return t; }
DI int tid_now() { int t = (int)__builtin_amdgcn_workitem_id_x(); asm volatile("" : "+v"(t)); return t; }
DI unsigned pk2(float a, float b) { f32x2 v = {a, b}; bf16x2_t r = __builtin_convertvector(v, bf16x2_t); return __builtin_bit_cast(unsigned, r); }
DI float bflo(unsigned u) { return __uint_as_float(u << 16); }
DI float bfhi(unsigned u) { return __uint_as_float(u & 0xffff0000u); }
DI float bf2f(bf16_t v) { return __uint_as_float((unsigned)v << 16); }
DI bf16_t f2bf(float f) { return (bf16_t)(pk2(f, 0.f) & 0xffffu); }
DI float sigmoidf_(float v) { return __builtin_amdgcn_rcpf(1.f + __expf(-v)); }
template <int CTRL> DI float dpp_f(float x) { return __builtin_bit_cast(float, __builtin_amdgcn_update_dpp(0, __builtin_bit_cast(int, x), CTRL, 0xf, 0xf, true)); }
DI float wave_sum(float v) { v += dpp_f<0xB1>(v); v += dpp_f<0x4E>(v); v += dpp_f<0x141>(v); v += dpp_f<0x140>(v); v += __shfl_xor(v, 16); v += __shfl_xor(v, 32); return v; }
DI void row_bk(int row, int& b, int& key) { if (row < ML) { b = row >> 12; key = row & 4095; } else { const int r = row - ML; b = r >> 8; key = SEQ + (r & 255); } }
DI int key_row(int b, int key) { return key < SEQ ? b * SEQ + key : ML + b * CTXL + (key - SEQ); }
DI int chunk_row0(int cidx) { return cidx < 512 ? cidx * 64 : ML + (cidx - 512) * 64; }

#define XB_TMO      128
#define XB_XCNT(j)  (256  + 64 * (j))
#define XB_XSUB(j)  (1280 + 64 * (j))
#define XB_XGEN(j)  (2304 + 64 * (j))
#define XB_TOP      3328
#define XB_TOPGEN   3392
#define XCD_BAR_WORDS 3456
#define XB_SPIN_CAP (1u << 22)
DI unsigned xb_ld(unsigned* p)              { return __hip_atomic_load(p, __ATOMIC_RELAXED, __HIP_MEMORY_SCOPE_AGENT); }
DI unsigned xb_add(unsigned* p, unsigned v) { return __hip_atomic_fetch_add(p, v, __ATOMIC_RELAXED, __HIP_MEMORY_SCOPE_AGENT); }
DI unsigned xb_xcc_id() { return (unsigned)__builtin_amdgcn_s_getreg((3 << 11) | 20) & 0xFu; }
#define XB_SPIN(cond, bar) do { unsigned _sp = 0; while (cond) { __builtin_amdgcn_s_sleep(1); \
    if ((++_sp & 255u) == 0u) { if (xb_ld(&(bar)[XB_TMO])) break; if (_sp > XB_SPIN_CAP) { atomicAdd(&(bar)[XB_TMO], 1u); break; } } } } while (0)
struct XcdBarrier { unsigned* bar; unsigned x; volatile LAS unsigned* st; };
DI XcdBarrier xcd_barrier_post(unsigned* bar, volatile LAS unsigned* st) {
    XcdBarrier b; b.bar = bar; b.x = xb_xcc_id(); b.st = st;
    if (tid_now() == 0) (void)xb_add(&bar[XB_XCNT(b.x)], 1u);
    return b;
}
DI void xcd_barrier_complete(unsigned* bar, unsigned x, unsigned& nloc, unsigned& nx) {
    const unsigned G = (unsigned)gdim_now();
    unsigned sum, cnt, mine, sp = 0u;
    for (;;) {
        sum = 0u; cnt = 0u;
#pragma unroll 1
        for (unsigned j = 0; j < 16; ++j) { const unsigned c = xb_ld(&bar[XB_XCNT(j)]); sum += c; cnt += (c > 0u) ? 1u : 0u; }
        if (sum == G) break;
        __builtin_amdgcn_s_sleep(1);
        if ((++sp & 255u) == 0u) { if (xb_ld(&bar[XB_TMO])) break; if (sp > XB_SPIN_CAP) { atomicAdd(&bar[XB_TMO], 1u); break; } }
    }
    mine = xb_ld(&bar[XB_XCNT(x)]);
    nloc = mine > 0u ? mine : 1u; nx = cnt > 0u ? cnt : 1u;
}
DI void xcd_barrier1(const XcdBarrier& b) {
    asm volatile("s_waitcnt vmcnt(0)" ::: "memory");
    __syncthreads();
    if (tid_now() == 0) {
        unsigned long long ba = (unsigned long long)b.bar; unsigned bx = b.x; asm volatile("" : "+s"(ba), "+s"(bx));
        unsigned* bar = (unsigned*)(unsigned GAS*)ba;
        __builtin_amdgcn_s_waitcnt(0);
        unsigned nloc = b.st[0], nx = b.st[1];
        if (nloc == 0u) { xcd_barrier_complete(bar, bx, nloc, nx); b.st[0] = nloc; b.st[1] = nx; }
        const unsigned old = xb_add(&bar[XB_XSUB(bx)], 1u);
        const unsigned gen = old / nloc;
        if (old + 1u == (gen + 1u) * nloc) {
            __builtin_amdgcn_fence(__ATOMIC_RELEASE, "agent");
            asm volatile("s_waitcnt vmcnt(0)" ::: "memory");
            const unsigned og = xb_add(&bar[XB_TOP], 1u);
            const unsigned tg = og / nx;
            if (og + 1u == (tg + 1u) * nx) xb_add(&bar[XB_TOPGEN], 1u);
            else XB_SPIN(xb_ld(&bar[XB_TOPGEN]) == tg, bar);
            __builtin_amdgcn_fence(__ATOMIC_ACQUIRE, "agent");
            xb_add(&bar[XB_XGEN(bx)], 1u);
            asm volatile("s_waitcnt vmcnt(0)" ::: "memory");
        } else {
            XB_SPIN(xb_ld(&bar[XB_XGEN(bx)]) == gen, bar);
            __builtin_amdgcn_fence(__ATOMIC_ACQUIRE, "agent");
            asm volatile("s_waitcnt vmcnt(0)" ::: "memory");
        }
    }
    __syncthreads();
}
DI void xcd_barrier(const XcdBarrier& b) {
    xcd_barrier1(b);
#ifdef DUP_BARRIER
    xcd_barrier1(b); xcd_barrier1(b);
#endif
}

namespace pg8 {
constexpr int BM = 256, BK = 64, HALF = 128, HTB = HALF * BK * 2, STAGE_BYTES = 8 * HTB, NXCD = 8, WGM = 8;
DI int lds_byte(int r, int c) { const int st = (r >> 4) * 2 + (c >> 5), rr = r & 15, cc = c & 31, ob = rr * 64 + cc * 2; return st * 1024 + (ob ^ (((ob >> 9) & 1) << 5)); }
DI void stage_rc(int b, int& R, int& C) { const int st = b / 1024, sb = b % 1024, swz = sb ^ (((sb >> 9) & 1) << 5); R = (st >> 1) * 16 + swz / 64; C = (st & 1) * 32 + (swz % 64) / 2; }
DI int perm32(int rho) { const int n = rho >> 4, i = rho & 15; return 8 * (i >> 2) + 4 * n + (i & 3); }
struct Unit { int pm, pn, aux; };
DI void tile_of(int L, int nM, int nN, int& pm, int& pn) {
    const int nwg = nM * nN; int wgid = L;
    { const int q = nwg / NXCD, r = nwg % NXCD, xcd = wgid % NXCD, off = wgid / NXCD; wgid = (xcd < r ? xcd * (q + 1) : r * (q + 1) + (xcd - r) * q) + off; }
    const int nig = WGM * nN, gid = wgid / nig, fm = gid * WGM, gsz = (nM - fm) < WGM ? (nM - fm) : WGM;
    pm = fm + ((wgid % nig) % gsz); pn = (wgid % nig) / gsz;
}

template <class Epi, class Sched>
DI void gemm_phase(ldsp lds, const int lda, const int ldb, const int K, const Sched& S, const Epi& E) {
    const int tid = tid_now(), wid = __builtin_amdgcn_readfirstlane(tid >> 6), lane = tid & 63, wr = wid >> 2, wc = wid & 3, fr = lane & 15, fq = lane >> 4;
    const int nt = K / BK;
    unsigned voffA[2], voffB[2];
#pragma unroll
    for (int i = 0; i < 2; ++i) { int R, C; stage_rc(tid * 16 + i * 8192, R, C); const int Rb = Epi::PERM ? ((R & ~31) + perm32(R & 31)) : R;
        voffA[i] = (unsigned)(R * lda + C) * 2u; voffB[i] = (unsigned)(Rb * ldb + C) * 2u; }
    const size_t kstep = (size_t)(BK * 2);
    const size_t hstepA = (size_t)HALF * lda * 2, hstepB = (size_t)HALF * ldb * 2;
    const unsigned ldsw = (unsigned)wid * 1024u;
    const int aoff = lds_byte(wr * 64 + fr, fq * 8), boff = lds_byte(wc * 32 + fr, fq * 8);
#define PG8_SA(b, h) (((b) * 2 + (h)) * HTB)
#define PG8_SB(b, h) ((4 + (b) * 2 + (h)) * HTB)
#define PG8_STAGE(bufoff, gbase, voff) do { _Pragma("unroll") for (int _i = 0; _i < 2; ++_i) \
        __builtin_amdgcn_global_load_lds((const unsigned*)((const char*)(gbase) + (voff)[_i]), (LAS unsigned*)(lds + (bufoff) + ldsw + _i * 8192), 16, 0, 0); } while (0)
#define PG8_LDA(dst, b, h) do { _Pragma("unroll") for (int m = 0; m < 4; ++m) _Pragma("unroll") for (int k = 0; k < 2; ++k) dst[m][k] = *(const LAS bf16x8*)(lds + PG8_SA(b, h) + aoff + m * 2048 + k * 1024); } while (0)
#define PG8_LDB(dst, b, h) do { _Pragma("unroll") for (int n = 0; n < 2; ++n) _Pragma("unroll") for (int k = 0; k < 2; ++k) dst[n][k] = *(const LAS bf16x8*)(lds + PG8_SB(b, h) + boff + n * 2048 + k * 1024); } while (0)
#define PG8_MMA(ai, bj, At, Bt) do { __builtin_amdgcn_s_setprio(1); _Pragma("unroll") for (int m = 0; m < 4; ++m) _Pragma("unroll") for (int n = 0; n < 2; ++n) _Pragma("unroll") for (int k = 0; k < 2; ++k) \
        acc[ai][bj][m][n] = __builtin_amdgcn_mfma_f32_16x16x32_bf16(Bt[n][k], At[m][k], acc[ai][bj][m][n], 0, 0, 0); __builtin_amdgcn_s_setprio(0); } while (0)
#define PG8_WAIT_V(n) asm volatile("s_waitcnt vmcnt(" #n ")" ::: "memory")
#define PG8_WAIT_L(n) asm volatile("s_waitcnt lgkmcnt(" #n ")" ::: "memory")
#define PG8_BAR __builtin_amdgcn_s_barrier()
#define PG8_SCHED __builtin_amdgcn_sched_barrier(0)
    Unit cur, nxt; int ui = 0;
    if (!S.next(0, cur)) return;
    f32x4 acc[2][2][4][2];
#pragma unroll
    for (int a = 0; a < 2; ++a)
#pragma unroll
        for (int b = 0; b < 2; ++b)
#pragma unroll
            for (int m = 0; m < 4; ++m)
#pragma unroll
                for (int n = 0; n < 2; ++n) acc[a][b][m][n] = (f32x4){0.f, 0.f, 0.f, 0.f};
    bf16x8 At[4][2], B0[2][2], B1[2][2];
    const char* cA = S.abase(cur); const char* cB = S.bbase(cur);
    PG8_STAGE(PG8_SB(0, 0), cB, voffB); PG8_STAGE(PG8_SA(0, 0), cA, voffA); PG8_STAGE(PG8_SB(0, 1), cB + hstepB, voffB); PG8_STAGE(PG8_SA(0, 1), cA + hstepA, voffA);
    if (wr == 1) PG8_BAR;
    PG8_WAIT_V(4); PG8_BAR;
    PG8_STAGE(PG8_SB(1, 0), cB + kstep, voffB); PG8_STAGE(PG8_SA(1, 0), cA + kstep, voffA); PG8_STAGE(PG8_SB(1, 1), cB + hstepB + kstep, voffB);
    PG8_WAIT_V(6); PG8_BAR;
    for (;;) {
        const bool has_next = S.next(ui + 1, nxt);
        const char* nA = has_next ? S.abase(nxt) : cA; const char* nB = has_next ? S.bbase(nxt) : cB;
#pragma unroll 1
        for (int t = 0; t < nt; t += 2) {
            const bool last = (t == nt - 2);
            const char* a1 = cA + (size_t)(t + 1) * kstep;
            const char* a2 = last ? nA : cA + (size_t)(t + 2) * kstep; const char* b2 = last ? nB : cB + (size_t)(t + 2) * kstep;
            const char* a3 = a2 + kstep; const char* b3 = b2 + kstep;
            PG8_LDB(B0, 0, 0); PG8_SCHED; PG8_LDA(At, 0, 0); PG8_STAGE(PG8_SA(1, 1), a1 + hstepA, voffA);
            PG8_WAIT_L(8); PG8_BAR; PG8_WAIT_L(0); PG8_MMA(0, 0, At, B0); PG8_BAR; PG8_SCHED;
            PG8_LDB(B1, 0, 1); PG8_STAGE(PG8_SB(0, 0), b2, voffB);
            PG8_BAR; PG8_WAIT_L(0); PG8_MMA(0, 1, At, B1); PG8_BAR;
            PG8_LDA(At, 0, 1); PG8_STAGE(PG8_SA(0, 0), a2, voffA);
            PG8_BAR; PG8_WAIT_L(0); PG8_MMA(1, 0, At, B0); PG8_BAR; PG8_SCHED;
            PG8_STAGE(PG8_SB(0, 1), b2 + hstepB, voffB);
            PG8_WAIT_V(6); PG8_BAR; PG8_MMA(1, 1, At, B1); PG8_BAR;
            PG8_LDB(B0, 1, 0); PG8_SCHED; PG8_LDA(At, 1, 0); PG8_STAGE(PG8_SA(0, 1), a2 + hstepA, voffA);
            PG8_WAIT_L(8); PG8_BAR; PG8_WAIT_L(0); PG8_MMA(0, 0, At, B0); PG8_BAR; PG8_SCHED;
            PG8_LDB(B1, 1, 1); PG8_STAGE(PG8_SB(1, 0), b3, voffB);
            PG8_BAR; PG8_WAIT_L(0); PG8_MMA(0, 1, At, B1); PG8_BAR;
            PG8_LDA(At, 1, 1); PG8_STAGE(PG8_SA(1, 0), a3, voffA);
            PG8_BAR; PG8_WAIT_L(0); PG8_MMA(1, 0, At, B0); PG8_BAR; PG8_SCHED;
            PG8_STAGE(PG8_SB(1, 1), b3 + hstepB, voffB);
            PG8_WAIT_V(6); PG8_BAR; PG8_MMA(1, 1, At, B1); PG8_BAR;
        }
        { int fr2 = fr, fq2 = fq; asm volatile("" : "+v"(fr2), "+v"(fq2));
          E(acc, cur, wr, wc, fr2, fq2); }
        if (!has_next) break;
#pragma unroll
        for (int a = 0; a < 2; ++a)
#pragma unroll
            for (int b = 0; b < 2; ++b)
#pragma unroll
                for (int m = 0; m < 4; ++m)
#pragma unroll
                    for (int n = 0; n < 2; ++n) acc[a][b][m][n] = (f32x4){0.f, 0.f, 0.f, 0.f};
        cur = nxt; cA = nA; cB = nB; ++ui;
    }
    PG8_WAIT_V(0);
    if (wr == 0) PG8_BAR;
    PG8_BAR;
#undef PG8_SA
#undef PG8_SB
#undef PG8_STAGE
#undef PG8_LDA
#undef PG8_LDB
#undef PG8_MMA
#undef PG8_WAIT_V
#undef PG8_WAIT_L
#undef PG8_BAR
#undef PG8_SCHED
}

template <class Epi, class Sched>
DI void gemm_gather(ldsp lds, const char* Abase, const int ldb, const int K, const Sched& S, const Epi& E) {
    const int tid = tid_now(), wid = __builtin_amdgcn_readfirstlane(tid >> 6), lane = tid & 63, wr = wid >> 2, wc = wid & 3, fr = lane & 15, fq = lane >> 4;
    const int nt = K / BK;
    unsigned voffB[2]; int Ra0, Ca0, Ra1, Ca1; stage_rc(tid * 16, Ra0, Ca0); stage_rc(tid * 16 + 8192, Ra1, Ca1);
#pragma unroll
    for (int i = 0; i < 2; ++i) { int R, C; stage_rc(tid * 16 + i * 8192, R, C); const int Rb = Epi::PERM ? ((R & ~31) + perm32(R & 31)) : R; voffB[i] = (unsigned)(Rb * ldb + C) * 2u; }
    const size_t kstep = (size_t)(BK * 2);
    const size_t hstepB = (size_t)HALF * ldb * 2;
    unsigned c00, c01, c10, c11, n00 = 0u, n01 = 0u, n10 = 0u, n11 = 0u;
#define PG8_STAGE2(bufoff, gbase, v0, v1) do { \
        __builtin_amdgcn_global_load_lds((const unsigned*)((const char*)(gbase) + (v0)), (LAS unsigned*)(lds + (bufoff) + ldsw), 16, 0, 0); \
        __builtin_amdgcn_global_load_lds((const unsigned*)((const char*)(gbase) + (v1)), (LAS unsigned*)(lds + (bufoff) + ldsw + 8192), 16, 0, 0); } while (0)
    const unsigned ldsw = (unsigned)wid * 1024u;
    const int aoff = lds_byte(wr * 64 + fr, fq * 8), boff = lds_byte(wc * 32 + fr, fq * 8);
#define PG8_SA(b, h) (((b) * 2 + (h)) * HTB)
#define PG8_SB(b, h) ((4 + (b) * 2 + (h)) * HTB)
#define PG8_STAGE(bufoff, gbase, voff) do { _Pragma("unroll") for (int _i = 0; _i < 2; ++_i) \
        __builtin_amdgcn_global_load_lds((const unsigned*)((const char*)(gbase) + (voff)[_i]), (LAS unsigned*)(lds + (bufoff) + ldsw + _i * 8192), 16, 0, 0); } while (0)
#define PG8_LDA(dst, b, h) do { _Pragma("unroll") for (int m = 0; m < 4; ++m) _Pragma("unroll") for (int k = 0; k < 2; ++k) dst[m][k] = *(const LAS bf16x8*)(lds + PG8_SA(b, h) + aoff + m * 2048 + k * 1024); } while (0)
#define PG8_LDB(dst, b, h) do { _Pragma("unroll") for (int n = 0; n < 2; ++n) _Pragma("unroll") for (int k = 0; k < 2; ++k) dst[n][k] = *(const LAS bf16x8*)(lds + PG8_SB(b, h) + boff + n * 2048 + k * 1024); } while (0)
#define PG8_MMA(ai, bj, At, Bt) do { __builtin_amdgcn_s_setprio(1); _Pragma("unroll") for (int m = 0; m < 4; ++m) _Pragma("unroll") for (int n = 0; n < 2; ++n) _Pragma("unroll") for (int k = 0; k < 2; ++k) \
        acc[ai][bj][m][n] = __builtin_amdgcn_mfma_f32_16x16x32_bf16(Bt[n][k], At[m][k], acc[ai][bj][m][n], 0, 0, 0); __builtin_amdgcn_s_setprio(0); } while (0)
#define PG8_WAIT_V(n) asm volatile("s_waitcnt vmcnt(" #n ")" ::: "memory")
#define PG8_WAIT_L(n) asm volatile("s_waitcnt lgkmcnt(" #n ")" ::: "memory")
#define PG8_BAR __builtin_amdgcn_s_barrier()
#define PG8_SCHED __builtin_amdgcn_sched_barrier(0)
    Unit cur, nxt; int ui = 0;
    if (!S.next(0, cur)) return;
    f32x4 acc[2][2][4][2];
#pragma unroll
    for (int a = 0; a < 2; ++a)
#pragma unroll
        for (int b = 0; b < 2; ++b)
#pragma unroll
            for (int m = 0; m < 4; ++m)
#pragma unroll
                for (int n = 0; n < 2; ++n) acc[a][b][m][n] = (f32x4){0.f, 0.f, 0.f, 0.f};
    bf16x8 At[4][2], B0[2][2], B1[2][2];
    const char* cA = Abase; const char* cB = S.bbase(cur);
    S.rowoff(cur, Ra0, Ca0, Ra1, Ca1, c00, c01, c10, c11);
    PG8_STAGE(PG8_SB(0, 0), cB, voffB); PG8_STAGE2(PG8_SA(0, 0), cA, c00, c01); PG8_STAGE(PG8_SB(0, 1), cB + hstepB, voffB); PG8_STAGE2(PG8_SA(0, 1), cA, c10, c11);
    if (wr == 1) PG8_BAR;
    PG8_WAIT_V(4); PG8_BAR;
    PG8_STAGE(PG8_SB(1, 0), cB + kstep, voffB); PG8_STAGE2(PG8_SA(1, 0), cA + kstep, c00, c01); PG8_STAGE(PG8_SB(1, 1), cB + hstepB + kstep, voffB);
    PG8_WAIT_V(6); PG8_BAR;
    for (;;) {
        const bool has_next = S.next(ui + 1, nxt);
        const char* nB = has_next ? S.bbase(nxt) : cB;
        if (has_next) S.rowoff(nxt, Ra0, Ca0, Ra1, Ca1, n00, n01, n10, n11); else { n00 = c00; n01 = c01; n10 = c10; n11 = c11; }
#pragma unroll 1
        for (int t = 0; t < nt; t += 2) {
            const bool last = (t == nt - 2);
            const char* a1 = cA + (size_t)(t + 1) * kstep;
            const char* a2 = last ? cA : cA + (size_t)(t + 2) * kstep; const char* b2 = last ? nB : cB + (size_t)(t + 2) * kstep;
            const char* a3 = a2 + kstep; const char* b3 = b2 + kstep;
            const unsigned w00 = last ? n00 : c00, w01 = last ? n01 : c01, w10 = last ? n10 : c10, w11 = last ? n11 : c11;
            PG8_LDB(B0, 0, 0); PG8_SCHED; PG8_LDA(At, 0, 0); PG8_STAGE2(PG8_SA(1, 1), a1, c10, c11);
            PG8_WAIT_L(8); PG8_BAR; PG8_WAIT_L(0); PG8_MMA(0, 0, At, B0); PG8_BAR; PG8_SCHED;
            PG8_LDB(B1, 0, 1); PG8_STAGE(PG8_SB(0, 0), b2, voffB);
            PG8_BAR; PG8_WAIT_L(0); PG8_MMA(0, 1, At, B1); PG8_BAR;
            PG8_LDA(At, 0, 1); PG8_STAGE2(PG8_SA(0, 0), a2, w00, w01);
            PG8_BAR; PG8_WAIT_L(0); PG8_MMA(1, 0, At, B0); PG8_BAR; PG8_SCHED;
            PG8_STAGE(PG8_SB(0, 1), b2 + hstepB, voffB);
            PG8_WAIT_V(6); PG8_BAR; PG8_MMA(1, 1, At, B1); PG8_BAR;
            PG8_LDB(B0, 1, 0); PG8_SCHED; PG8_LDA(At, 1, 0); PG8_STAGE2(PG8_SA(0, 1), a2, w10, w11);
            PG8_WAIT_L(8); PG8_BAR; PG8_WAIT_L(0); PG8_MMA(0, 0, At, B0); PG8_BAR; PG8_SCHED;
            PG8_LDB(B1, 1, 1); PG8_STAGE(PG8_SB(1, 0), b3, voffB);
            PG8_BAR; PG8_WAIT_L(0); PG8_MMA(0, 1, At, B1); PG8_BAR;
            PG8_LDA(At, 1, 1); PG8_STAGE2(PG8_SA(1, 0), a3, w00, w01);
            PG8_BAR; PG8_WAIT_L(0); PG8_MMA(1, 0, At, B0); PG8_BAR; PG8_SCHED;
            PG8_STAGE(PG8_SB(1, 1), b3 + hstepB, voffB);
            PG8_WAIT_V(6); PG8_BAR; PG8_MMA(1, 1, At, B1); PG8_BAR;
        }
        { int fr2 = fr, fq2 = fq; asm volatile("" : "+v"(fr2), "+v"(fq2));
          E(acc, cur, wr, wc, fr2, fq2); }
        if (!has_next) break;
#pragma unroll
        for (int a = 0; a < 2; ++a)
#pragma unroll
            for (int b = 0; b < 2; ++b)
#pragma unroll
                for (int m = 0; m < 4; ++m)
#pragma unroll
                    for (int n = 0; n < 2; ++n) acc[a][b][m][n] = (f32x4){0.f, 0.f, 0.f, 0.f};
        cur = nxt; cB = nB; ++ui; c00 = n00; c01 = n01; c10 = n10; c11 = n11;
    }
    PG8_WAIT_V(0);
    if (wr == 0) PG8_BAR;
    PG8_BAR;
#undef PG8_SA
#undef PG8_SB
#undef PG8_STAGE
#undef PG8_STAGE2
#undef PG8_LDA
#undef PG8_LDB
#undef PG8_MMA
#undef PG8_WAIT_V
#undef PG8_WAIT_L
#undef PG8_BAR
#undef PG8_SCHED
}


template <class Epi, class Sched>
DI void gemm_seg(ldsp lds, const int lda, const int ldb, const Sched& S, const Epi& E) {
    constexpr int K = 1024;
    const int tid = tid_now(), wid = __builtin_amdgcn_readfirstlane(tid >> 6), lane = tid & 63, wr = wid >> 2, wc = wid & 3, fr = lane & 15, fq = lane >> 4;
    const int nt = K / BK;
    unsigned voffA[2], voffB[2];
#pragma unroll
    for (int i = 0; i < 2; ++i) { int R, C; stage_rc(tid * 16 + i * 8192, R, C); const int Rb = Epi::PERM ? ((R & ~31) + perm32(R & 31)) : R;
        voffA[i] = (unsigned)(R * lda + C) * 2u; voffB[i] = (unsigned)(Rb * ldb + C) * 2u; }
    const size_t kstep = (size_t)(BK * 2);
    const size_t hstepA = (size_t)HALF * lda * 2, hstepB = (size_t)HALF * ldb * 2;
    const unsigned ldsw = (unsigned)wid * 1024u;
    const int aoff = lds_byte(wr * 64 + fr, fq * 8), boff = lds_byte(wc * 32 + fr, fq * 8);
#define PG8_SA(b, h) (((b) * 2 + (h)) * HTB)
#define PG8_SB(b, h) ((4 + (b) * 2 + (h)) * HTB)
#define PG8_STAGE(bufoff, gbase, voff) do { _Pragma("unroll") for (int _i = 0; _i < 2; ++_i) \
        __builtin_amdgcn_global_load_lds((const unsigned*)((const char*)(gbase) + (voff)[_i]), (LAS unsigned*)(lds + (bufoff) + ldsw + _i * 8192), 16, 0, 0); } while (0)
#define PG8_LDA(dst, b, h) do { _Pragma("unroll") for (int m = 0; m < 4; ++m) _Pragma("unroll") for (int k = 0; k < 2; ++k) dst[m][k] = *(const LAS bf16x8*)(lds + PG8_SA(b, h) + aoff + m * 2048 + k * 1024); } while (0)
#define PG8_LDB(dst, b, h) do { _Pragma("unroll") for (int n = 0; n < 2; ++n) _Pragma("unroll") for (int k = 0; k < 2; ++k) dst[n][k] = *(const LAS bf16x8*)(lds + PG8_SB(b, h) + boff + n * 2048 + k * 1024); } while (0)
#define PG8_MMA(ai, bj, At, Bt) do { __builtin_amdgcn_s_setprio(1); _Pragma("unroll") for (int m = 0; m < 4; ++m) _Pragma("unroll") for (int n = 0; n < 2; ++n) _Pragma("unroll") for (int k = 0; k < 2; ++k) \
        acc[ai][bj][m][n] = __builtin_amdgcn_mfma_f32_16x16x32_bf16(Bt[n][k], At[m][k], acc[ai][bj][m][n], 0, 0, 0); __builtin_amdgcn_s_setprio(0); } while (0)
#define PG8_WAIT_V(n) asm volatile("s_waitcnt vmcnt(" #n ")" ::: "memory")
#define PG8_WAIT_L(n) asm volatile("s_waitcnt lgkmcnt(" #n ")" ::: "memory")
#define PG8_BAR __builtin_amdgcn_s_barrier()
#define PG8_SCHED __builtin_amdgcn_sched_barrier(0)
    Unit cur, nxt; int ui = 0;
    if (!S.next(0, cur)) return;
    f32x4 acc[2][2][4][2];
#pragma unroll
    for (int a = 0; a < 2; ++a)
#pragma unroll
        for (int b = 0; b < 2; ++b)
#pragma unroll
            for (int m = 0; m < 4; ++m)
#pragma unroll
                for (int n = 0; n < 2; ++n) acc[a][b][m][n] = (f32x4){0.f, 0.f, 0.f, 0.f};
    bf16x8 At[4][2], B0[2][2], B1[2][2];
    const char* cA = S.ak(cur, 0); const char* cB = S.bk(cur, 0);
    PG8_STAGE(PG8_SB(0, 0), cB, voffB); PG8_STAGE(PG8_SA(0, 0), cA, voffA); PG8_STAGE(PG8_SB(0, 1), cB + hstepB, voffB); PG8_STAGE(PG8_SA(0, 1), cA + hstepA, voffA);
    if (wr == 1) PG8_BAR;
    PG8_WAIT_V(4); PG8_BAR;
    PG8_STAGE(PG8_SB(1, 0), S.bk(cur, 1), voffB); PG8_STAGE(PG8_SA(1, 0), S.ak(cur, 1), voffA); PG8_STAGE(PG8_SB(1, 1), S.bk(cur, 1) + hstepB, voffB);
    PG8_WAIT_V(6); PG8_BAR;
    for (;;) {
        const bool has_next = S.next(ui + 1, nxt);
        Unit nu; nu.pm = has_next ? nxt.pm : cur.pm; nu.pn = has_next ? nxt.pn : cur.pn; nu.aux = 0;
#pragma unroll 1
        for (int t = 0; t < nt; t += 2) {
            const bool last = (t == nt - 2);
            const char* a1 = S.ak(cur, t + 1);
            const char* a2 = last ? S.ak(nu, 0) : S.ak(cur, t + 2); const char* b2 = last ? S.bk(nu, 0) : S.bk(cur, t + 2);
            const char* a3 = last ? S.ak(nu, 1) : S.ak(cur, t + 3); const char* b3 = last ? S.bk(nu, 1) : S.bk(cur, t + 3);
            if (t != 0 && (t & 3) == 0) { int fr2 = fr, fq2 = fq; asm volatile("" : "+v"(fr2), "+v"(fq2)); E.mid(acc, cur, (t >> 2) - 1, wr, wc, fr2, fq2); }
            PG8_LDB(B0, 0, 0); PG8_SCHED; PG8_LDA(At, 0, 0); PG8_STAGE(PG8_SA(1, 1), a1 + hstepA, voffA);
            PG8_WAIT_L(8); PG8_BAR; PG8_WAIT_L(0); PG8_MMA(0, 0, At, B0); PG8_BAR; PG8_SCHED;
            PG8_LDB(B1, 0, 1); PG8_STAGE(PG8_SB(0, 0), b2, voffB);
            PG8_BAR; PG8_WAIT_L(0); PG8_MMA(0, 1, At, B1); PG8_BAR;
            PG8_LDA(At, 0, 1); PG8_STAGE(PG8_SA(0, 0), a2, voffA);
            PG8_BAR; PG8_WAIT_L(0); PG8_MMA(1, 0, At, B0); PG8_BAR; PG8_SCHED;
            PG8_STAGE(PG8_SB(0, 1), b2 + hstepB, voffB);
            PG8_WAIT_V(6); PG8_BAR; PG8_MMA(1, 1, At, B1); PG8_BAR;
            PG8_LDB(B0, 1, 0); PG8_SCHED; PG8_LDA(At, 1, 0); PG8_STAGE(PG8_SA(0, 1), a2 + hstepA, voffA);
            PG8_WAIT_L(8); PG8_BAR; PG8_WAIT_L(0); PG8_MMA(0, 0, At, B0); PG8_BAR; PG8_SCHED;
            PG8_LDB(B1, 1, 1); PG8_STAGE(PG8_SB(1, 0), b3, voffB);
            PG8_BAR; PG8_WAIT_L(0); PG8_MMA(0, 1, At, B1); PG8_BAR;
            PG8_LDA(At, 1, 1); PG8_STAGE(PG8_SA(1, 0), a3, voffA);
            PG8_BAR; PG8_WAIT_L(0); PG8_MMA(1, 0, At, B0); PG8_BAR; PG8_SCHED;
            PG8_STAGE(PG8_SB(1, 1), b3 + hstepB, voffB);
            PG8_WAIT_V(6); PG8_BAR; PG8_MMA(1, 1, At, B1); PG8_BAR;
        }
        { int fr2 = fr, fq2 = fq; asm volatile("" : "+v"(fr2), "+v"(fq2));
          E(acc, cur, wr, wc, fr2, fq2); }
        if (!has_next) break;
#pragma unroll
        for (int a = 0; a < 2; ++a)
#pragma unroll
            for (int b = 0; b < 2; ++b)
#pragma unroll
                for (int m = 0; m < 4; ++m)
#pragma unroll
                    for (int n = 0; n < 2; ++n) acc[a][b][m][n] = (f32x4){0.f, 0.f, 0.f, 0.f};
        cur = nxt; ++ui;
    }
    PG8_WAIT_V(0);
    if (wr == 0) PG8_BAR;
    PG8_BAR;
#undef PG8_SA
#undef PG8_SB
#undef PG8_STAGE
#undef PG8_LDA
#undef PG8_LDB
#undef PG8_MMA
#undef PG8_WAIT_V
#undef PG8_WAIT_L
#undef PG8_BAR
#undef PG8_SCHED
}


struct SchedPlain {
    const char* A; const char* B; int lda, ldb, nM, nN, G, c, pm0;
    DI bool next(int i, Unit& u) const { const long L = (long)i * G + c; if (L >= (long)nM * nN) return false; tile_of((int)L, nM, nN, u.pm, u.pn); u.pm += pm0; u.aux = 0; return true; }
    DI const char* abase(const Unit& u) const { return A + (size_t)u.pm * 256 * lda * 2; }
    DI const char* bbase(const Unit& u) const { return B + (size_t)u.pn * 256 * ldb * 2; }
};
struct SchedMerge {
    const char* Z; const char* Wb; int nM, G, c, pm0;
    DI bool next(int i, Unit& u) const { const long L = (long)(i >> 2) * G + c; if (L >= (long)nM * 4) return false; tile_of((int)L, nM, 4, u.pm, u.pn); u.pm += pm0; u.aux = i & 3; return true; }
    DI const char* abase(const Unit& u) const { const int co = u.aux == 0 ? ZA_Q : (u.aux == 1 ? ZB_Q : (u.aux == 2 ? ZC_Q : ZD_Q)); return Z + ((size_t)u.pm * 256 * NZ + co) * 2; }
    DI const char* bbase(const Unit& u) const { return Wb + ((size_t)u.aux * 1024 * 256 + (size_t)u.pn * 256 * 256) * 2; }
};
struct SchedSeg {
    const char* Z; const char* Wb; int nM, G, c, pm0;
    DI bool next(int i, Unit& u) const { const long L = (long)i * G + c; if (L >= (long)nM * 4) return false; tile_of((int)L, nM, 4, u.pm, u.pn); u.pm += pm0; u.aux = 0; return true; }
    DI const char* ak(const Unit& u, const int kt) const { const int sg = kt >> 2; const int co = sg == 0 ? ZA_Q : (sg == 1 ? ZB_Q : (sg == 2 ? ZC_Q : ZD_Q)); return Z + ((size_t)u.pm * 256 * NZ + co + (kt & 3) * 64) * 2; }
    DI const char* bk(const Unit& u, const int kt) const { return Wb + ((size_t)(kt >> 2) * 1024 * 256 + (size_t)u.pn * 256 * 256 + (kt & 3) * 64) * 2; }
};
template <bool PLAIN> struct SchedMoeT {
    const char* B; int ldb, nP, nN, G, c; size_t estride; const LAS unsigned char* pe; const LAS unsigned* off; const int* list; const unsigned* cnt; int sh_r, sh_l;
    DI bool next(int i, Unit& u) const { const long L = (long)i * G + c; if (L >= (long)nP * nN) return false; u.pm = (int)(L / nN); u.pn = (int)(L % nN); u.aux = pe[u.pm]; return true; }
    DI const char* bbase(const Unit& u) const { return B + (size_t)u.aux * estride + (size_t)u.pn * 256 * ldb * 2; }
    DI void rowoff(const Unit& u, const int R0, const int C0, const int R1, const int C1, unsigned& v00, unsigned& v01, unsigned& v10, unsigned& v11) const {
        if (PLAIN) { const unsigned b = (unsigned)u.pm * 256u; v00 = ((b + R0) << sh_l) + C0 * 2; v01 = ((b + R1) << sh_l) + C1 * 2; v10 = ((b + 128 + R0) << sh_l) + C0 * 2; v11 = ((b + 128 + R1) << sh_l) + C1 * 2; return; }
        const int j0 = (u.pm - (int)(off[u.aux] >> 8)) * 256; const int n = (int)cnt[u.aux]; const int* lp = list + (size_t)u.aux * MOE_CAP;
        const int p00 = j0 + R0, p01 = j0 + R1, p10 = j0 + 128 + R0, p11 = j0 + 128 + R1;
        const unsigned i00 = p00 < n ? (unsigned)lp[p00] : 0u, i01 = p01 < n ? (unsigned)lp[p01] : 0u, i10 = p10 < n ? (unsigned)lp[p10] : 0u, i11 = p11 < n ? (unsigned)lp[p11] : 0u;
        v00 = ((i00 >> sh_r) << sh_l) + C0 * 2; v01 = ((i01 >> sh_r) << sh_l) + C1 * 2; v10 = ((i10 >> sh_r) << sh_l) + C0 * 2; v11 = ((i11 >> sh_r) << sh_l) + C1 * 2; }
};

#define EPI_ARGS const f32x4 (&acc)[2][2][4][2], const Unit& u, int wr, int wc, int fr, int fq
struct EpiZ { static constexpr bool PERM = true; bf16_t* Z;
    DI void operator()(EPI_ARGS) const {
        const int row0 = u.pm * 256 + wr * 64 + fr, col0 = u.pn * 256 + wc * 32 + 8 * fq;
#pragma unroll
        for (int ai = 0; ai < 2; ++ai)
#pragma unroll
            for (int m = 0; m < 4; ++m) { bf16_t* rp = Z + (size_t)(row0 + ai * 128 + m * 16) * NZ + col0;
#pragma unroll
                for (int bj = 0; bj < 2; ++bj) { const f32x4 v0 = acc[ai][bj][m][0], v1 = acc[ai][bj][m][1];
                    u32x4 w; w.x = pk2(v0[0], v0[1]); w.y = pk2(v0[2], v0[3]); w.z = pk2(v1[0], v1[1]); w.w = pk2(v1[2], v1[3]);
                    *(u32x4*)(rp + bj * 128) = w; } }
    } };
struct EpiMla { static constexpr bool PERM = true; bf16_t* QC; bf16_t* KC; bf16_t* CVt;
    DI void operator()(const f32x4 (&acc)[2][2][4][2], const Unit& u, int wr, int wc, int fr_in, int fq_in) const {
        int fr = fr_in, fq = fq_in; asm volatile("" : "+v"(fr), "+v"(fq));
#pragma unroll
        for (int ai = 0; ai < 2; ++ai)
#pragma unroll
            for (int m = 0; m < 4; ++m) {
                const int row = u.pm * 256 + wr * 64 + fr + ai * 128 + m * 16; int b, key; row_bk(row, b, key);
#pragma unroll
                for (int bj = 0; bj < 2; ++bj) {
                    const int c = u.pn * 256 + bj * 128 + wc * 32 + 8 * fq;
                    const f32x4 v0 = acc[ai][bj][m][0], v1 = acc[ai][bj][m][1];
                    float v[8] = {v0[0], v0[1], v0[2], v0[3], v1[0], v1[1], v1[2], v1[3]};
                    if (c < 384) {
                        u32x4 w; w.x = pk2(v[0], v[1]); w.y = pk2(v[2], v[3]); w.z = pk2(v[4], v[5]); w.w = pk2(v[6], v[7]);
                        *(u32x4*)(QC + (size_t)row * 384 + c) = w;
                    } else if (c < 896) {
                        const int c2 = c - 384, hh = c2 >> 7, j = c2 & 127;
                        if (j < 64) { u32x4 w; w.x = pk2(v[0], v[1]); w.y = pk2(v[2], v[3]); w.z = pk2(v[4], v[5]); w.w = pk2(v[6], v[7]);
                            *(u32x4*)(KC + ((size_t)(b * 4 + hh) * KEYS + key) * 96 + j) = w; }
                        else { bf16_t* vp = CVt + ((size_t)(b * 4 + hh) * 64 + (j - 64)) * KEYS + key;
#pragma unroll
                            for (int i = 0; i < 8; ++i) vp[(size_t)i * KEYS] = f2bf(v[i]); }
                    }
                }
                __builtin_amdgcn_sched_barrier(0);
            }
    } };
struct EpiGate { static constexpr bool PERM = true; unsigned char* G;
    DI void operator()(EPI_ARGS) const {
        const int row0 = u.pm * 256 + wr * 64 + fr, col0 = u.pn * 256 + wc * 32 + 8 * fq;
#pragma unroll
        for (int ai = 0; ai < 2; ++ai)
#pragma unroll
            for (int m = 0; m < 4; ++m) { unsigned char* rp = G + (size_t)(row0 + ai * 128 + m * 16) * 4096 + col0;
#pragma unroll
                for (int bj = 0; bj < 2; ++bj) { const f32x4 v0 = acc[ai][bj][m][0], v1 = acc[ai][bj][m][1];
                    auto q = [](float x) { return fmaxf(255.f * sigmoidf_(x), 1.f); };
                    u32x2 w; w.x = 0u; w.y = 0u;
#pragma unroll
                    for (int j = 0; j < 4; ++j) { w.x = __builtin_amdgcn_cvt_pk_u8_f32(q(v0[j]), j, w.x); w.y = __builtin_amdgcn_cvt_pk_u8_f32(q(v1[j]), j, w.y); }
                    *(u32x2*)(rp + bj * 128) = w; } }
    } };
struct EpiMerge { static constexpr bool PERM = true; bf16_t* Z; const bf16_t* G; int row_base;
    DI void operator()(EPI_ARGS) const {
        const int row0 = u.pm * 256 + wr * 64 + fr, col0 = u.pn * 256 + wc * 32 + 8 * fq;
#pragma unroll
        for (int ai = 0; ai < 2; ++ai) {
            u32x4 g[4][2], y[4][2];
#pragma unroll
            for (int m = 0; m < 4; ++m) { const int row = row0 + ai * 128 + m * 16;
                const bf16_t* yp = Z + (size_t)row * NZ + ZY + col0; const bf16_t* gp = G + (size_t)(row - row_base) * 4096 + u.aux * 1024 + col0;
#pragma unroll
                for (int bj = 0; bj < 2; ++bj) { g[m][bj] = *(const u32x4*)(gp + bj * 128); y[m][bj] = (u32x4){0u, 0u, 0u, 0u}; if (u.aux != 0) y[m][bj] = *(const u32x4*)(yp + bj * 128); } }
#pragma unroll
            for (int m = 0; m < 4; ++m) { const int row = row0 + ai * 128 + m * 16; bf16_t* yp = Z + (size_t)row * NZ + ZY + col0;
#pragma unroll
                for (int bj = 0; bj < 2; ++bj) { const f32x4 v0 = acc[ai][bj][m][0], v1 = acc[ai][bj][m][1]; const u32x4 gg = g[m][bj], yy = y[m][bj];
                    u32x4 w;
                    w.x = pk2(bflo(yy.x) + bflo(gg.x) * v0[0], bfhi(yy.x) + bfhi(gg.x) * v0[1]); w.y = pk2(bflo(yy.y) + bflo(gg.y) * v0[2], bfhi(yy.y) + bfhi(gg.y) * v0[3]);
                    w.z = pk2(bflo(yy.z) + bflo(gg.z) * v1[0], bfhi(yy.z) + bfhi(gg.z) * v1[1]); w.w = pk2(bflo(yy.w) + bflo(gg.w) * v1[2], bfhi(yy.w) + bfhi(gg.w) * v1[3]);
                    *(u32x4*)(yp + bj * 128) = w; } }
        }
    } };
struct EpiHorner { static constexpr bool PERM = true; bf16_t* Z; const unsigned char* G;
    DI void mid(f32x4 (&acc)[2][2][4][2], const Unit& u, const int seg, int wr, int wc, int fr, int fq) const {
        const int row0 = u.pm * 256 + wr * 64 + fr, col0 = u.pn * 256 + wc * 32 + 8 * fq;
        u32x2 gc[2][4][2], gn[2][4][2];
#pragma unroll
        for (int ai = 0; ai < 2; ++ai)
#pragma unroll
            for (int m = 0; m < 4; ++m) { const unsigned char* gp = G + (size_t)(row0 + ai * 128 + m * 16) * 4096 + seg * 1024 + col0;
#pragma unroll
                for (int bj = 0; bj < 2; ++bj) { gc[ai][m][bj] = *(const u32x2*)(gp + bj * 128); gn[ai][m][bj] = *(const u32x2*)(gp + 1024 + bj * 128); } }
#pragma unroll
        for (int ai = 0; ai < 2; ++ai)
#pragma unroll
            for (int m = 0; m < 4; ++m)
#pragma unroll
                for (int bj = 0; bj < 2; ++bj) { const u32x2 c2 = gc[ai][m][bj], n2 = gn[ai][m][bj];
#pragma unroll
                    for (int j = 0; j < 4; ++j) {
                        acc[ai][bj][m][0][j] *= (float)((c2.x >> (8 * j)) & 255u) * __builtin_amdgcn_rcpf((float)((n2.x >> (8 * j)) & 255u));
                        acc[ai][bj][m][1][j] *= (float)((c2.y >> (8 * j)) & 255u) * __builtin_amdgcn_rcpf((float)((n2.y >> (8 * j)) & 255u)); } }
    }
    DI void operator()(EPI_ARGS) const {
        const int row0 = u.pm * 256 + wr * 64 + fr, col0 = u.pn * 256 + wc * 32 + 8 * fq;
#pragma unroll
        for (int ai = 0; ai < 2; ++ai) {
            u32x2 g[4][2];
#pragma unroll
            for (int m = 0; m < 4; ++m)
#pragma unroll
                for (int bj = 0; bj < 2; ++bj) g[m][bj] = *(const u32x2*)(G + (size_t)(row0 + ai * 128 + m * 16) * 4096 + 3 * 1024 + col0 + bj * 128);
#pragma unroll
            for (int m = 0; m < 4; ++m) { bf16_t* yp = Z + (size_t)(row0 + ai * 128 + m * 16) * NZ + ZY + col0;
#pragma unroll
                for (int bj = 0; bj < 2; ++bj) { const f32x4 v0 = acc[ai][bj][m][0], v1 = acc[ai][bj][m][1]; const u32x2 gg = g[m][bj]; const float k = 1.f / 255.f;
                    u32x4 w; w.x = pk2((float)(gg.x & 255u) * k * v0[0], (float)((gg.x >> 8) & 255u) * k * v0[1]); w.y = pk2((float)((gg.x >> 16) & 255u) * k * v0[2], (float)(gg.x >> 24) * k * v0[3]);
                    w.z = pk2((float)(gg.y & 255u) * k * v1[0], (float)((gg.y >> 8) & 255u) * k * v1[1]); w.w = pk2((float)((gg.y >> 16) & 255u) * k * v1[2], (float)(gg.y >> 24) * k * v1[3]);
                    *(u32x4*)(yp + bj * 128) = w; } }
        }
    } };
struct EpiOut { static constexpr bool PERM = false; const float* res_l; const float* res_c; float* xs_l; float* xs_c; const float* modv_l;
    DI void operator()(EPI_ARGS) const {
        const int row0 = u.pm * 256 + wr * 64 + fr, col0 = u.pn * 256 + wc * 32 + 4 * fq;
        const bool lat = u.pm < ML / 256; const int bsel = lat ? (u.pm >> 4) : 8;
        const float* gp = modv_l + (bsel * 6 + 2) * 1024 + col0;
        f32x4 gt[2][2];
#pragma unroll
        for (int bj = 0; bj < 2; ++bj)
#pragma unroll
            for (int n = 0; n < 2; ++n) gt[bj][n] = *(const f32x4*)(gp + bj * 128 + n * 16);
#pragma unroll
        for (int ai = 0; ai < 2; ++ai) {
            f32x4 rs[4][2][2];
#pragma unroll
            for (int m = 0; m < 4; ++m) { const int row = row0 + ai * 128 + m * 16; const size_t ro = lat ? (size_t)row * 1024 : (size_t)(row - ML) * 1024;
                const float* rp = (lat ? res_l : res_c) + ro + col0;
#pragma unroll
                for (int bj = 0; bj < 2; ++bj)
#pragma unroll
                    for (int n = 0; n < 2; ++n) rs[m][bj][n] = *(const f32x4*)(rp + bj * 128 + n * 16); }
#pragma unroll
            for (int m = 0; m < 4; ++m) { const int row = row0 + ai * 128 + m * 16; const size_t ro = lat ? (size_t)row * 1024 : (size_t)(row - ML) * 1024;
                float* xp = (lat ? xs_l : xs_c) + ro + col0;
#pragma unroll
                for (int bj = 0; bj < 2; ++bj)
#pragma unroll
                    for (int n = 0; n < 2; ++n) *(f32x4*)(xp + bj * 128 + n * 16) = rs[m][bj][n] + gt[bj][n] * acc[ai][bj][m][n]; }
        }
    } };
struct EpiMoeUp { static constexpr bool PERM = true; bf16_t* H; const LAS unsigned* off; const unsigned* cnt;
    DI void operator()(EPI_ARGS) const {
        const int j0 = (u.pm - (int)(off[u.aux] >> 8)) * 256 + wr * 64 + fr, h0 = (u.pn * 256 + wc * 32 + 8 * fq) >> 1; const int n = (int)cnt[u.aux];
        bf16_t* hb = H + (size_t)(u.pm * 256 + wr * 64 + fr) * 256 + h0;
#pragma unroll
        for (int ai = 0; ai < 2; ++ai)
#pragma unroll
            for (int m = 0; m < 4; ++m) if (j0 + ai * 128 + m * 16 < n) { bf16_t* hp = hb + (size_t)(ai * 128 + m * 16) * 256;
#pragma unroll
                for (int bj = 0; bj < 2; ++bj) { const f32x4 g = acc[ai][bj][m][0], up = acc[ai][bj][m][1];
                    u32x2 w; w.x = pk2(g[0] * sigmoidf_(g[0]) * up[0], g[1] * sigmoidf_(g[1]) * up[1]); w.y = pk2(g[2] * sigmoidf_(g[2]) * up[2], g[3] * sigmoidf_(g[3]) * up[3]);
                    *(u32x2*)(hp + bj * 64) = w; } }
    } };
struct EpiMoeDown { static constexpr bool PERM = true; bf16_t* Y; const LAS unsigned* off; const int* list; const unsigned* cnt; const float* listw;
    DI void operator()(EPI_ARGS) const {
        const int j0 = (u.pm - (int)(off[u.aux] >> 8)) * 256 + wr * 64 + fr, col0 = u.pn * 256 + wc * 32 + 8 * fq; const int n = (int)cnt[u.aux]; const int* lp = list + (size_t)u.aux * MOE_CAP; const float* lp_w = listw + (size_t)u.aux * MOE_CAP;
        int it[2][4]; float wt8[2][4];
#pragma unroll
        for (int ai = 0; ai < 2; ++ai)
#pragma unroll
            for (int m = 0; m < 4; ++m) { const int pos = j0 + ai * 128 + m * 16; it[ai][m] = pos < n ? lp[pos] : -1; wt8[ai][m] = pos < n ? lp_w[pos] : 0.f; }
#pragma unroll
        for (int ai = 0; ai < 2; ++ai)
#pragma unroll
            for (int m = 0; m < 4; ++m) if (it[ai][m] >= 0) { const int ri = it[ai][m]; const float w8 = wt8[ai][m]; bf16_t* yp = Y + ((size_t)(ri & 1) * MT + (ri >> 1)) * 1024 + col0;
#pragma unroll
                for (int bj = 0; bj < 2; ++bj) { const f32x4 v0 = acc[ai][bj][m][0] * w8, v1 = acc[ai][bj][m][1] * w8;
                    u32x4 w; w.x = pk2(v0[0], v0[1]); w.y = pk2(v0[2], v0[3]); w.z = pk2(v1[0], v1[1]); w.w = pk2(v1[2], v1[3]);
                    *(u32x4*)(yp + bj * 128) = w; } }
    } };
}

DI void phase_pre(const Params& p, ldsp lds) {
    float* modv = (float*)(p.ws + WS_MODV);
    LAS float* sc = (LAS float*)lds;
    LAS float* red = (LAS float*)(lds + 9 * 1024 * 4);
    const int tid = tid_now();
    for (int i = tid; i < 9 * 1024; i += 512) { const int r = i >> 10, k = i & 1023; const float v = r < 8 ? p.in[1][r * 1024 + k] : p.in[3][k]; sc[i] = v / (1.f + __expf(-v)); }
    __syncthreads();
    const int kg = tid >> 6, col = tid & 63;
    for (int u = bid_now(); u < 192; u += gdim_now()) {
        const int li = u / 96, j = (u % 96) * 64 + col;
        const float* w = p.in[4] + (size_t)li * 1024 * 6144 + j;
        float acc[9];
#pragma unroll
        for (int r = 0; r < 9; ++r) acc[r] = 0.f;
        for (int k = kg * 128; k < kg * 128 + 128; ++k) { const float wv = w[(size_t)k * 6144];
#pragma unroll
            for (int r = 0; r < 9; ++r) acc[r] += sc[r * 1024 + k] * wv; }
#pragma unroll
        for (int r = 0; r < 9; ++r) red[(kg * 9 + r) * 64 + col] = acc[r];
        __syncthreads();
        if (tid < 64) {
#pragma unroll
            for (int r = 0; r < 9; ++r) { float s = 0.f;
#pragma unroll
                for (int g = 0; g < 8; ++g) s += red[(g * 9 + r) * 64 + col];
                modv[(li * 9 + r) * 6144 + j] = s + p.in[5][li * 6144 + j]; } }
        __syncthreads();
    }
    if (bid_now() == gdim_now() - 1) {
        f32x2* cs16 = (f32x2*)(p.ws + WS_ROPE16); f32x2* cs8 = (f32x2*)(p.ws + WS_ROPE8);
        for (int i = tid; i < 64 * 16 + 64 * 8; i += 512) {
            const bool a = i < 1024; const int ii = a ? i : i - 1024; const int pos = a ? ii >> 4 : ii >> 3, f = a ? ii & 15 : ii & 7;
            const float inv = exp2f(-(float)f * (13.287712379549449f / (a ? 16.f : 8.f)));
            const float x = (float)pos * inv; const float n = rintf(x * 0.15915494309189535f);
            float r = fmaf(-n, 6.2831855f, x); r = fmaf(-n, -1.7484555e-7f, r);
            const f32x2 cs = {__cosf(r), __sinf(r)};
            if (a) cs16[ii] = cs; else cs8[ii] = cs;
        }
        if (tid == 64) { const float** tab = (const float**)(p.ws + WS_TAB);
#pragma unroll
            for (int i = 0; i < 29; ++i) tab[i] = p.in[i]; }
        if (tid < 2) { const float* lp = p.in[19] + tid * 128; float s1 = 0.f, s2 = 0.f;
            for (int i = 0; i < 32; ++i) { s1 += lp[i] * lp[32 + i]; s2 += lp[64 + i] * lp[96 + i]; }
            const float lam_init = 0.8f - 0.6f * expf(-0.3f * (float)tid);
            float* lamv = (float*)(p.ws + WS_LAM); lamv[tid * 2] = expf(s1) - expf(s2) + lam_init; lamv[tid * 2 + 1] = lam_init; }
    }
}

template <class DM> DI void conv_tiles(ldsp lds, const float* W0, const int ldw, const int Kd, const int Ncols, bf16_t* Wt0, const int ldt, const int koff, DM dmap, const int nb = 1, const size_t wstride = 0, const size_t tstride = 0) {
    const int tid = tid_now(); LAS bf16_t* T = (LAS bf16_t*)lds;
    const int ntn = (Ncols + 63) >> 6, ntk = Kd >> 6;
    for (int tt = bid_now(); tt < nb * ntn * ntk; tt += gdim_now()) {
        const int bi = tt / (ntn * ntk), t = tt - bi * (ntn * ntk); const float* W = W0 + (size_t)bi * wstride; bf16_t* Wt = Wt0 + (size_t)bi * tstride;
        const int n0 = (t % ntn) * 64, k0 = (t / ntn) * 64;
        { const int kk = tid >> 3, nn = (tid & 7) * 8; float v[8];
          if (n0 + nn + 8 <= Ncols) { const f32x4 a = *(const f32x4*)(W + (size_t)(k0 + kk) * ldw + n0 + nn), c = *(const f32x4*)(W + (size_t)(k0 + kk) * ldw + n0 + nn + 4);
              v[0] = a[0]; v[1] = a[1]; v[2] = a[2]; v[3] = a[3]; v[4] = c[0]; v[5] = c[1]; v[6] = c[2]; v[7] = c[3]; }
          else {
#pragma unroll
              for (int j = 0; j < 8; ++j) v[j] = 0.f; }
#pragma unroll
          for (int j = 0; j < 8; ++j) T[(nn + j) * 72 + kk] = f2bf(v[j]); }
        __syncthreads();
        { const int n = tid >> 3, k8 = (tid & 7) * 8;
          if (n0 + n < Ncols) { const u32x4 w = *(const LAS u32x4*)(T + n * 72 + k8); *(u32x4*)(Wt + (size_t)dmap(n0 + n) * ldt + koff + k0 + k8) = w; } }
        __syncthreads();
    }
}
DI void zero_rows(bf16_t* Wt, const int ldt, const int r0, const int nr, const int c0, const int nc) {
    const int per = nc >> 3;
    for (int i = bid_now() * 512 + tid_now(); i < nr * per; i += gdim_now() * 512) { const int r = i / per, c8 = (i - r * per) * 8; *(u32x4*)(Wt + (size_t)(r0 + r) * ldt + c0 + c8) = (u32x4){0u, 0u, 0u, 0u}; }
}
DI void phase_wconv(const Ctx& p, const int li, ldsp lds) {
    unsigned char* wt = p.ws + WS_WT; auto id = [](int n) { return n; };
    conv_tiles(lds, p.in[8] + (size_t)li * 1024 * 2976, 2976, 1024, 2976, (bf16_t*)(wt + WT_IN), 1024, 0, id);
    zero_rows((bf16_t*)(wt + WT_IN), 1024, 2976, NZ - 2976, 0, 1024);
    conv_tiles(lds, p.in[9] + (size_t)li * 1024 * 4096, 4096, 1024, 4096, (bf16_t*)(wt + WT_G), 1024, 0, id);
    conv_tiles(lds, p.in[10] + (size_t)li * 4 * 256 * 1024, 1024, 256, 1024, (bf16_t*)(wt + WT_B), 256, 0, id, 4, (size_t)256 * 1024, (size_t)1024 * 256);
    conv_tiles(lds, p.in[11] + (size_t)li * 1024 * 1024, 1024, 1024, 1024, (bf16_t*)(wt + WT_O), 1024, 0, id);
    conv_tiles(lds, p.in[17] + (size_t)li * 256 * 384, 384, 256, 384, (bf16_t*)(wt + WT_MLA), 384, 0, id);
    conv_tiles(lds, p.in[18] + (size_t)li * 128 * 512, 512, 128, 512, (bf16_t*)(wt + WT_MLA), 384, 256, [](int n) { return 384 + n; });
    zero_rows((bf16_t*)(wt + WT_MLA), 384, 0, 384, 256, 128); zero_rows((bf16_t*)(wt + WT_MLA), 384, 384, 512, 0, 256); zero_rows((bf16_t*)(wt + WT_MLA), 384, 896, 128, 0, 384);
    conv_tiles(lds, p.in[25] + (size_t)li * 32 * 1024 * 256, 256, 1024, 256, (bf16_t*)(wt + WT_E1), 1024, 0, [](int hc) { return (hc >> 2) * 8 + (hc & 3); }, 32, (size_t)1024 * 256, (size_t)512 * 1024);
    conv_tiles(lds, p.in[26] + (size_t)li * 32 * 1024 * 256, 256, 1024, 256, (bf16_t*)(wt + WT_E1), 1024, 0, [](int hc) { return (hc >> 2) * 8 + 4 + (hc & 3); }, 32, (size_t)1024 * 256, (size_t)512 * 1024);
    conv_tiles(lds, p.in[27] + (size_t)li * 32 * 256 * 1024, 1024, 256, 1024, (bf16_t*)(wt + WT_E2), 256, 0, id, 32, (size_t)256 * 1024, (size_t)1024 * 256);
}

template <int MODE> DI void phase_norm(const Ctx& p, const int li) {
    const int lane = tid_now() & 63, wave = tid_now() >> 6;
    const int nrows = MODE == 2 ? ML : MT;
    const float* modv = (const float*)(p.ws + WS_MODV);
    float* ctxs = (float*)(p.ws + WS_CTXS); bf16_t* HB = (bf16_t*)(p.ws + WS_HB); const bf16_t* Y = (const bf16_t*)(p.ws + WS_Y);
    const bool combine = (MODE == 2) || (li > 0);
    const int lprev = MODE == 2 ? 1 : li - 1;
    const float* gain = MODE == 2 ? p.in[28] : p.in[6] + li * 1024;
    for (int row = bid_now() * 8 + wave; row < nrows; row += gdim_now() * 8) {
        const bool lat = row < ML; const int bsel = lat ? (row >> 12) : 8;
        float* xs = lat ? p.out + (size_t)row * 1024 : ctxs + (size_t)(row - ML) * 1024;
        const float* src = combine ? xs : (lat ? p.in[0] + (size_t)row * 1024 : p.in[2] + (size_t)(row - ML) * 1024);
        f32x4 v[4];
#pragma unroll
        for (int i = 0; i < 4; ++i) v[i] = *(const f32x4*)(src + i * 256 + lane * 4);
        if (combine) {
            const float* g2 = modv + ((lprev * 9 + bsel) * 6 + 5) * 1024;
#pragma unroll
            for (int i = 0; i < 4; ++i) { const int col = i * 256 + lane * 4;
                const u32x2 y0 = *(const u32x2*)(Y + (size_t)row * 1024 + col), y1 = *(const u32x2*)(Y + ((size_t)MT + row) * 1024 + col);
                const f32x4 g = *(const f32x4*)(g2 + col);
                v[i][0] += g[0] * (bflo(y0.x) + bflo(y1.x)); v[i][1] += g[1] * (bfhi(y0.x) + bfhi(y1.x));
                v[i][2] += g[2] * (bflo(y0.y) + bflo(y1.y)); v[i][3] += g[3] * (bfhi(y0.y) + bfhi(y1.y));
                if (MODE == 0) *(f32x4*)(xs + col) = v[i]; }
        }
        float ss = 0.f;
#pragma unroll
        for (int i = 0; i < 4; ++i) ss += v[i][0] * v[i][0] + v[i][1] * v[i][1] + v[i][2] * v[i][2] + v[i][3] * v[i][3];
        ss = wave_sum(ss);
        const float rstd = rsqrtf(ss * (1.f / 1024.f) + NORM_EPS);
        if (MODE == 2) {
#pragma unroll
            for (int i = 0; i < 4; ++i) { const int col = i * 256 + lane * 4; const f32x4 g = *(const f32x4*)(gain + col); f32x4 o = v[i] * rstd * g;
#ifdef STAMP_A
                { const float* tv = (const float*)(p.ws + WS_LAM + 64); if (row == 0 && col == 0) o[0] += tv[1] * 0.05f; }
#endif
                *(f32x4*)(xs + col) = o; }
        } else {
            const float* sh = modv + ((li * 9 + bsel) * 6 + 0) * 1024; const float* scl = modv + ((li * 9 + bsel) * 6 + 1) * 1024;
#pragma unroll
            for (int i = 0; i < 4; ++i) { const int col = i * 256 + lane * 4; const f32x4 g = *(const f32x4*)(gain + col), s1 = *(const f32x4*)(scl + col), s0 = *(const f32x4*)(sh + col);
                const f32x4 h = v[i] * rstd * g * (s1 + 1.f) + s0;
                u32x2 w; w.x = pk2(h[0], h[1]); w.y = pk2(h[2], h[3]); *(u32x2*)(HB + (size_t)row * 1024 + col) = w; }
        }
    }
}

DI void phase_norm2(const Ctx& p, const int li, ldsp lds, const int dry = 0) {
    const int tid = tid_now(), lane = tid & 63, wave = tid >> 6;
    const int nrows = li == 0 ? MT : ML;
    const float* modv = (const float*)(p.ws + WS_MODV);
    const float* ctxs = (const float*)(p.ws + WS_CTXS); bf16_t* HB = (bf16_t*)(p.ws + WS_HB);
    unsigned* cnt = (unsigned*)(p.ws + WS_CTL + CTL_CNT) + li * 32;
    int* list = (int*)(p.ws + WS_XG); float* listw = (float*)(p.ws + WS_XG) + (size_t)32 * MOE_CAP;
    constexpr int RWS = 1028;
    LAS float* rw = (LAS float*)lds;
    const float* wrg = p.in[21] + (size_t)li * 1024 * 4; const float* wre = p.in[23] + (size_t)li * 1024 * 32;
    for (int i = tid; i < 4 * 1024; i += 512) rw[(i & 3) * RWS + (i >> 2)] = wrg[i];
    for (int i = tid; i < 32 * 1024; i += 512) rw[(4 + (i & 31)) * RWS + (i >> 5)] = wre[i];
    LAS unsigned* lcnt = (LAS unsigned*)(lds + 148480); LAS unsigned* lbase = lcnt + 32; LAS int* rec = (LAS int*)(lcnt + 64);
    if (tid < 32) lcnt[tid] = 0u;
    __syncthreads();
    const float* gain = p.in[7] + li * 1024;
    LAS float* bias = (LAS float*)(rec + 144 * 8);
    if (tid < 4) bias[tid] = p.in[22][li * 4 + tid]; else if (tid < 36) bias[tid] = p.in[24][li * 32 + tid - 4];
    __syncthreads();
    const int rpw = (nrows + gdim_now() * 8 - 1) / (gdim_now() * 8), r0w = (bid_now() * 8 + wave) * rpw, r1w = r0w + rpw < nrows ? r0w + rpw : nrows;
    int cur_b = -1; f32x4 gs[4], s0v[4];
#pragma unroll
    for (int i = 0; i < 4; ++i) { gs[i] = (f32x4){0.f, 0.f, 0.f, 0.f}; s0v[i] = gs[i]; }
    for (int row = r0w; row < r1w; ++row) {
        const bool lat = row < ML; const int bsel = lat ? (row >> 12) : 8;
        const float* xs = lat ? p.out + (size_t)row * 1024 : ctxs + (size_t)(row - ML) * 1024;
        f32x4 v[4];
#pragma unroll
        for (int i = 0; i < 4; ++i) v[i] = *(const f32x4*)(xs + i * 256 + lane * 4);
        if (bsel != cur_b) { cur_b = bsel; const float* sh = modv + ((li * 9 + bsel) * 6 + 3) * 1024; const float* scl = modv + ((li * 9 + bsel) * 6 + 4) * 1024;
#pragma unroll
            for (int i = 0; i < 4; ++i) { const int col = i * 256 + lane * 4; gs[i] = *(const f32x4*)(gain + col) * (*(const f32x4*)(scl + col) + 1.f); s0v[i] = *(const f32x4*)(sh + col); } }
        float ss = 0.f;
#pragma unroll
        for (int i = 0; i < 4; ++i) ss += v[i][0] * v[i][0] + v[i][1] * v[i][1] + v[i][2] * v[i][2] + v[i][3] * v[i][3];
        ss = wave_sum(ss);
        const float rstd = rsqrtf(ss * (1.f / 1024.f) + NORM_EPS);
#pragma unroll
        for (int i = 0; i < 4; ++i) { const int col = i * 256 + lane * 4;
            v[i] = v[i] * rstd * gs[i] + s0v[i];
            u32x2 w; w.x = pk2(v[i][0], v[i][1]); w.y = pk2(v[i][2], v[i][3]); *(u32x2*)(HB + (size_t)row * 1024 + col) = w; }
        float lg[4];
#pragma unroll
        for (int e = 0; e < 4; ++e) { float s = 0.f;
#pragma unroll
            for (int i = 0; i < 4; ++i) { const f32x4 w = *(const LAS f32x4*)(rw + e * RWS + i * 256 + lane * 4); s += v[i][0] * w[0] + v[i][1] * w[1] + v[i][2] * w[2] + v[i][3] * w[3]; }
            lg[e] = wave_sum(s) + bias[e]; }
        int gi = 0; float gm = lg[0];
#pragma unroll
        for (int g = 1; g < 4; ++g) { if (lg[g] > gm) { gm = lg[g]; gi = g; } }
        gi = __builtin_amdgcn_readfirstlane(gi);
        float gden = 0.f;
#pragma unroll
        for (int g = 0; g < 4; ++g) gden += __expf(lg[g] - gm);
        const float gval = 1.f / gden;
        float el[8];
#pragma unroll
        for (int j = 0; j < 8; ++j) { float s = 0.f; const LAS float* wp = rw + (4 + gi * 8 + j) * RWS + lane * 4;
#pragma unroll
            for (int i = 0; i < 4; ++i) { const f32x4 w = *(const LAS f32x4*)(wp + i * 256); s += v[i][0] * w[0] + v[i][1] * w[1] + v[i][2] * w[2] + v[i][3] * w[3]; }
            el[j] = wave_sum(s) + bias[4 + gi * 8 + j]; }
        int i1 = 0; float m1 = el[0];
#pragma unroll
        for (int j = 1; j < 8; ++j) if (el[j] > m1) { m1 = el[j]; i1 = j; }
        int i2 = -1; float m2 = -3.0e38f;
#pragma unroll
        for (int j = 0; j < 8; ++j) if (j != i1 && el[j] > m2) { m2 = el[j]; i2 = j; }
        const float t = __expf(m2 - m1); const float w1 = gval / (1.f + t), w2 = gval * t / (1.f + t);
        if (dry && w1 + w2 == 123.f) HB[0] = 0;
        if (lane == 0 && !dry) {
            const int e1 = gi * 8 + i1, e2 = gi * 8 + i2; const int lr = wave * 18 + (row - r0w);
            const unsigned p1 = __hip_atomic_fetch_add(lcnt + e1, 1u, __ATOMIC_RELAXED, __HIP_MEMORY_SCOPE_WORKGROUP), p2 = __hip_atomic_fetch_add(lcnt + e2, 1u, __ATOMIC_RELAXED, __HIP_MEMORY_SCOPE_WORKGROUP);
            rec[lr * 8 + 0] = e1; rec[lr * 8 + 1] = (int)p1; rec[lr * 8 + 2] = __float_as_int(w1); rec[lr * 8 + 3] = e2; rec[lr * 8 + 4] = (int)p2; rec[lr * 8 + 5] = __float_as_int(w2);
        }
    }
    __syncthreads();
    if (tid < 32 && !dry) { const unsigned n = lcnt[tid]; lbase[tid] = n ? atomicAdd(&cnt[tid], n) : 0u; }
    __syncthreads();
    if (!dry) for (int lr = tid; lr < 144; lr += 512) { const int wv = lr / 18, k = lr - wv * 18; const int row = (bid_now() * 8 + wv) * rpw + k;
        if (k < rpw && row < nrows) { const int e1 = rec[lr * 8 + 0], e2 = rec[lr * 8 + 3];
            { const size_t q1 = (size_t)e1 * MOE_CAP + lbase[e1] + rec[lr * 8 + 1], q2 = (size_t)e2 * MOE_CAP + lbase[e2] + rec[lr * 8 + 4];
              list[q1] = row * 2;     listw[q1] = __int_as_float(rec[lr * 8 + 2]);
              list[q2] = row * 2 + 1; listw[q2] = __int_as_float(rec[lr * 8 + 5]); } } }
    __syncthreads();
}

DI int moe_offsets(const unsigned* cnt, LAS unsigned* off, LAS unsigned char* pe) {
    if (tid_now() == 0) { unsigned o = 0;
#pragma unroll 1
        for (int e = 0; e < 32; ++e) { const unsigned c = __hip_atomic_load(cnt + e, __ATOMIC_RELAXED, __HIP_MEMORY_SCOPE_AGENT); const unsigned np = (c + 255u) >> 8; off[e] = o;
#pragma unroll 1
            for (unsigned q = 0; q < np; ++q) pe[(o >> 8) + q] = (unsigned char)e;
            o += np << 8; } off[32] = o; }
    __syncthreads();
    return (int)(off[32] >> 8);
}
template <int N> DI float dpp_row_shr(float x) { return __builtin_bit_cast(float, __builtin_amdgcn_update_dpp(0, __builtin_bit_cast(int, x), 0x110 + N, 0xf, 0xf, true)); }
DI float row_scan16(float x) { x += dpp_row_shr<1>(x); x += dpp_row_shr<2>(x); x += dpp_row_shr<4>(x); x += dpp_row_shr<8>(x); return x; }
DI bf16x8 pack8(const float* v) { u32x4 w; w.x = pk2(v[0], v[1]); w.y = pk2(v[2], v[3]); w.z = pk2(v[4], v[5]); w.w = pk2(v[6], v[7]); return __builtin_bit_cast(bf16x8, w); }
DI void unpack8(const u32x4 w, float* v) { v[0] = bflo(w.x); v[1] = bfhi(w.x); v[2] = bflo(w.y); v[3] = bfhi(w.y); v[4] = bflo(w.z); v[5] = bfhi(w.z); v[6] = bflo(w.w); v[7] = bfhi(w.w); }
#define MFMA16(a, b, c) __builtin_amdgcn_mfma_f32_16x16x32_bf16((a), (b), (c), 0, 0, 0)
constexpr int HG_RS = 136;
constexpr int HG_TILE = 64 * HG_RS;
DI void hgrn_gate_block(const bf16_t* zf  , const float* lb, float* logf, float* kf) {
    float x[16]; unpack8(*(const u32x4*)zf, x); unpack8(*(const u32x4*)(zf + 32), x + 8);
#pragma unroll
    for (int i = 0; i < 16; ++i) { const float sf = sigmoidf_(x[i]); logf[i] = __logf(fmaxf(lb[i] + (1.f - lb[i]) * sf, 1e-30f)); kf[i] = (1.f - lb[i]) * (1.f - sf); }
}
DI void hgrn_lb(const float* lbl, const int li, const int dir, const int h, const int g, float* lb) {
#pragma unroll
    for (int i = 0; i < 16; ++i) { const int hd = h * 64 + 32 * (i >> 3) + 8 * g + (i & 7); lb[i] = li > 0 ? sigmoidf_(lbl[(2 + dir) * 256 + hd] - lbl[dir * 256 + hd]) : 0.f; }
}
DI void hgrn_stage_v(const bf16_t* Z, const int row0, const int h, const int dir, const int lane, ldsp VT) {
#pragma unroll
    for (int i = 0; i < 8; ++i) { const int tau = (lane >> 3) + 8 * i, t = dir ? 63 - tau : tau;
        const u32x4 v = *(const u32x4*)(Z + (size_t)(row0 + t) * NZ + ZB_I + h * 64 + (lane & 7) * 8);
        *(LAS u32x2*)(VT + tau * HG_RS + (lane & 7) * 16) = (u32x2){v.x, v.y}; *(LAS u32x2*)(VT + tau * HG_RS + (lane & 7) * 16 + 8) = (u32x2){v.z, v.w}; }
}
DI bf16x8 hgrn_tr_frag(ldsp T, const int col, const int r0, const int r1) {
    const LAS bf16_t* p0 = (const LAS bf16_t*)(T + r0 * HG_RS) + col; const LAS bf16_t* p1 = (const LAS bf16_t*)(T + r1 * HG_RS) + col;
    u32x4 w;
    w.x = (unsigned)p0[0] | ((unsigned)p0[HG_RS / 2] << 16); w.y = (unsigned)p0[HG_RS] | ((unsigned)p0[3 * HG_RS / 2] << 16);
    w.z = (unsigned)p1[0] | ((unsigned)p1[HG_RS / 2] << 16); w.w = (unsigned)p1[HG_RS] | ((unsigned)p1[3 * HG_RS / 2] << 16);
    return __builtin_bit_cast(bf16x8, w);
}

DI void hgrn1_unit(const Ctx& p, const int li, const int cidx, ldsp lds) {
    const int tid = tid_now(), lane = tid & 63, w = __builtin_amdgcn_readfirstlane(tid >> 6), h = w >> 1, dir = w & 1, tl = lane & 15, g = lane >> 4;
    const bf16_t* Z = (const bf16_t*)(p.ws + WS_Z); bf16_t* U = (bf16_t*)(p.ws + WS_X + X_U); float* HE = (float*)(p.ws + WS_HE);
    const int row0 = chunk_row0(cidx);
    ldsp VT = lds + w * HG_TILE; ldsp KT = lds + 8 * HG_TILE + w * HG_TILE;
    hgrn_stage_v(Z, row0, h, dir, lane, VT);
    float lb[16]; hgrn_lb(p.in[13], li, dir, h, g, lb);
    const int fcol = (dir ? ZB_FB : ZB_FF) + h * 64 + 8 * g;
    float tot[4][16];
#pragma unroll
    for (int I = 0; I < 4; ++I) { const int tau = 16 * I + tl, t = dir ? 63 - tau : tau; float logf[16], kf[16];
        hgrn_gate_block(Z + (size_t)(row0 + t) * NZ + fcol, lb, logf, kf);
#pragma unroll
        for (int i = 0; i < 16; ++i) { const float a = row_scan16(logf[i]); tot[I][i] = __shfl(a, (lane & 48) | 15); } }
#pragma unroll
    for (int I = 0; I < 4; ++I) { const int tau = 16 * I + tl, t = dir ? 63 - tau : tau; float logf[16], kf[16], kd[16];
        hgrn_gate_block(Z + (size_t)(row0 + t) * NZ + fcol, lb, logf, kf);
#pragma unroll
        for (int i = 0; i < 16; ++i) { const float a = row_scan16(logf[i]); float rest = tot[I][i] - a;
#pragma unroll
            for (int M = I + 1; M < 4; ++M) rest += tot[M][i];
            kd[i] = kf[i] * __expf(rest); }
        { const u32x4 k0 = __builtin_bit_cast(u32x4, pack8(kd)), k1 = __builtin_bit_cast(u32x4, pack8(kd + 8));
          LAS u32x2* d0 = (LAS u32x2*)(KT + tau * HG_RS + (8 * g) * 2); LAS u32x2* d1 = (LAS u32x2*)(KT + tau * HG_RS + (32 + 8 * g) * 2);
          d0[0] = (u32x2){k0.x, k0.y}; d0[1] = (u32x2){k0.z, k0.w}; d1[0] = (u32x2){k1.x, k1.y}; d1[1] = (u32x2){k1.z, k1.w}; } }
    if (tl == 0) {
#pragma unroll
        for (int i = 0; i < 16; ++i) HE[((size_t)(cidx * 4 + h) * 2 + dir) * 64 + 32 * (i >> 3) + 8 * g + (i & 7)] = __expf(tot[0][i] + tot[1][i] + tot[2][i] + tot[3][i]); }
    asm volatile("s_waitcnt lgkmcnt(0)" ::: "memory"); __builtin_amdgcn_wave_barrier();
    bf16x8 va[4][2];
#pragma unroll
    for (int E = 0; E < 4; ++E)
#pragma unroll
        for (int st = 0; st < 2; ++st) va[E][st] = hgrn_tr_frag(VT, 16 * E + tl, 32 * st + 8 * g, 32 * st + 8 * g + 4);
    bf16_t* up = U + ((size_t)(cidx * 4 + h) * 2 + dir) * 4096;
#pragma unroll
    for (int Dt = 0; Dt < 4; ++Dt) {
        const bf16x8 kb0 = hgrn_tr_frag(KT, 16 * Dt + tl, 8 * g, 8 * g + 4), kb1 = hgrn_tr_frag(KT, 16 * Dt + tl, 32 + 8 * g, 32 + 8 * g + 4);
#pragma unroll
        for (int E = 0; E < 4; ++E) { f32x4 acc = {0.f, 0.f, 0.f, 0.f}; acc = MFMA16(va[E][0], kb0, acc); acc = MFMA16(va[E][1], kb1, acc);
#pragma unroll
            for (int r = 0; r < 4; ++r) up[(16 * E + 4 * g + r) * 64 + 16 * Dt + tl] = f2bf(acc[r]); }
    }
}

DI void hgrn3_unit(const Ctx& p, const int li, const int cidx, ldsp lds, const int dry = 0) {
    const int tid = tid_now(), lane = tid & 63, w = __builtin_amdgcn_readfirstlane(tid >> 6), h = w >> 1, dir = w & 1, tl = lane & 15, g = lane >> 4;
    bf16_t* Z = (bf16_t*)(p.ws + WS_Z); const bf16_t* U = (const bf16_t*)(p.ws + WS_X + X_U);
    const int row0 = chunk_row0(cidx);
    ldsp VT = lds + w * HG_TILE; ldsp OX = lds + 8 * HG_TILE;
    hgrn_stage_v(Z, row0, h, dir, lane, VT);
    float lb[16]; hgrn_lb(p.in[13], li, dir, h, g, lb);
    const int fcol = (dir ? ZB_FB : ZB_FF) + h * 64 + 8 * g;
    const bf16_t* sp = U + ((size_t)(cidx * 4 + h) * 2 + dir) * 4096;
    float crun[16], tot1[16], tot2[16];
#pragma unroll
    for (int i = 0; i < 16; ++i) { crun[i] = 0.f; tot1[i] = 0.f; tot2[i] = 0.f; }
    bf16x8 kend[3][2];
    asm volatile("s_waitcnt lgkmcnt(0)" ::: "memory"); __builtin_amdgcn_wave_barrier();
#pragma unroll
    for (int I = 0; I < 4; ++I) {
        const int tau = 16 * I + tl, t = dir ? 63 - tau : tau;
        const bf16_t* zr = Z + (size_t)(row0 + t) * NZ;
        float logf[16], kf[16], qv[16], al[16], tot[16], tmp[16];
        hgrn_gate_block(zr + fcol, lb, logf, kf);
        unpack8(*(const u32x4*)(zr + ZB_Q + h * 64 + 8 * g), qv); unpack8(*(const u32x4*)(zr + ZB_Q + h * 64 + 32 + 8 * g), qv + 8);
#pragma unroll
        for (int i = 0; i < 16; ++i) { al[i] = row_scan16(logf[i]); tot[i] = __shfl(al[i], (lane & 48) | 15); }
        f32x4 wt[4];
#pragma unroll
        for (int i = 0; i < 16; ++i) tmp[i] = kf[i] * __expf(fminf(-al[i], 80.f));
        const bf16x8 kd0 = pack8(tmp), kd1 = pack8(tmp + 8);
#pragma unroll
        for (int i = 0; i < 16; ++i) tmp[i] = qv[i] * __expf(al[i]);
        const bf16x8 qp0 = pack8(tmp), qp1 = pack8(tmp + 8);
        { f32x4 a = {0.f, 0.f, 0.f, 0.f}; a = MFMA16(kd0, qp0, a); a = MFMA16(kd1, qp1, a);
#pragma unroll
          for (int r = 0; r < 4; ++r) a[r] = (4 * g + r <= tl) ? a[r] : 0.f;
          wt[I] = a; }
#pragma unroll
        for (int J = 0; J < I; ++J) {
            bf16x8 q0 = qp0, q1 = qp1;
            if (J < I - 1) {
#pragma unroll
                for (int i = 0; i < 16; ++i) { float dl = (I - 1 - J >= 1) ? ((I - 1 == 1) ? tot1[i] : tot2[i]) : 0.f; if (I - 1 - J == 2) dl += tot1[i]; tmp[i] = qv[i] * __expf(al[i] + dl); }
                q0 = pack8(tmp); q1 = pack8(tmp + 8);
            }
            f32x4 a = {0.f, 0.f, 0.f, 0.f}; a = MFMA16(kend[J][0], q0, a); a = MFMA16(kend[J][1], q1, a); wt[J] = a;
        }
        if (I < 3) {
#pragma unroll
            for (int i = 0; i < 16; ++i) tmp[i] = kf[i] * __expf(tot[i] - al[i]);
            kend[I][0] = pack8(tmp); kend[I][1] = pack8(tmp + 8);
        }
#pragma unroll
        for (int i = 0; i < 16; ++i) tmp[i] = qv[i] * __expf(al[i] + crun[i]);
        const bf16x8 qd0 = pack8(tmp), qd1 = pack8(tmp + 8);
        bf16x8 bw[2];
#pragma unroll
        for (int st = 0; st < 2; ++st) { float v8[8];
#pragma unroll
            for (int r = 0; r < 4; ++r) { v8[r] = (2 * st <= I) ? wt[(2 * st <= I) ? 2 * st : 0][r] : 0.f; v8[4 + r] = (2 * st + 1 <= I) ? wt[(2 * st + 1 <= I) ? 2 * st + 1 : 0][r] : 0.f; }
            bw[st] = pack8(v8); }
        bf16_t* ox = (bf16_t*)nullptr;
#pragma unroll
        for (int E = 0; E < 4; ++E) {
            f32x4 acc = {0.f, 0.f, 0.f, 0.f};
#pragma unroll
            for (int st = 0; st < 2; ++st) if (2 * st <= I) { const bf16x8 va = hgrn_tr_frag(VT, 16 * E + tl, 32 * st + 4 * g, 32 * st + 16 + 4 * g); acc = MFMA16(va, bw[st], acc); }
            const bf16x8 s0 = *(const bf16x8*)(sp + (16 * E + tl) * 64 + 8 * g), s1 = *(const bf16x8*)(sp + (16 * E + tl) * 64 + 32 + 8 * g);
            acc = MFMA16(s0, qd0, acc); acc = MFMA16(s1, qd1, acc);
            u32x2 o2; o2.x = pk2(acc[0], acc[1]); o2.y = pk2(acc[2], acc[3]);
            *(LAS u32x2*)(OX + ((dir * 4 + h) * 64 + t) * HG_RS + (16 * E + 4 * g) * 2) = o2;
        }
        (void)ox;
#pragma unroll
        for (int i = 0; i < 16; ++i) { crun[i] += tot[i]; if (I == 1) tot1[i] = tot[i]; if (I == 2) tot2[i] = tot[i]; }
    }
    __syncthreads();
    { const int t = 32 * dir + (lane >> 1), e0 = (lane & 1) * 32; const float* gn = p.in[14] + li * 64;
      const LAS unsigned char* of = OX + ((0 * 4 + h) * 64 + t) * HG_RS + e0 * 2; const LAS unsigned char* ob = OX + ((1 * 4 + h) * 64 + t) * HG_RS + e0 * 2;
      bf16_t* zr = Z + (size_t)(row0 + t) * NZ + h * 64 + e0;
      float o[32]; float ss = 0.f;
#pragma unroll
      for (int q = 0; q < 4; ++q) { float a8[8], b8[8];
          { const u32x2 x0 = *(const LAS u32x2*)(of + q * 16), x1 = *(const LAS u32x2*)(of + q * 16 + 8), y0 = *(const LAS u32x2*)(ob + q * 16), y1 = *(const LAS u32x2*)(ob + q * 16 + 8);
            unpack8((u32x4){x0.x, x0.y, x1.x, x1.y}, a8); unpack8((u32x4){y0.x, y0.y, y1.x, y1.y}, b8); }
#pragma unroll
          for (int j = 0; j < 8; ++j) { o[q * 8 + j] = a8[j] + b8[j]; ss += o[q * 8 + j] * o[q * 8 + j]; } }
      ss += __shfl_xor(ss, 1);
      const float rstd = rsqrtf(ss * (1.f / 64.f) + NORM_EPS);
#pragma unroll
      for (int q = 0; q < 4; ++q) { float g8[8], r8[8]; unpack8(*(const u32x4*)(zr + ZB_G + q * 8), g8);
#pragma unroll
          for (int j = 0; j < 8; ++j) r8[j] = o[q * 8 + j] * rstd * gn[e0 + q * 8 + j] * g8[j] * sigmoidf_(g8[j]);
          if (!dry) *(bf16x8*)(zr + ZB_Q + q * 8) = pack8(r8); } }
    __syncthreads();
}

DI void phase_prep(const Ctx& p, const int li, ldsp lds) {
    const int tid = tid_now();
    bf16_t* Z = (bf16_t*)(p.ws + WS_Z);
    const f32x2* cs16 = (const f32x2*)(p.ws + WS_ROPE16); const f32x2* cs8 = (const f32x2*)(p.ws + WS_ROPE8);
    bf16_t* KC = (bf16_t*)(p.ws + WS_X + X_KC); bf16_t* AVt = (bf16_t*)(p.ws + WS_X + X_AVT); bf16_t* DVt = (bf16_t*)(p.ws + WS_X + X_DVT);
    bf16_t* U = (bf16_t*)(p.ws + WS_X + X_U); float* HE = (float*)(p.ws + WS_HE);
    const float* qn = p.in[15] + li * 256; const float* kvn = p.in[16] + li * 128; const float* lbl = p.in[13];
    for (int cidx = bid_now(); cidx < NCHUNK; cidx += gdim_now()) {
        const int row0 = chunk_row0(cidx); const bool lat = cidx < 512;
        int b, key0; row_bk(row0, b, key0);
        if (lat) {
            const int prow = key0 >> 6;
            if (tid < 128) { const int t = tid >> 1, blk = 4 + (tid & 1), pcol = (key0 + t) & 63;
                bf16_t* zp = Z + (size_t)(row0 + t) * NZ + ZA_Q + blk * 64; u32x4 w[8]; float x[64];
#pragma unroll
                for (int q = 0; q < 8; ++q) w[q] = *(const u32x4*)(zp + q * 8);
#pragma unroll
                for (int q = 0; q < 8; ++q) unpack8(w[q], x + q * 8);
#pragma unroll
                for (int j = 0; j < 16; ++j) { const f32x2 cr = cs16[prow * 16 + j], cc = cs16[pcol * 16 + j];
                    const float a1 = x[j], a2 = x[16 + j], b1 = x[32 + j], b2 = x[48 + j];
                    x[j] = a1 * cr.x - a2 * cr.y; x[16 + j] = a2 * cr.x + a1 * cr.y; x[32 + j] = b1 * cc.x - b2 * cc.y; x[48 + j] = b2 * cc.x + b1 * cc.y; }
#pragma unroll
                for (int q = 0; q < 8; ++q) *(bf16x8*)(zp + q * 8) = pack8(x + q * 8); }
            { const int t = tid >> 3, blk = 8 + (tid & 7), pcol = (key0 + t) & 63;
                bf16_t* zp = Z + (size_t)(row0 + t) * NZ + ZD_Q + blk * 32; u32x4 w[4]; float x[32];
#pragma unroll
                for (int q = 0; q < 4; ++q) w[q] = *(const u32x4*)(zp + q * 8);
#pragma unroll
                for (int q = 0; q < 4; ++q) unpack8(w[q], x + q * 8);
#pragma unroll
                for (int j = 0; j < 8; ++j) { const f32x2 cr = cs8[prow * 8 + j], cc = cs8[pcol * 8 + j];
                    const float a1 = x[j], a2 = x[8 + j], b1 = x[16 + j], b2 = x[24 + j];
                    x[j] = a1 * cr.x - a2 * cr.y; x[8 + j] = a2 * cr.x + a1 * cr.y; x[16 + j] = b1 * cc.x - b2 * cc.y; x[24 + j] = b2 * cc.x + b1 * cc.y; }
#pragma unroll
                for (int q = 0; q < 4; ++q) *(bf16x8*)(zp + q * 8) = pack8(x + q * 8); }
        }
#ifdef DUP_PREP234
        for (int rep = 0; rep < 2; ++rep) { int dryp = rep == 0; asm volatile("" : "+s"(dryp));
#else
        { const int dryp = 0;
#endif
        { const int t = tid >> 3, s = tid & 7; bf16_t* zr = Z + (size_t)(row0 + t) * NZ;
          float xq[32], xk[16]; float sq = 0.f, sk = 0.f;
#pragma unroll
          for (int j = 0; j < 4; ++j) { const u32x4 w = *(const u32x4*)(zr + ZC_Q + s * 32 + j * 8); const unsigned wu[4] = {w.x, w.y, w.z, w.w};
#pragma unroll
              for (int q = 0; q < 4; ++q) { xq[j * 8 + 2 * q] = bflo(wu[q]); xq[j * 8 + 2 * q + 1] = bfhi(wu[q]); } }
#pragma unroll
          for (int j = 0; j < 2; ++j) { const u32x4 w = *(const u32x4*)(zr + ZC_KV + s * 16 + j * 8); const unsigned wu[4] = {w.x, w.y, w.z, w.w};
#pragma unroll
              for (int q = 0; q < 4; ++q) { xk[j * 8 + 2 * q] = bflo(wu[q]); xk[j * 8 + 2 * q + 1] = bfhi(wu[q]); } }
#pragma unroll
          for (int j = 0; j < 32; ++j) sq += xq[j] * xq[j];
#pragma unroll
          for (int j = 0; j < 16; ++j) sk += xk[j] * xk[j];
          sq += __shfl_xor(sq, 1); sq += __shfl_xor(sq, 2); sq += __shfl_xor(sq, 4); sk += __shfl_xor(sk, 1); sk += __shfl_xor(sk, 2); sk += __shfl_xor(sk, 4);
          const float rq = rsqrtf(sq * (1.f / 256.f) + NORM_EPS), rk = rsqrtf(sk * (1.f / 128.f) + NORM_EPS);
#pragma unroll
          for (int j = 0; j < 4; ++j) { u32x4 w; const float* g = qn + s * 32 + j * 8;
              w.x = pk2(xq[j * 8 + 0] * rq * g[0], xq[j * 8 + 1] * rq * g[1]); w.y = pk2(xq[j * 8 + 2] * rq * g[2], xq[j * 8 + 3] * rq * g[3]);
              w.z = pk2(xq[j * 8 + 4] * rq * g[4], xq[j * 8 + 5] * rq * g[5]); w.w = pk2(xq[j * 8 + 6] * rq * g[6], xq[j * 8 + 7] * rq * g[7]);
              if (!dryp) *(u32x4*)(zr + ZC_Q + s * 32 + j * 8) = w; }
#pragma unroll
          for (int j = 0; j < 2; ++j) { u32x4 w; const float* g = kvn + s * 16 + j * 8;
              w.x = pk2(xk[j * 8 + 0] * rk * g[0], xk[j * 8 + 1] * rk * g[1]); w.y = pk2(xk[j * 8 + 2] * rk * g[2], xk[j * 8 + 3] * rk * g[3]);
              w.z = pk2(xk[j * 8 + 4] * rk * g[4], xk[j * 8 + 5] * rk * g[5]); w.w = pk2(xk[j * 8 + 6] * rk * g[6], xk[j * 8 + 7] * rk * g[7]);
              if (!dryp) *(u32x4*)(zr + ZC_KV + s * 16 + j * 8) = w; } }
        for (int i = tid; i < 64 * 16; i += 512) { const int t = i >> 4, pr = i & 15, half = pr >> 3, j = pr & 7;
            const bf16_t* x = Z + (size_t)(row0 + t) * NZ + ZC_KR + half * 16 + j; float x1 = bf2f(x[0]), x2 = bf2f(x[8]);
            if (lat) { const int pos = half ? ((key0 + t) & 63) : ((key0 + t) >> 6); const f32x2 cs = cs8[pos * 8 + j]; const float a = x1 * cs.x - x2 * cs.y, c = x2 * cs.x + x1 * cs.y; x1 = a; x2 = c; }
            const bf16_t o1 = f2bf(x1), o2 = f2bf(x2);
#pragma unroll
            for (int hh = 0; hh < 4; ++hh) { bf16_t* kp = KC + ((size_t)(b * 4 + hh) * KEYS + key0 + t) * 96 + 64 + half * 16 + j; kp[0] = o1; kp[8] = o2; } }
        __syncthreads();
        { const int t = tid >> 3, c8 = (tid & 7) * 8; u32x4 w[6];
#pragma unroll
          for (int tile = 0; tile < 6; ++tile) w[tile] = *(const u32x4*)(Z + (size_t)(row0 + t) * NZ + (tile < 2 ? ZA_V + tile * 64 : ZD_V + (tile - 2) * 64) + c8);
#pragma unroll
          for (int tile = 0; tile < 6; ++tile) { LAS bf16_t* tt = (LAS bf16_t*)(lds + tile * 9216); *(LAS u32x2*)(tt + t * 72 + c8) = (u32x2){w[tile].x, w[tile].y}; *(LAS u32x2*)(tt + t * 72 + c8 + 4) = (u32x2){w[tile].z, w[tile].w}; } }
        __syncthreads();
        { const int dv = tid >> 3, k8 = (tid & 7) * 8;
#pragma unroll
          for (int tile = 0; tile < 6; ++tile) { const LAS bf16_t* tt = (const LAS bf16_t*)(lds + tile * 9216); unsigned short e[8];
#pragma unroll
              for (int j = 0; j < 8; ++j) e[j] = tt[(k8 + j) * 72 + dv];
              u32x4 w; w.x = e[0] | ((unsigned)e[1] << 16); w.y = e[2] | ((unsigned)e[3] << 16); w.z = e[4] | ((unsigned)e[5] << 16); w.w = e[6] | ((unsigned)e[7] << 16);
              bf16_t* dst = tile < 2 ? AVt + ((size_t)(b * 2 + tile) * 64 + dv) * KEYS + key0 + k8 : DVt + ((size_t)(b * 4 + tile - 2) * 64 + dv) * KEYS + key0 + k8;
              *(u32x4*)dst = w; } }
        __syncthreads();
        }
        hgrn1_unit(p, li, cidx, lds);
#ifdef DUP_H1
        hgrn1_unit(p, li, cidx, lds);
#endif
    }
}

DI void phase_hscan(const Ctx& p, const int dry = 0) {
    unsigned* U = (unsigned*)(p.ws + WS_X + X_U); const float* HE = (const float*)(p.ws + WS_HE);
    for (int g = bid_now() * 512 + tid_now(); g < 64 * 2048; g += gdim_now() * 512) {
        const int chain = g >> 11, pr = g & 2047, d = (pr * 2) & 63; const int b = chain >> 3, h = (chain >> 1) & 3, dir = chain & 1;
        float S0 = 0.f, S1 = 0.f;
#pragma unroll 1
        for (int k0 = 0; k0 < 68; k0 += 17) {
            unsigned u[17]; f32x2 e[17];
#pragma unroll
            for (int q = 0; q < 17; ++q) { const int k = k0 + q; int cidx;
                if (dir == 0) cidx = k < 4 ? 512 + b * 4 + k : b * 64 + (k - 4); else cidx = k < 4 ? 512 + b * 4 + (3 - k) : b * 64 + (67 - k);
                const size_t ch = (size_t)(cidx * 4 + h) * 2 + dir; u[q] = U[ch * 2048 + pr]; e[q] = *(const f32x2*)(HE + ch * 64 + d); }
#pragma unroll
            for (int q = 0; q < 17; ++q) { const int k = k0 + q; int cidx;
                if (dir == 0) cidx = k < 4 ? 512 + b * 4 + k : b * 64 + (k - 4); else cidx = k < 4 ? 512 + b * 4 + (3 - k) : b * 64 + (67 - k);
                const size_t ch = (size_t)(cidx * 4 + h) * 2 + dir; if (!dry) U[ch * 2048 + pr] = pk2(S0, S1); S0 = e[q].x * S0 + bflo(u[q]); S1 = e[q].y * S1 + bfhi(u[q]); }
        }
        if (dry && S0 == 1.2345f) U[0] = 0u;
    }
}

template <int DQK, int NMAP, int MODE>
struct AttnCfg { static constexpr int KW = DQK * NMAP, RSK = KW * 2 + 16, RSV = 144, KBYTES = 64 * RSK, VBYTES = 64 * RSV, CPR = KW / 8, NCK = 64 * CPR; };

template <int DQK, int NMAP, int MODE, int ABL = 0, class TileFn>
DI void attn_unit(ldsp lds, const bf16_t* qrow  , const int ntiles, TileFn tile,
                  const float scl2  , const float m_init, const float l_init, const int qpos  ,
                  bf16_t* orow, const float lam, const float post, const float* subln, const int qtok = -1, const f32x2* cs8 = nullptr) {
    typedef AttnCfg<DQK, NMAP, MODE> C;
    const int tid = tid_now(), lane = tid & 63, r = lane & 31, hh = lane >> 5;
    bf16x8 qf[NMAP][DQK / 16];
#pragma unroll
    for (int mp = 0; mp < NMAP; ++mp)
#pragma unroll
        for (int kk = 0; kk < DQK / 16; ++kk) qf[mp][kk] = *(const bf16x8*)(qrow + mp * DQK + kk * 16 + hh * 8);
    auto rope_x = [&](bf16x8& frag, const int pos) {
        const u32x4 w = __builtin_bit_cast(u32x4, frag); const unsigned wu[4] = {w.x, w.y, w.z, w.w}; unsigned ou[4];
#pragma unroll
        for (int q2 = 0; q2 < 4; ++q2) { const unsigned pw = __shfl_xor(wu[q2], 32);
            const f32x2 c0 = cs8[pos * 8 + 2 * q2], c1 = cs8[pos * 8 + 2 * q2 + 1];
            const float a0 = bflo(wu[q2]), a1 = bfhi(wu[q2]), b0 = bflo(pw), b1 = bfhi(pw);
            const float r0 = hh ? a0 * c0.x + b0 * c0.y : a0 * c0.x - b0 * c0.y, r1 = hh ? a1 * c1.x + b1 * c1.y : a1 * c1.x - b1 * c1.y;
            ou[q2] = pk2(r0, r1); }
        const u32x4 o4 = {ou[0], ou[1], ou[2], ou[3]}; frag = __builtin_bit_cast(bf16x8, o4); };
    auto rope_in = [&](bf16x8& fa, bf16x8& fb, const int pos) {
        const u32x4 wa = __builtin_bit_cast(u32x4, fa), wb = __builtin_bit_cast(u32x4, fb); const unsigned ua[4] = {wa.x, wa.y, wa.z, wa.w}, ub[4] = {wb.x, wb.y, wb.z, wb.w}; unsigned oa[4], ob[4];
#pragma unroll
        for (int q2 = 0; q2 < 4; ++q2) { const f32x2 c0 = cs8[pos * 16 + hh * 8 + 2 * q2], c1 = cs8[pos * 16 + hh * 8 + 2 * q2 + 1];
            const float a0 = bflo(ua[q2]), a1 = bfhi(ua[q2]), b0 = bflo(ub[q2]), b1 = bfhi(ub[q2]);
            oa[q2] = pk2(a0 * c0.x - b0 * c0.y, a1 * c1.x - b1 * c1.y); ob[q2] = pk2(b0 * c0.x + a0 * c0.y, b1 * c1.x + a1 * c1.y); }
        fa = __builtin_bit_cast(bf16x8, (u32x4){oa[0], oa[1], oa[2], oa[3]}); fb = __builtin_bit_cast(bf16x8, (u32x4){ob[0], ob[1], ob[2], ob[3]}); };
    if (qtok >= 0) {
        const int prow = qtok >> 6, pcol = qtok & 63;
        if (MODE == 0) { rope_x(qf[0][4], prow); rope_x(qf[0][5], pcol); }
        if (MODE == 1) {
#pragma unroll
            for (int mp = 0; mp < NMAP; ++mp) { rope_x(qf[mp][0], prow); rope_x(qf[mp][DQK / 16 - 1], pcol); } }
        if (MODE == 2) { rope_in(qf[0][0], qf[0][1], prow); rope_in(qf[0][DQK / 16 - 2], qf[0][DQK / 16 - 1], pcol); }
    }
    constexpr bool FOLD = true;
#pragma unroll
    for (int mp = 0; mp < NMAP; ++mp)
#pragma unroll
        for (int kk = 0; kk < DQK / 16; ++kk) { const u32x4 w = __builtin_bit_cast(u32x4, qf[mp][kk]); u32x4 o4;
            o4.x = pk2(bflo(w.x) * scl2, bfhi(w.x) * scl2); o4.y = pk2(bflo(w.y) * scl2, bfhi(w.y) * scl2); o4.z = pk2(bflo(w.z) * scl2, bfhi(w.z) * scl2); o4.w = pk2(bflo(w.w) * scl2, bfhi(w.w) * scl2);
            qf[mp][kk] = __builtin_bit_cast(bf16x8, o4); }
    const bool noinit = m_init < -1.0e29f;
    const bf16x8 onesA = __builtin_bit_cast(bf16x8, (u32x4){hh == 0 ? 0x3F803F80u : 0u, 0u, 0u, 0u});
    bf16x8 mB[NMAP];
    auto set_mB = [&](const int mp, const float mv) { const float nm = -mv; const unsigned t = pk2(nm, 0.f); const unsigned w = pk2(nm, nm - bflo(t)); mB[mp] = __builtin_bit_cast(bf16x8, (u32x4){hh == 0 ? w : 0u, 0u, 0u, 0u}); };
    f32x16 O[NMAP][2];
    float m[NMAP], l[NMAP];
#pragma unroll
    for (int mp = 0; mp < NMAP; ++mp) { m[mp] = noinit ? 0.f : m_init; l[mp] = l_init; set_mB(mp, m[mp]);
#pragma unroll
        for (int dv = 0; dv < 2; ++dv)
#pragma unroll
            for (int i = 0; i < 16; ++i) O[mp][dv][i] = 0.f; }
    const int kr0 = tid / C::CPR, kc0 = tid % C::CPR; const int kr1 = (tid + 512) / C::CPR, kc1 = (tid + 512) % C::CPR;
    const int vr = tid >> 3, vc = tid & 7;
    const bool k2 = C::NCK > 512 && tid + 512 < C::NCK;
    const int kr1c = k2 ? kr1 : kr0, kc1c = k2 ? kc1 : kc0;
    struct Stg { u32x4 k0, k1, v; };
    auto ld_tile = [&](const int jt, Stg& g) { const bf16_t* kp; const bf16_t* vp; int ldk, kpos0, masked; tile(jt, kp, ldk, vp, kpos0, masked);
        g.k0 = *(const u32x4*)(kp + (size_t)kr0 * ldk + kc0 * 8); if (C::NCK > 512) g.k1 = *(const u32x4*)(kp + (size_t)kr1c * ldk + kc1c * 8);
        g.v = *(const u32x4*)(vp + (size_t)vr * KEYS + vc * 8); };
    auto st_tile = [&](const int jt, const Stg& g) { ldsp kb = lds + (jt & 1) * C::KBYTES; ldsp vb = lds + 2 * C::KBYTES + (jt % 3) * C::VBYTES + vr * C::RSV + (vc >> 1) * 32 + (vc & 1) * 8;
        *(LAS u32x4*)(kb + kr0 * C::RSK + kc0 * 16) = g.k0; if (k2) *(LAS u32x4*)(kb + kr1 * C::RSK + kc1 * 16) = g.k1;
        *(LAS u32x2*)vb = (u32x2){g.v.x, g.v.y}; *(LAS u32x2*)(vb + 16) = (u32x2){g.v.z, g.v.w}; };
    const int grp = __builtin_amdgcn_readfirstlane(tid >> 8);
    bf16x8 pf[NMAP][2][2];
#pragma unroll
    for (int mp = 0; mp < NMAP; ++mp)
#pragma unroll
        for (int a2 = 0; a2 < 2; ++a2)
#pragma unroll
            for (int b2 = 0; b2 < 2; ++b2) pf[mp][a2][b2] = (bf16x8){0, 0, 0, 0, 0, 0, 0, 0};
    auto vbuf = [&](const int x) -> ldsp { return lds + 2 * C::KBYTES + (x % 3) * C::VBYTES; };
    auto pv_load = [&](ldsp vb, bf16x8 (&vf)[2][2][2]) {
#pragma unroll
        for (int dv = 0; dv < 2; ++dv)
#pragma unroll
            for (int ks = 0; ks < 2; ++ks)
#pragma unroll
                for (int s2 = 0; s2 < 2; ++s2) vf[dv][ks][s2] = *(const LAS bf16x8*)(vb + (32 * dv + r) * C::RSV + (32 * ks + 16 * s2 + 8 * hh) * 2); };
    auto pv_mma = [&](const bf16x8 (&vf)[2][2][2]) {
#pragma unroll
        for (int dv = 0; dv < 2; ++dv)
#pragma unroll
            for (int ks = 0; ks < 2; ++ks)
#pragma unroll
                for (int s2 = 0; s2 < 2; ++s2)
#pragma unroll
                    for (int mp = 0; mp < NMAP; ++mp) O[mp][dv] = __builtin_amdgcn_mfma_f32_32x32x16_bf16(vf[dv][ks][s2], pf[mp][ks][s2], O[mp][dv], 0, 0, 0); };
    auto pv_tile = [&](ldsp vb) { bf16x8 vf[2][2][2]; pv_load(vb, vf); if (NMAP == 1) __builtin_amdgcn_sched_barrier(0); pv_mma(vf); };
    auto smax = [&](const int mp, f32x16 (&s)[2], const int cur_kpos0, const int cur_masked, const bool first) {
        float mx = -3.0e38f;
#pragma unroll
        for (int ks = 0; ks < 2; ++ks)
#pragma unroll
            for (int i = 0; i < 16; ++i) {
                if (MODE == 2) { const int rel = cur_kpos0 + 32 * ks + (i & 3) + 8 * (i >> 2) + 4 * hh - qpos; if (cur_masked && (rel > 128 || rel < -128)) s[ks][i] = -1.0e30f; }
                mx = fmaxf(mx, s[ks][i]); }
        { const auto sw = __builtin_amdgcn_permlane32_swap(__float_as_uint(mx), __float_as_uint(mx), false, false); mx = fmaxf(__uint_as_float(sw[0]), __uint_as_float(sw[1])); }
        const bool force = noinit && first;
        if (force || __any(mx > 8.f)) {
            const float dl = force ? mx : fmaxf(mx, 0.f), alpha = force ? 1.f : __builtin_amdgcn_exp2f(-dl); m[mp] += dl; l[mp] *= alpha; set_mB(mp, m[mp]);
#pragma unroll
            for (int i = 0; i < 16; ++i) { s[0][i] -= dl; s[1][i] -= dl; }
#pragma unroll
            for (int dv = 0; dv < 2; ++dv)
#pragma unroll
                for (int i = 0; i < 16; ++i) O[mp][dv][i] *= alpha;
        }
        float ps = 0.f;
#pragma unroll
        for (int ks = 0; ks < 2; ++ks)
#pragma unroll
            for (int i = 0; i < 16; ++i) { const float pv = (ABL == 1) ? s[ks][i] : __builtin_amdgcn_exp2f(s[ks][i]); s[ks][i] = pv; if (ABL != 1) ps += pv; }
        l[mp] += ps;
#pragma unroll
        for (int ks = 0; ks < 2; ++ks)
#pragma unroll
            for (int s2 = 0; s2 < 2; ++s2) { u32x4 w; w.x = pk2(s[ks][8 * s2 + 0], s[ks][8 * s2 + 1]); w.y = pk2(s[ks][8 * s2 + 2], s[ks][8 * s2 + 3]);
                w.z = pk2(s[ks][8 * s2 + 4], s[ks][8 * s2 + 5]); w.w = pk2(s[ks][8 * s2 + 6], s[ks][8 * s2 + 7]);
                pf[mp][ks][s2] = __builtin_bit_cast(bf16x8, w); }
    };
    Stg ga, gb; ga.k1 = (u32x4){0u, 0u, 0u, 0u}; gb.k1 = (u32x4){0u, 0u, 0u, 0u}; gb.k0 = ga.k1; gb.v = ga.k1;
    auto step = [&](const int j, Stg& gx  , Stg& gy  ) {
        if (ABL != 8) ld_tile(j + 2 < ntiles ? j + 2 : ntiles - 1, gy);
        const bf16_t* kp_; const bf16_t* vp_; int ldk_, cur_kpos0, cur_masked; tile(j, kp_, ldk_, vp_, cur_kpos0, cur_masked);
        ldsp kb = lds + (j & 1) * C::KBYTES;
        if (grp == 1 && j > 0) pv_tile(vbuf(j - 1));
        bf16x8 vf0[2][2][2];
#pragma unroll
        for (int mp = 0; mp < NMAP; ++mp) {
            f32x16 s[2];
            bf16x8 kfr[2][DQK / 16];
#pragma unroll
            for (int ks = 0; ks < 2; ++ks)
#pragma unroll
                for (int kk = 0; kk < DQK / 16; ++kk) kfr[ks][kk] = *(const LAS bf16x8*)(kb + (32 * ks + r) * C::RSK + (mp * DQK + kk * 16 + hh * 8) * 2);
            if (NMAP == 1) __builtin_amdgcn_sched_barrier(0);
#pragma unroll
            for (int ks = 0; ks < 2; ++ks) {
#pragma unroll
                for (int i = 0; i < 16; ++i) s[ks][i] = 0.f;
                s[ks] = __builtin_amdgcn_mfma_f32_32x32x16_bf16(onesA, mB[mp], s[ks], 0, 0, 0);
#pragma unroll
                for (int kk = 0; kk < DQK / 16; ++kk) s[ks] = __builtin_amdgcn_mfma_f32_32x32x16_bf16(kfr[ks][kk], qf[mp][kk], s[ks], 0, 0, 0); }
            if (NMAP == 1 && grp == 0) pv_load(vbuf(j), vf0);
            if (NMAP == 1) __builtin_amdgcn_sched_barrier(0);
            smax(mp, s, cur_kpos0, cur_masked, j == 0);
        }
        if (grp == 0) { if (NMAP == 1) pv_mma(vf0); else pv_tile(vbuf(j)); }
        if (ABL != 8) if (j + 1 < ntiles) st_tile(j + 1, gx);
        if (ABL != 7) __syncthreads();
    };
    ld_tile(0, ga); ld_tile(ntiles > 1 ? 1 : 0, gb);
    __syncthreads();
    st_tile(0, ga);
    __syncthreads();
#pragma unroll 1
    for (int j = 0; j < ntiles; j += 2) { step(j, gb, ga); if (j + 1 < ntiles) step(j + 1, ga, gb); }
    if (grp == 1) pv_tile(vbuf(ntiles - 1));
    asm volatile("" ::: "memory");
    float inv[NMAP];
#pragma unroll
    for (int mp = 0; mp < NMAP; ++mp) { const float lt = l[mp] + __shfl_xor(l[mp], 32); inv[mp] = 1.f / lt; }
    float o[2][16];
#pragma unroll
    for (int dv = 0; dv < 2; ++dv)
#pragma unroll
        for (int i = 0; i < 16; ++i) { if (MODE == 1) o[dv][i] = O[0][dv][i] * inv[0] - lam * O[NMAP - 1][dv][i] * inv[NMAP - 1]; else o[dv][i] = O[0][dv][i] * inv[0]; }
    if (MODE == 1) {
        float ss = 0.f;
#pragma unroll
        for (int dv = 0; dv < 2; ++dv)
#pragma unroll
            for (int i = 0; i < 16; ++i) ss += o[dv][i] * o[dv][i];
        ss += __shfl_xor(ss, 32);
        const float rstd = rsqrtf(ss * (1.f / 64.f) + NORM_EPS) * post;
#pragma unroll
        for (int dv = 0; dv < 2; ++dv)
#pragma unroll
            for (int i = 0; i < 16; ++i) o[dv][i] *= rstd * subln[32 * dv + (i & 3) + 8 * (i >> 2) + 4 * hh];
    }
#pragma unroll
    for (int dv = 0; dv < 2; ++dv)
#pragma unroll
        for (int g = 0; g < 4; ++g) { u32x2 w; w.x = pk2(o[dv][4 * g + 0], o[dv][4 * g + 1]); w.y = pk2(o[dv][4 * g + 2], o[dv][4 * g + 3]);
            *(u32x2*)(orow + 32 * dv + 8 * g + 4 * hh) = w; }
}

template <int ABL = 0> DI void attn_c_unit(const Ctx& p, const int u, ldsp lds, const int dry = 0) {
    const int wave = tid_now() >> 6, r = tid_now() & 31;
    const bf16_t* QC = (const bf16_t*)(p.ws + WS_X + X_QC); const bf16_t* KC = (const bf16_t*)(p.ws + WS_X + X_KC); const bf16_t* CVt = (const bf16_t*)(p.ws + WS_X + X_CVT);
    bf16_t* Z = (bf16_t*)(p.ws + WS_Z);
    int b, h, row, nt, t0;
    if (u < 512) { b = u >> 6; h = (u >> 4) & 3; row = b * SEQ + (u & 15) * 256 + wave * 32 + r; nt = 68; t0 = 0; }
    else { const int v = u - 512; b = v >> 2; h = v & 3; row = ML + b * CTXL + wave * 32 + r; nt = 4; t0 = 64; }
    const bf16_t* kbase = KC + (size_t)(b * 4 + h) * KEYS * 96; const bf16_t* vbase = CVt + (size_t)(b * 4 + h) * 64 * KEYS;
    attn_unit<96, 1, 0, ABL>(lds, QC + (size_t)row * 384 + h * 96, nt,
        [=](int j, const bf16_t*& kp, int& ldk, const bf16_t*& vp, int& kpos0, int& masked) { const int key0 = (t0 + j) * 64; kp = kbase + (size_t)key0 * 96; ldk = 96; vp = vbase + key0; kpos0 = 0; masked = 0; },
        0.10206207261596577f * 1.4426950408889634f, -1.0e30f, 0.f, 0, dry ? (bf16_t*)(p.ws + WS_END) + (size_t)(row & 8191) * 1024 + h * 64 : Z + (size_t)row * NZ + ZC_Q + h * 64, 0.f, 0.f, nullptr,
        u < 512 ? (row & 4095) : -1, (const f32x2*)(p.ws + WS_ROPE8));
}
DI void attn_d_unit(const Ctx& p, const int li, const int u, ldsp lds, const int dry = 0) {
    const int wave = tid_now() >> 6, r = tid_now() & 31;
    bf16_t* Z = (bf16_t*)(p.ws + WS_Z); const bf16_t* DVt = (const bf16_t*)(p.ws + WS_X + X_DVT);
    int b, h, row, nt, t0;
    if (u < 512) { b = u >> 6; h = (u >> 4) & 3; row = b * SEQ + (u & 15) * 256 + wave * 32 + r; nt = 68; t0 = 0; }
    else { const int v = u - 512; b = v >> 2; h = v & 3; row = ML + b * CTXL + wave * 32 + r; nt = 4; t0 = 64; }
    const float* lamv = (const float*)(p.ws + WS_LAM); const float lam = lamv[li * 2], lam_init = lamv[li * 2 + 1];
    const bf16_t* vbase = DVt + (size_t)(b * 4 + h) * 64 * KEYS; const bf16_t* zk = Z + ZD_K + h * 64;
    attn_unit<32, 2, 1>(lds, Z + (size_t)row * NZ + ZD_Q + h * 64, nt,
        [=](int j, const bf16_t*& kp, int& ldk, const bf16_t*& vp, int& kpos0, int& masked) { const int key0 = (t0 + j) * 64; kp = zk + (size_t)key_row(b, key0) * NZ; ldk = NZ; vp = vbase + key0; kpos0 = 0; masked = 0; },
        0.17677669529663687f * 1.4426950408889634f, -1.0e30f, 0.f, 0, dry ? (bf16_t*)(p.ws + WS_END) + (size_t)(row & 8191) * 1024 + h * 64 : Z + (size_t)row * NZ + ZD_Q + h * 64, lam, 1.f - lam_init, p.in[20] + li * 64,
        u < 512 ? (row & 4095) : -1, (const f32x2*)(p.ws + WS_ROPE8));
}
DI void attn_a_unit(const Ctx& p, const int li, const int u, ldsp lds, const int dry = 0) {
    const int wave = tid_now() >> 6, r = tid_now() & 31;
    bf16_t* Z = (bf16_t*)(p.ws + WS_Z); const bf16_t* AVt = (const bf16_t*)(p.ws + WS_X + X_AVT);
    int b, kvh, row, qpos, nt, tlo;
    const bool latq = u < 512;
    if (latq) { b = u >> 6; kvh = (u >> 5) & 1; const int qb = u & 31; qpos = qb * 128 + (wave & 3) * 32 + r; row = b * SEQ + qpos;
        const int lo = qb > 0 ? (qb - 1) * 2 : 0, hi = qb < 31 ? (qb + 2) * 2 : 64; tlo = lo; nt = (hi - lo) + 4; }
    else { const int v = u - 512; b = v >> 2; kvh = (v >> 1) & 1; qpos = 0; row = ML + b * CTXL + (v & 1) * 128 + (wave & 3) * 32 + r; tlo = 64; nt = 4; }
    const int head = 2 * kvh + (wave >> 2);
    const int nband = latq ? nt - 4 : 0;
    const bf16_t* vbase = AVt + (size_t)(b * 2 + kvh) * 64 * KEYS; const bf16_t* zk = Z + ZA_K + kvh * 64;
    const float sink = p.in[12][li * 4 + head] * 1.4426950408889634f;
    attn_unit<64, 1, 2>(lds, Z + (size_t)row * NZ + ZA_Q + head * 64, nt,
        [=](int j, const bf16_t*& kp, int& ldk, const bf16_t*& vp, int& kpos0, int& masked) {
            const int key0 = j < nband ? (tlo + j) * 64 : SEQ + (j - nband) * 64;
            kp = zk + (size_t)key_row(b, key0) * NZ; ldk = NZ; vp = vbase + key0; kpos0 = key0; masked = j < nband; },
        0.125f * 1.4426950408889634f, sink, (tid_now() & 32) ? 0.f : 1.f, qpos, dry ? (bf16_t*)(p.ws + WS_END) + (size_t)(row & 8191) * 1024 + head * 64 : Z + (size_t)row * NZ + ZA_Q + head * 64, 0.f, 0.f, nullptr,
        latq ? qpos : -1, (const f32x2*)(p.ws + WS_ROPE16));
}

enum { PH_PRE = 0, PH_WN1, PH_IN, PH_PREP, PH_MLA, PH_MIX, PH_GATE0, PH_MERGE0, PH_GATE1, PH_MERGE1, PH_OUT, PH_NORM2, PH_SCAT, PH_MOE1, PH_MOE2, PH_FINAL, PH_COUNT };

template <int PH> DI void run_phase(const Params& P, const CtxRaw& pc, const int li, ldsp lds) {
    const Ctx p = fresh(pc);
    unsigned char* ws = p.ws; const char* wt = (const char*)(ws + WS_WT);
    const int G = gdim_now(), c = bid_now();
    if constexpr (PH == PH_PRE) phase_pre(P, lds);
    if constexpr (PH == PH_WN1) { phase_wconv(p, li, lds); phase_norm<0>(p, li); }
    if constexpr (PH == PH_IN) {
        pg8::SchedPlain S{(const char*)(ws + WS_HB), wt + WT_IN, 1024, 1024, MT / 256, NZ / 256, G, c, 0};
        pg8::EpiZ E{(bf16_t*)(ws + WS_Z)};
        pg8::gemm_phase(lds, 1024, 1024, 1024, S, E);
    }
    if constexpr (PH == PH_PREP) phase_prep(p, li, lds);
    if constexpr (PH == PH_MLA) {
        pg8::SchedPlain S{(const char*)(ws + WS_Z) + ZC_Q * 2, wt + WT_MLA, NZ, 384, MT / 256, 4, G, c, 0};
        pg8::EpiMla E{(bf16_t*)(ws + WS_X + X_QC), (bf16_t*)(ws + WS_X + X_KC), (bf16_t*)(ws + WS_X + X_CVT)};
#ifdef DUP_HSCAN
        { int dry = 1; asm volatile("" : "+s"(dry)); phase_hscan(p, dry); }
#endif
        phase_hscan(p);
#ifdef DUP_MLAG
        pg8::gemm_phase(lds, NZ, 384, 384, S, E);
#endif
        pg8::gemm_phase(lds, NZ, 384, 384, S, E);
    }
    if constexpr (PH == PH_MIX) {
        const int nq = li == 0 ? 544 : 512;
        const int cv = (G & 7) == 0 ? (c & 7) * (G >> 3) + (c >> 3) : c;
        for (int u = cv; u < nq; u += G) attn_c_unit(p, u, lds);
#ifdef DUP_ATTN_C
        { int dry = 1; asm volatile("" : "+s"(dry)); __syncthreads(); for (int u = cv; u < nq; u += G) attn_c_unit<DUP_ATTN_C>(p, u, lds, dry); __syncthreads(); }
#endif
#ifdef DUP_ATTN_D
        { int dry = 1; asm volatile("" : "+s"(dry)); for (int u = cv; u < nq; u += G) attn_d_unit(p, li, u, lds, dry); __syncthreads(); }
#endif
        for (int u = (cv + 32) % G; u < nq; u += G) attn_d_unit(p, li, u, lds);
#ifdef DUP_ATTN_A
        { int dry = 1; asm volatile("" : "+s"(dry)); for (int u = cv; u < nq; u += G) attn_a_unit(p, li, u, lds, dry); __syncthreads(); }
#endif
        for (int u = (cv + 64) % G; u < nq; u += G) attn_a_unit(p, li, u, lds);
        __syncthreads();
        const int nch = li == 0 ? NCHUNK : 512;
#ifdef DUP_H3
        { int dry = 1; asm volatile("" : "+s"(dry)); for (int u = cv; u < nch; u += G) hgrn3_unit(p, li, u, lds, dry); __syncthreads(); }
#endif
        for (int u = (cv + 96) % G; u < nch; u += G) hgrn3_unit(p, li, u, lds);
    }
    if constexpr (PH == PH_GATE0) {
        const int nM = li == 0 ? 136 : 128;
        pg8::SchedPlain S{(const char*)(ws + WS_HB), wt + WT_G, 1024, 1024, nM, 16, G, c, 0};
        pg8::EpiGate E{(unsigned char*)(ws + WS_X)};
        pg8::gemm_phase(lds, 1024, 1024, 1024, S, E);
    }
    if constexpr (PH == PH_MERGE0) {
        const int nM = li == 0 ? 136 : 128;
        pg8::SchedSeg S{(const char*)(ws + WS_Z), wt + WT_B, nM, G, c, 0};
        pg8::EpiHorner E{(bf16_t*)(ws + WS_Z), (const unsigned char*)(ws + WS_X)};
        pg8::gemm_seg(lds, NZ, 256, S, E);
    }
    if constexpr (PH == PH_OUT) {
        const int nM = li == 0 ? 136 : 128;
        pg8::SchedPlain S{(const char*)(ws + WS_Z) + ZY * 2, wt + WT_O, NZ, 1024, nM, 4, G, c, 0};
        float* ctxs = (float*)(ws + WS_CTXS);
        pg8::EpiOut E{li == 0 ? p.in[0] : p.out, li == 0 ? p.in[2] : ctxs, p.out, ctxs, (const float*)(ws + WS_MODV) + li * 9 * 6144};
        pg8::gemm_phase(lds, NZ, 1024, 1024, S, E);
    }
    if constexpr (PH == PH_NORM2) {
#ifdef DUP_NORM2
        { int dry = 1; asm volatile("" : "+s"(dry)); phase_norm2(p, li, lds, dry); __syncthreads(); }
#endif
        phase_norm2(p, li, lds); }
    if constexpr (PH == PH_MOE1 || PH == PH_MOE2) {
        LAS unsigned* off = (LAS unsigned*)(lds + pg8::STAGE_BYTES + 1024); LAS unsigned char* pe = (LAS unsigned char*)(lds + pg8::STAGE_BYTES);
        const unsigned* cnt = (const unsigned*)(ws + WS_CTL + CTL_CNT) + li * 32; const int* list = (const int*)(ws + WS_XG);
        const int nP = moe_offsets(cnt, off, pe);
        if constexpr (PH == PH_MOE1) {
            pg8::SchedMoeT<false> S{wt + WT_E1, 1024, nP, 2, G, c, (size_t)512 * 1024 * 2, pe, off, list, cnt, 1, 11};
            pg8::EpiMoeUp E{(bf16_t*)(ws + WS_HMID), off, cnt};
            pg8::gemm_gather(lds, (const char*)(ws + WS_HB), 1024, 1024, S, E);
        } else {
            pg8::SchedMoeT<true> S{wt + WT_E2, 256, nP, 4, G, c, (size_t)1024 * 256 * 2, pe, off, list, cnt, 0, 9};
            pg8::EpiMoeDown E{(bf16_t*)(ws + WS_Y), off, list, cnt, (const float*)(ws + WS_XG) + (size_t)32 * MOE_CAP};
            pg8::gemm_gather(lds, (const char*)(ws + WS_HMID), 256, 256, S, E);
        }
        __syncthreads();
    }
    if constexpr (PH == PH_FINAL) phase_norm<2>(p, 1);
}

#if N_LAUNCH_MODE == 1
template <int PH> __global__ __launch_bounds__(512, 2) void k_phase(Params p, int li) {
    extern __shared__ __attribute__((aligned(16))) unsigned char shm[];
    CtxRaw c; c.tab = (unsigned long long)(p.ws + WS_TAB); c.out = (unsigned long long)p.out; c.ws = (unsigned long long)p.ws;
    run_phase<PH>(p, c, li, (ldsp)shm);
}
#else
__global__ __launch_bounds__(512, 2) void k_mega(Params p) {
    extern __shared__ __attribute__((aligned(16))) unsigned char shm[];
    ldsp lds = (ldsp)shm;
    volatile LAS unsigned* st = (volatile LAS unsigned*)(lds + LDS_BYTES - 16);
    if (tid_now() == 0) { st[0] = 0u; st[1] = 0u; st[2] = 0u; st[3] = 0u; }
    __syncthreads();
    XcdBarrier bar = xcd_barrier_post((unsigned*)(p.ws + WS_CTL), st);
    CtxRaw c; c.tab = (unsigned long long)(p.ws + WS_TAB); c.out = (unsigned long long)p.out; c.ws = (unsigned long long)p.ws;
#ifdef STAMP_A
    LAS unsigned* tacc = (LAS unsigned*)(lds + LDS_BYTES - 512);
    if (tid_now() < 32) tacc[tid_now()] = 0u;
    __syncthreads();
    unsigned long long tprev = __builtin_amdgcn_s_memrealtime();
#define STAMP(ph) do { if (bid_now() == 0 && tid_now() == 0) { const unsigned long long tn = __builtin_amdgcn_s_memrealtime(); tacc[ph] += (unsigned)(tn - tprev); tprev = tn; } } while (0)
#else
#define STAMP(ph) do { } while (0)
#endif
#ifndef DUP_MASK
#define DUP_MASK 0
#endif
#ifndef DUP_L0_MASK
#define DUP_L0_MASK 0
#endif
#define DUP(PHX) do { if (((DUP_MASK >> PHX) & 1) || (((DUP_L0_MASK >> PHX) & 1) && li == 0)) { run_phase<PHX>(p, c, li, lds); xcd_barrier(bar); } } while (0)
    run_phase<PH_PRE>(p, c, 0, lds); xcd_barrier(bar); STAMP(PH_PRE);
#ifdef DUP_PRE
    run_phase<PH_PRE>(p, c, 0, lds); xcd_barrier(bar);
#endif
    for (int li = 0; li < 2; ++li) {
        run_phase<PH_WN1>(p, c, li, lds); xcd_barrier(bar); STAMP(PH_WN1); DUP(PH_WN1);
        run_phase<PH_IN>(p, c, li, lds); xcd_barrier(bar); STAMP(PH_IN); DUP(PH_IN);
        run_phase<PH_PREP>(p, c, li, lds); xcd_barrier(bar); STAMP(PH_PREP); DUP(PH_PREP);
        run_phase<PH_MLA>(p, c, li, lds); xcd_barrier(bar); STAMP(PH_MLA); DUP(PH_MLA);
        run_phase<PH_MIX>(p, c, li, lds); xcd_barrier(bar); STAMP(PH_MIX); DUP(PH_MIX);
        run_phase<PH_GATE0>(p, c, li, lds); xcd_barrier(bar); STAMP(PH_GATE0); DUP(PH_GATE0);
        run_phase<PH_MERGE0>(p, c, li, lds); xcd_barrier(bar); STAMP(PH_MERGE0); DUP(PH_MERGE0);
        run_phase<PH_OUT>(p, c, li, lds); xcd_barrier(bar); STAMP(PH_OUT); DUP(PH_OUT);
        run_phase<PH_NORM2>(p, c, li, lds); xcd_barrier(bar); STAMP(PH_NORM2); DUP(PH_NORM2);
        run_phase<PH_MOE1>(p, c, li, lds); xcd_barrier(bar); STAMP(PH_MOE1); DUP(PH_MOE1);
        run_phase<PH_MOE2>(p, c, li, lds); xcd_barrier(bar); STAMP(PH_MOE2); DUP(PH_MOE2);
    }
#ifdef STAMP_A
    if (bid_now() == 0 && tid_now() == 0) { float* tv = (float*)(p.ws + WS_LAM + 64); unsigned sa = 0u, sb = 0u;
#pragma unroll
        for (int q = 0; q < PH_COUNT; ++q) { if ((STAMP_A >> q) & 1) sa += tacc[q]; if ((STAMP_B >> q) & 1) sb += tacc[q]; }
        tv[0] = (float)sa * 0.01f; tv[1] = (float)sb * 0.01f; }
    xcd_barrier(bar);
#endif
    run_phase<PH_FINAL>(p, c, 1, lds);
}
#endif

extern "C" void kernel_launch(void* const* d_in, const int* in_sizes, int n_in, void* d_out, int out_size, void* d_ws, size_t ws_size, hipStream_t stream) {
    if (n_in != 29 || ws_size < WS_END || out_size != ML * D) { fprintf(stderr, "kernel_launch: unexpected shapes (n_in %d, ws %zu need %zu, out %d)\n", n_in, ws_size, (size_t)WS_END, out_size); return; }
    Params p{};
    for (int i = 0; i < 29; ++i) p.in[i] = (const float*)d_in[i];
    p.out = (float*)d_out; p.ws = (unsigned char*)d_ws;
    hipMemsetAsync((char*)d_ws + WS_CTL, 0, 65536, stream);
    const int grid = 256;
#if N_LAUNCH_MODE == 1
    static bool init = false;
#define SETLDS(PH) hipFuncSetAttribute((const void*)k_phase<PH>, hipFuncAttributeMaxDynamicSharedMemorySize, LDS_BYTES)
    if (!init) { SETLDS(PH_PRE); SETLDS(PH_WN1); SETLDS(PH_IN); SETLDS(PH_PREP); SETLDS(PH_MLA); SETLDS(PH_MIX); SETLDS(PH_GATE0); SETLDS(PH_MERGE0); SETLDS(PH_GATE1); SETLDS(PH_MERGE1);
        SETLDS(PH_OUT); SETLDS(PH_NORM2); SETLDS(PH_SCAT); SETLDS(PH_MOE1); SETLDS(PH_MOE2); SETLDS(PH_FINAL); init = true; }
#define LAUNCH(PH, li) hipLaunchKernelGGL(k_phase<PH>, dim3(grid), dim3(512), LDS_BYTES, stream, p, li)
    LAUNCH(PH_PRE, 0);
    for (int li = 0; li < 2; ++li) {
        LAUNCH(PH_WN1, li); LAUNCH(PH_IN, li); LAUNCH(PH_PREP, li); LAUNCH(PH_MLA, li); LAUNCH(PH_MIX, li);
        LAUNCH(PH_GATE0, li); LAUNCH(PH_MERGE0, li); LAUNCH(PH_OUT, li);
        LAUNCH(PH_NORM2, li); LAUNCH(PH_MOE1, li); LAUNCH(PH_MOE2, li);
    }
    LAUNCH(PH_FINAL, 1);
#else
    static bool init = false;
    if (!init) { hipFuncSetAttribute((const void*)k_mega, hipFuncAttributeMaxDynamicSharedMemorySize, LDS_BYTES); init = true; }
    hipLaunchKernelGGL(k_mega, dim3(grid), dim3(512), LDS_BYTES, stream, p);
#endif
}
```

```cpp
#include <hip/hip_runtime.h>
#include <stdint.h>
#include <stdio.h>

#ifndef N_LAUNCH_MODE
#define N_LAUNCH_MODE 0
#endif

#define LAS __attribute__((address_space(3)))
#define GAS __attribute__((address_space(1)))
typedef LAS unsigned char* ldsp;
typedef unsigned short bf16_t;
typedef short bf16x8 __attribute__((ext_vector_type(8)));
typedef short s16x4 __attribute__((ext_vector_type(4)));
typedef float f32x2 __attribute__((ext_vector_type(2)));
typedef float f32x4 __attribute__((ext_vector_type(4)));
typedef float f32x16 __attribute__((ext_vector_type(16)));
typedef unsigned u32x2 __attribute__((ext_vector_type(2)));
typedef unsigned u32x4 __attribute__((ext_vector_type(4)));
typedef __bf16 bf16x2_t __attribute__((ext_vector_type(2)));
#define DI __device__ __forceinline__

constexpr int D = 1024, NBAT = 8, SEQ = 4096, CTXL = 256;
constexpr int ML = NBAT * SEQ, MC = NBAT * CTXL, MT = ML + MC;
constexpr int NZ = 3072, KEYS = SEQ + CTXL;
constexpr int ZA_Q = 0, ZA_K = 256, ZA_V = 384, ZB_Q = 512, ZB_FF = 768, ZB_FB = 1024, ZB_I = 1280, ZB_G = 1536,
              ZC_Q = 1792, ZC_KV = 2048, ZC_KR = 2176, ZD_Q = 2208, ZD_K = 2464, ZD_V = 2720;
constexpr int ZY = 768;
constexpr int NCHUNK = MT / 64;
constexpr int MOE_MAXROWS = 77824;
constexpr int MOE_CAP = 2 * MT;
constexpr float NORM_EPS = 1e-6f;
constexpr int LDS_BYTES = 155648;
constexpr int HALF_ROWS = MT / 2;

constexpr size_t WS_CTL = 0;
constexpr size_t CTL_CNT = 16384;
constexpr size_t WS_MODV = 65536;
constexpr size_t WS_ROPE16 = 524288;
constexpr size_t WS_ROPE8 = WS_ROPE16 + 8192;
constexpr size_t WS_TAB = WS_ROPE8 + 8192;
constexpr size_t WS_LAM = WS_ROPE8 + 4096;
constexpr size_t WS_TOKI = 1048576;
constexpr size_t WS_ROWI = WS_TOKI + (size_t)MT * 32;
constexpr size_t WS_ROWW = WS_ROWI + (size_t)MOE_MAXROWS * 4;
constexpr size_t WS_HE = WS_ROWW + (size_t)MOE_MAXROWS * 4;
constexpr size_t WS_WT = 4u << 20;
constexpr size_t WT_IN = 0, WT_G = WT_IN + (size_t)NZ * 1024 * 2, WT_B = WT_G + (size_t)4096 * 1024 * 2, WT_O = WT_B + (size_t)4 * 1024 * 256 * 2,
                 WT_MLA = WT_O + (size_t)1024 * 1024 * 2, WT_E1 = WT_MLA + (size_t)1024 * 384 * 2, WT_E2 = WT_E1 + (size_t)32 * 512 * 1024 * 2,
                 WT_END = WT_E2 + (size_t)32 * 1024 * 256 * 2;
constexpr size_t WS_CTXS = WS_WT + WT_END;
constexpr size_t WS_HB = WS_CTXS + (size_t)MC * 1024 * 4;
constexpr size_t WS_Z = WS_HB + (size_t)MT * 1024 * 2;
constexpr size_t WS_X = WS_Z + (size_t)MT * NZ * 2;
constexpr size_t X_QC = 0, X_KC = X_QC + (size_t)MT * 384 * 2, X_CVT = X_KC + (size_t)NBAT * 4 * KEYS * 96 * 2, X_AVT = X_CVT + (size_t)NBAT * 4 * 64 * KEYS * 2,
                 X_DVT = X_AVT + (size_t)NBAT * 2 * 64 * KEYS * 2, X_U = X_DVT + (size_t)NBAT * 4 * 64 * KEYS * 2, X_END_MIX = X_U + (size_t)NCHUNK * 4 * 2 * 4096 * 2;
constexpr size_t X_SIZE = (size_t)MT * 4096;
static_assert(X_END_MIX <= X_SIZE, "mixer extras must fit the gate region");
constexpr size_t WS_END = WS_X + X_SIZE;
constexpr size_t WS_XG = WS_Z;
constexpr size_t WS_HMID = WS_XG + (size_t)MOE_MAXROWS * 1024 * 2;
constexpr size_t WS_Y = WS_HMID + (size_t)MOE_MAXROWS * 256 * 2;
static_assert(WS_Y + (size_t)2 * MT * 1024 * 2 <= WS_END, "MoE buffers must fit");

struct Params { const float* in[29]; float* out; unsigned char* ws; };
struct Inp { const unsigned long long GAS* tab; DI const float* operator[](int i) const { return (const float*)(const float GAS*)tab[i]; } };
struct Ctx { Inp in; float* out; unsigned char* ws; };
struct CtxRaw { unsigned long long tab, out, ws; };
DI Ctx fresh(CtxRaw c) { asm volatile("" : "+s"(c.tab), "+s"(c.out), "+s"(c.ws)); Ctx q; q.in.tab = (const unsigned long long GAS*)c.tab; q.out = (float*)(float GAS*)c.out; q.ws = (unsigned char*)(unsigned char GAS*)c.ws; return q; }

DI int bid_now() { int t = (int)__builtin_amdgcn_workgroup_id_x(); asm volatile("" : "+s"(t)); return t; }
DI int gdim_now() { int t = (int)__builtin_amdgcn_grid_size_x() / 512; asm volatile("" : "+s"(t)); return t; }
DI int tid_now() { int t = (int)__builtin_amdgcn_workitem_id_x(); asm volatile("" : "+v"(t)); return t; }
DI unsigned pk2(float a, float b) { f32x2 v = {a, b}; bf16x2_t r = __builtin_convertvector(v, bf16x2_t); return __builtin_bit_cast(unsigned, r); }
DI float bflo(unsigned u) { return __uint_as_float(u << 16); }
DI float bfhi(unsigned u) { return __uint_as_float(u & 0xffff0000u); }
DI float bf2f(bf16_t v) { return __uint_as_float((unsigned)v << 16); }
DI bf16_t f2bf(float f) { return (bf16_t)(pk2(f, 0.f) & 0xffffu); }
DI float sigmoidf_(float v) { return __builtin_amdgcn_rcpf(1.f + __expf(-v)); }
template <int CTRL> DI float dpp_f(float x) { return __builtin_bit_cast(float, __builtin_amdgcn_update_dpp(0, __builtin_bit_cast(int, x), CTRL, 0xf, 0xf, true)); }
DI float wave_sum(float v) { v += dpp_f<0xB1>(v); v += dpp_f<0x4E>(v); v += dpp_f<0x141>(v); v += dpp_f<0x140>(v); v += __shfl_xor(v, 16); v += __shfl_xor(v, 32); return v; }
DI void row_bk(int row, int& b, int& key) { if (row < ML) { b = row >> 12; key = row & 4095; } else { const int r = row - ML; b = r >> 8; key = SEQ + (r & 255); } }
DI int key_row(int b, int key) { return key < SEQ ? b * SEQ + key : ML + b * CTXL + (key - SEQ); }
DI int chunk_row0(int cidx) { return cidx < 512 ? cidx * 64 : ML + (cidx - 512) * 64; }

#define XB_TMO      128
#define XB_XCNT(j)  (256  + 64 * (j))
#define XB_XSUB(j)  (1280 + 64 * (j))
#define XB_XGEN(j)  (2304 + 64 * (j))
#define XB_TOP      3328
#define XB_TOPGEN   3392
#define XCD_BAR_WORDS 3456
#define XB_SPIN_CAP (1u << 22)
DI unsigned xb_ld(unsigned* p)              { return __hip_atomic_load(p, __ATOMIC_RELAXED, __HIP_MEMORY_SCOPE_AGENT); }
DI unsigned xb_add(unsigned* p, unsigned v) { return __hip_atomic_fetch_add(p, v, __ATOMIC_RELAXED, __HIP_MEMORY_SCOPE_AGENT); }
DI unsigned xb_xcc_id() { return (unsigned)__builtin_amdgcn_s_getreg((3 << 11) | 20) & 0xFu; }
#define XB_SPIN(cond, bar) do { unsigned _sp = 0; while (cond) { __builtin_amdgcn_s_sleep(1); \
    if ((++_sp & 255u) == 0u) { if (xb_ld(&(bar)[XB_TMO])) break; if (_sp > XB_SPIN_CAP) { atomicAdd(&(bar)[XB_TMO], 1u); break; } } } } while (0)
struct XcdBarrier { unsigned* bar; unsigned x; volatile LAS unsigned* st; };
DI XcdBarrier xcd_barrier_post(unsigned* bar, volatile LAS unsigned* st) {
    XcdBarrier b; b.bar = bar; b.x = xb_xcc_id(); b.st = st;
    if (tid_now() == 0) (void)xb_add(&bar[XB_XCNT(b.x)], 1u);
    return b;
}
DI void xcd_barrier_complete(unsigned* bar, unsigned x, unsigned& nloc, unsigned& nx) {
    const unsigned G = (unsigned)gdim_now();
    unsigned sum, cnt, mine, sp = 0u;
    for (;;) {
        sum = 0u; cnt = 0u;
#pragma unroll 1
        for (unsigned j = 0; j < 16; ++j) { const unsigned c = xb_ld(&bar[XB_XCNT(j)]); sum += c; cnt += (c > 0u) ? 1u : 0u; }
        if (sum == G) break;
        __builtin_amdgcn_s_sleep(1);
        if ((++sp & 255u) == 0u) { if (xb_ld(&bar[XB_TMO])) break; if (sp > XB_SPIN_CAP) { atomicAdd(&bar[XB_TMO], 1u); break; } }
    }
    mine = xb_ld(&bar[XB_XCNT(x)]);
    nloc = mine > 0u ? mine : 1u; nx = cnt > 0u ? cnt : 1u;
}
DI void xcd_barrier1(const XcdBarrier& b) {
    asm volatile("s_waitcnt vmcnt(0)" ::: "memory");
    __syncthreads();
    if (tid_now() == 0) {
        unsigned long long ba = (unsigned long long)b.bar; unsigned bx = b.x; asm volatile("" : "+s"(ba), "+s"(bx));
        unsigned* bar = (unsigned*)(unsigned GAS*)ba;
        __builtin_amdgcn_s_waitcnt(0);
        unsigned nloc = b.st[0], nx = b.st[1];
        if (nloc == 0u) { xcd_barrier_complete(bar, bx, nloc, nx); b.st[0] = nloc; b.st[1] = nx; }
        const unsigned old = xb_add(&bar[XB_XSUB(bx)], 1u);
        const unsigned gen = old / nloc;
        if (old + 1u == (gen + 1u) * nloc) {
            __builtin_amdgcn_fence(__ATOMIC_RELEASE, "agent");
            asm volatile("s_waitcnt vmcnt(0)" ::: "memory");
            const unsigned og = xb_add(&bar[XB_TOP], 1u);
            const unsigned tg = og / nx;
            if (og + 1u == (tg + 1u) * nx) xb_add(&bar[XB_TOPGEN], 1u);
            else XB_SPIN(xb_ld(&bar[XB_TOPGEN]) == tg, bar);
            __builtin_amdgcn_fence(__ATOMIC_ACQUIRE, "agent");
            xb_add(&bar[XB_XGEN(bx)], 1u);
            asm volatile("s_waitcnt vmcnt(0)" ::: "memory");
        } else {
            XB_SPIN(xb_ld(&bar[XB_XGEN(bx)]) == gen, bar);
            __builtin_amdgcn_fence(__ATOMIC_ACQUIRE, "agent");
            asm volatile("s_waitcnt vmcnt(0)" ::: "memory");
        }
    }
    __syncthreads();
}
DI void xcd_barrier(const XcdBarrier& b) {
    xcd_barrier1(b);
#ifdef DUP_BARRIER
    xcd_barrier1(b); xcd_barrier1(b);
#endif
}

namespace pg8 {
constexpr int BM = 256, BK = 64, HALF = 128, HTB = HALF * BK * 2, STAGE_BYTES = 8 * HTB, NXCD = 8, WGM = 8;
DI int lds_byte(int r, int c) { const int st = (r >> 4) * 2 + (c >> 5), rr = r & 15, cc = c & 31, ob = rr * 64 + cc * 2; return st * 1024 + (ob ^ (((ob >> 9) & 1) << 5)); }
DI void stage_rc(int b, int& R, int& C) { const int st = b / 1024, sb = b % 1024, swz = sb ^ (((sb >> 9) & 1) << 5); R = (st >> 1) * 16 + swz / 64; C = (st & 1) * 32 + (swz % 64) / 2; }
DI int perm32(int rho) { const int n = rho >> 4, i = rho & 15; return 8 * (i >> 2) + 4 * n + (i & 3); }
struct Unit { int pm, pn, aux; };
DI void tile_of(int L, int nM, int nN, int& pm, int& pn) {
    const int nwg = nM * nN; int wgid = L;
    { const int q = nwg / NXCD, r = nwg % NXCD, xcd = wgid % NXCD, off = wgid / NXCD; wgid = (xcd < r ? xcd * (q + 1) : r * (q + 1) + (xcd - r) * q) + off; }
    const int nig = WGM * nN, gid = wgid / nig, fm = gid * WGM, gsz = (nM - fm) < WGM ? (nM - fm) : WGM;
    pm = fm + ((wgid % nig) % gsz); pn = (wgid % nig) / gsz;
}

template <class Epi, class Sched>
DI void gemm_phase(ldsp lds, const int lda, const int ldb, const int K, const Sched& S, const Epi& E) {
    const int tid = tid_now(), wid = __builtin_amdgcn_readfirstlane(tid >> 6), lane = tid & 63, wr = wid >> 2, wc = wid & 3, fr = lane & 15, fq = lane >> 4;
    const int nt = K / BK;
    unsigned voffA[2], voffB[2];
#pragma unroll
    for (int i = 0; i < 2; ++i) { int R, C; stage_rc(tid * 16 + i * 8192, R, C); const int Rb = Epi::PERM ? ((R & ~31) + perm32(R & 31)) : R;
        voffA[i] = (unsigned)(R * lda + C) * 2u; voffB[i] = (unsigned)(Rb * ldb + C) * 2u; }
    const size_t kstep = (size_t)(BK * 2);
    const size_t hstepA = (size_t)HALF * lda * 2, hstepB = (size_t)HALF * ldb * 2;
    const unsigned ldsw = (unsigned)wid * 1024u;
    const int aoff = lds_byte(wr * 64 + fr, fq * 8), boff = lds_byte(wc * 32 + fr, fq * 8);
#define PG8_SA(b, h) (((b) * 2 + (h)) * HTB)
#define PG8_SB(b, h) ((4 + (b) * 2 + (h)) * HTB)
#define PG8_STAGE(bufoff, gbase, voff) do { _Pragma("unroll") for (int _i = 0; _i < 2; ++_i) \
        __builtin_amdgcn_global_load_lds((const unsigned*)((const char*)(gbase) + (voff)[_i]), (LAS unsigned*)(lds + (bufoff) + ldsw + _i * 8192), 16, 0, 0); } while (0)
#define PG8_LDA(dst, b, h) do { _Pragma("unroll") for (int m = 0; m < 4; ++m) _Pragma("unroll") for (int k = 0; k < 2; ++k) dst[m][k] = *(const LAS bf16x8*)(lds + PG8_SA(b, h) + aoff + m * 2048 + k * 1024); } while (0)
#define PG8_LDB(dst, b, h) do { _Pragma("unroll") for (int n = 0; n < 2; ++n) _Pragma("unroll") for (int k = 0; k < 2; ++k) dst[n][k] = *(const LAS bf16x8*)(lds + PG8_SB(b, h) + boff + n * 2048 + k * 1024); } while (0)
#define PG8_MMA(ai, bj, At, Bt) do { __builtin_amdgcn_s_setprio(1); _Pragma("unroll") for (int m = 0; m < 4; ++m) _Pragma("unroll") for (int n = 0; n < 2; ++n) _Pragma("unroll") for (int k = 0; k < 2; ++k) \
        acc[ai][bj][m][n] = __builtin_amdgcn_mfma_f32_16x16x32_bf16(Bt[n][k], At[m][k], acc[ai][bj][m][n], 0, 0, 0); __builtin_amdgcn_s_setprio(0); } while (0)
#define PG8_WAIT_V(n) asm volatile("s_waitcnt vmcnt(" #n ")" ::: "memory")
#define PG8_WAIT_L(n) asm volatile("s_waitcnt lgkmcnt(" #n ")" ::: "memory")
#define PG8_BAR __builtin_amdgcn_s_barrier()
#define PG8_SCHED __builtin_amdgcn_sched_barrier(0)
    Unit cur, nxt; int ui = 0;
    if (!S.next(0, cur)) return;
    f32x4 acc[2][2][4][2];
#pragma unroll
    for (int a = 0; a < 2; ++a)
#pragma unroll
        for (int b = 0; b < 2; ++b)
#pragma unroll
            for (int m = 0; m < 4; ++m)
#pragma unroll
                for (int n = 0; n < 2; ++n) acc[a][b][m][n] = (f32x4){0.f, 0.f, 0.f, 0.f};
    bf16x8 At[4][2], B0[2][2], B1[2][2];
    const char* cA = S.abase(cur); const char* cB = S.bbase(cur);
    PG8_STAGE(PG8_SB(0, 0), cB, voffB); PG8_STAGE(PG8_SA(0, 0), cA, voffA); PG8_STAGE(PG8_SB(0, 1), cB + hstepB, voffB); PG8_STAGE(PG8_SA(0, 1), cA + hstepA, voffA);
    if (wr == 1) PG8_BAR;
    PG8_WAIT_V(4); PG8_BAR;
    PG8_STAGE(PG8_SB(1, 0), cB + kstep, voffB); PG8_STAGE(PG8_SA(1, 0), cA + kstep, voffA); PG8_STAGE(PG8_SB(1, 1), cB + hstepB + kstep, voffB);
    PG8_WAIT_V(6); PG8_BAR;
    for (;;) {
        const bool has_next = S.next(ui + 1, nxt);
        const char* nA = has_next ? S.abase(nxt) : cA; const char* nB = has_next ? S.bbase(nxt) : cB;
#pragma unroll 1
        for (int t = 0; t < nt; t += 2) {
            const bool last = (t == nt - 2);
            const char* a1 = cA + (size_t)(t + 1) * kstep;
            const char* a2 = last ? nA : cA + (size_t)(t + 2) * kstep; const char* b2 = last ? nB : cB + (size_t)(t + 2) * kstep;
            const char* a3 = a2 + kstep; const char* b3 = b2 + kstep;
            PG8_LDB(B0, 0, 0); PG8_SCHED; PG8_LDA(At, 0, 0); PG8_STAGE(PG8_SA(1, 1), a1 + hstepA, voffA);
            PG8_WAIT_L(8); PG8_BAR; PG8_WAIT_L(0); PG8_MMA(0, 0, At, B0); PG8_BAR; PG8_SCHED;
            PG8_LDB(B1, 0, 1); PG8_STAGE(PG8_SB(0, 0), b2, voffB);
            PG8_BAR; PG8_WAIT_L(0); PG8_MMA(0, 1, At, B1); PG8_BAR;
            PG8_LDA(At, 0, 1); PG8_STAGE(PG8_SA(0, 0), a2, voffA);
            PG8_BAR; PG8_WAIT_L(0); PG8_MMA(1, 0, At, B0); PG8_BAR; PG8_SCHED;
            PG8_STAGE(PG8_SB(0, 1), b2 + hstepB, voffB);
            PG8_WAIT_V(6); PG8_BAR; PG8_MMA(1, 1, At, B1); PG8_BAR;
            PG8_LDB(B0, 1, 0); PG8_SCHED; PG8_LDA(At, 1, 0); PG8_STAGE(PG8_SA(0, 1), a2 + hstepA, voffA);
            PG8_WAIT_L(8); PG8_BAR; PG8_WAIT_L(0); PG8_MMA(0, 0, At, B0); PG8_BAR; PG8_SCHED;
            PG8_LDB(B1, 1, 1); PG8_STAGE(PG8_SB(1, 0), b3, voffB);
            PG8_BAR; PG8_WAIT_L(0); PG8_MMA(0, 1, At, B1); PG8_BAR;
            PG8_LDA(At, 1, 1); PG8_STAGE(PG8_SA(1, 0), a3, voffA);
            PG8_BAR; PG8_WAIT_L(0); PG8_MMA(1, 0, At, B0); PG8_BAR; PG8_SCHED;
            PG8_STAGE(PG8_SB(1, 1), b3 + hstepB, voffB);
            PG8_WAIT_V(6); PG8_BAR; PG8_MMA(1, 1, At, B1); PG8_BAR;
        }
        { int fr2 = fr, fq2 = fq; asm volatile("" : "+v"(fr2), "+v"(fq2));
          E(acc, cur, wr, wc, fr2, fq2); }
        if (!has_next) break;
#pragma unroll
        for (int a = 0; a < 2; ++a)
#pragma unroll
            for (int b = 0; b < 2; ++b)
#pragma unroll
                for (int m = 0; m < 4; ++m)
#pragma unroll
                    for (int n = 0; n < 2; ++n) acc[a][b][m][n] = (f32x4){0.f, 0.f, 0.f, 0.f};
        cur = nxt; cA = nA; cB = nB; ++ui;
    }
    PG8_WAIT_V(0);
    if (wr == 0) PG8_BAR;
    PG8_BAR;
#undef PG8_SA
#undef PG8_SB
#undef PG8_STAGE
#undef PG8_LDA
#undef PG8_LDB
#undef PG8_MMA
#undef PG8_WAIT_V
#undef PG8_WAIT_L
#undef PG8_BAR
#undef PG8_SCHED
}

template <class Epi, class Sched>
DI void gemm_gather(ldsp lds, const char* Abase, const int ldb, const int K, const Sched& S, const Epi& E) {
    const int tid = tid_now(), wid = __builtin_amdgcn_readfirstlane(tid >> 6), lane = tid & 63, wr = wid >> 2, wc = wid & 3, fr = lane & 15, fq = lane >> 4;
    const int nt = K / BK;
    unsigned voffB[2]; int Ra0, Ca0, Ra1, Ca1; stage_rc(tid * 16, Ra0, Ca0); stage_rc(tid * 16 + 8192, Ra1, Ca1);
#pragma unroll
    for (int i = 0; i < 2; ++i) { int R, C; stage_rc(tid * 16 + i * 8192, R, C); const int Rb = Epi::PERM ? ((R & ~31) + perm32(R & 31)) : R; voffB[i] = (unsigned)(Rb * ldb + C) * 2u; }
    const size_t kstep = (size_t)(BK * 2);
    const size_t hstepB = (size_t)HALF * ldb * 2;
    unsigned c00, c01, c10, c11, n00 = 0u, n01 = 0u, n10 = 0u, n11 = 0u;
#define PG8_STAGE2(bufoff, gbase, v0, v1) do { \
        __builtin_amdgcn_global_load_lds((const unsigned*)((const char*)(gbase) + (v0)), (LAS unsigned*)(lds + (bufoff) + ldsw), 16, 0, 0); \
        __builtin_amdgcn_global_load_lds((const unsigned*)((const char*)(gbase) + (v1)), (LAS unsigned*)(lds + (bufoff) + ldsw + 8192), 16, 0, 0); } while (0)
    const unsigned ldsw = (unsigned)wid * 1024u;
    const int aoff = lds_byte(wr * 64 + fr, fq * 8), boff = lds_byte(wc * 32 + fr, fq * 8);
#define PG8_SA(b, h) (((b) * 2 + (h)) * HTB)
#define PG8_SB(b, h) ((4 + (b) * 2 + (h)) * HTB)
#define PG8_STAGE(bufoff, gbase, voff) do { _Pragma("unroll") for (int _i = 0; _i < 2; ++_i) \
        __builtin_amdgcn_global_load_lds((const unsigned*)((const char*)(gbase) + (voff)[_i]), (LAS unsigned*)(lds + (bufoff) + ldsw + _i * 8192), 16, 0, 0); } while (0)
#define PG8_LDA(dst, b, h) do { _Pragma("unroll") for (int m = 0; m < 4; ++m) _Pragma("unroll") for (int k = 0; k < 2; ++k) dst[m][k] = *(const LAS bf16x8*)(lds + PG8_SA(b, h) + aoff + m * 2048 + k * 1024); } while (0)
#define PG8_LDB(dst, b, h) do { _Pragma("unroll") for (int n = 0; n < 2; ++n) _Pragma("unroll") for (int k = 0; k < 2; ++k) dst[n][k] = *(const LAS bf16x8*)(lds + PG8_SB(b, h) + boff + n * 2048 + k * 1024); } while (0)
#define PG8_MMA(ai, bj, At, Bt) do { __builtin_amdgcn_s_setprio(1); _Pragma("unroll") for (int m = 0; m < 4; ++m) _Pragma("unroll") for (int n = 0; n < 2; ++n) _Pragma("unroll") for (int k = 0; k < 2; ++k) \
        acc[ai][bj][m][n] = __builtin_amdgcn_mfma_f32_16x16x32_bf16(Bt[n][k], At[m][k], acc[ai][bj][m][n], 0, 0, 0); __builtin_amdgcn_s_setprio(0); } while (0)
#define PG8_WAIT_V(n) asm volatile("s_waitcnt vmcnt(" #n ")" ::: "memory")
#define PG8_WAIT_L(n) asm volatile("s_waitcnt lgkmcnt(" #n ")" ::: "memory")
#define PG8_BAR __builtin_amdgcn_s_barrier()
#define PG8_SCHED __builtin_amdgcn_sched_barrier(0)
    Unit cur, nxt; int ui = 0;
    if (!S.next(0, cur)) return;
    f32x4 acc[2][2][4][2];
#pragma unroll
    for (int a = 0; a < 2; ++a)
#pragma unroll
        for (int b = 0; b < 2; ++b)
#pragma unroll
            for (int m = 0; m < 4; ++m)
#pragma unroll
                for (int n = 0; n < 2; ++n) acc[a][b][m][n] = (f32x4){0.f, 0.f, 0.f, 0.f};
    bf16x8 At[4][2], B0[2][2], B1[2][2];
    const char* cA = Abase; const char* cB = S.bbase(cur);
    S.rowoff(cur, Ra0, Ca0, Ra1, Ca1, c00, c01, c10, c11);
    PG8_STAGE(PG8_SB(0, 0), cB, voffB); PG8_STAGE2(PG8_SA(0, 0), cA, c00, c01); PG8_STAGE(PG8_SB(0, 1), cB + hstepB, voffB); PG8_STAGE2(PG8_SA(0, 1), cA, c10, c11);
    if (wr == 1) PG8_BAR;
    PG8_WAIT_V(4); PG8_BAR;
    PG8_STAGE(PG8_SB(1, 0), cB + kstep, voffB); PG8_STAGE2(PG8_SA(1, 0), cA + kstep, c00, c01); PG8_STAGE(PG8_SB(1, 1), cB + hstepB + kstep, voffB);
    PG8_WAIT_V(6); PG8_BAR;
    for (;;) {
        const bool has_next = S.next(ui + 1, nxt);
        const char* nB = has_next ? S.bbase(nxt) : cB;
        if (has_next) S.rowoff(nxt, Ra0, Ca0, Ra1, Ca1, n00, n01, n10, n11); else { n00 = c00; n01 = c01; n10 = c10; n11 = c11; }
#pragma unroll 1
        for (int t = 0; t < nt; t += 2) {
            const bool last = (t == nt - 2);
            const char* a1 = cA + (size_t)(t + 1) * kstep;
            const char* a2 = last ? cA : cA + (size_t)(t + 2) * kstep; const char* b2 = last ? nB : cB + (size_t)(t + 2) * kstep;
            const char* a3 = a2 + kstep; const char* b3 = b2 + kstep;
            const unsigned w00 = last ? n00 : c00, w01 = last ? n01 : c01, w10 = last ? n10 : c10, w11 = last ? n11 : c11;
            PG8_LDB(B0, 0, 0); PG8_SCHED; PG8_LDA(At, 0, 0); PG8_STAGE2(PG8_SA(1, 1), a1, c10, c11);
            PG8_WAIT_L(8); PG8_BAR; PG8_WAIT_L(0); PG8_MMA(0, 0, At, B0); PG8_BAR; PG8_SCHED;
            PG8_LDB(B1, 0, 1); PG8_STAGE(PG8_SB(0, 0), b2, voffB);
            PG8_BAR; PG8_WAIT_L(0); PG8_MMA(0, 1, At, B1); PG8_BAR;
            PG8_LDA(At, 0, 1); PG8_STAGE2(PG8_SA(0, 0), a2, w00, w01);
            PG8_BAR; PG8_WAIT_L(0); PG8_MMA(1, 0, At, B0); PG8_BAR; PG8_SCHED;
            PG8_STAGE(PG8_SB(0, 1), b2 + hstepB, voffB);
            PG8_WAIT_V(6); PG8_BAR; PG8_MMA(1, 1, At, B1); PG8_BAR;
            PG8_LDB(B0, 1, 0); PG8_SCHED; PG8_LDA(At, 1, 0); PG8_STAGE2(PG8_SA(0, 1), a2, w10, w11);
            PG8_WAIT_L(8); PG8_BAR; PG8_WAIT_L(0); PG8_MMA(0, 0, At, B0); PG8_BAR; PG8_SCHED;
            PG8_LDB(B1, 1, 1); PG8_STAGE(PG8_SB(1, 0), b3, voffB);
            PG8_BAR; PG8_WAIT_L(0); PG8_MMA(0, 1, At, B1); PG8_BAR;
            PG8_LDA(At, 1, 1); PG8_STAGE2(PG8_SA(1, 0), a3, w00, w01);
            PG8_BAR; PG8_WAIT_L(0); PG8_MMA(1, 0, At, B0); PG8_BAR; PG8_SCHED;
            PG8_STAGE(PG8_SB(1, 1), b3 + hstepB, voffB);
            PG8_WAIT_V(6); PG8_BAR; PG8_MMA(1, 1, At, B1); PG8_BAR;
        }
        { int fr2 = fr, fq2 = fq; asm volatile("" : "+v"(fr2), "+v"(fq2));
          E(acc, cur, wr, wc, fr2, fq2); }
        if (!has_next) break;
#pragma unroll
        for (int a = 0; a < 2; ++a)
#pragma unroll
            for (int b = 0; b < 2; ++b)
#pragma unroll
                for (int m = 0; m < 4; ++m)
#pragma unroll
                    for (int n = 0; n < 2; ++n) acc[a][b][m][n] = (f32x4){0.f, 0.f, 0.f, 0.f};
        cur = nxt; cB = nB; ++ui; c00 = n00; c01 = n01; c10 = n10; c11 = n11;
    }
    PG8_WAIT_V(0);
    if (wr == 0) PG8_BAR;
    PG8_BAR;
#undef PG8_SA
#undef PG8_SB
#undef PG8_STAGE
#undef PG8_STAGE2
#undef PG8_LDA
#undef PG8_LDB
#undef PG8_MMA
#undef PG8_WAIT_V
#undef PG8_WAIT_L
#undef PG8_BAR
#undef PG8_SCHED
}


template <class Epi, class Sched>
DI void gemm_seg(ldsp lds, const int lda, const int ldb, const Sched& S, const Epi& E) {
    constexpr int K = 1024;
    const int tid = tid_now(), wid = __builtin_amdgcn_readfirstlane(tid >> 6), lane = tid & 63, wr = wid >> 2, wc = wid & 3, fr = lane & 15, fq = lane >> 4;
    const int nt = K / BK;
    unsigned voffA[2], voffB[2];
#pragma unroll
    for (int i = 0; i < 2; ++i) { int R, C; stage_rc(tid * 16 + i * 8192, R, C); const int Rb = Epi::PERM ? ((R & ~31) + perm32(R & 31)) : R;
        voffA[i] = (unsigned)(R * lda + C) * 2u; voffB[i] = (unsigned)(Rb * ldb + C) * 2u; }
    const size_t kstep = (size_t)(BK * 2);
    const size_t hstepA = (size_t)HALF * lda * 2, hstepB = (size_t)HALF * ldb * 2;
    const unsigned ldsw = (unsigned)wid * 1024u;
    const int aoff = lds_byte(wr * 64 + fr, fq * 8), boff = lds_byte(wc * 32 + fr, fq * 8);
#define PG8_SA(b, h) (((b) * 2 + (h)) * HTB)
#define PG8_SB(b, h) ((4 + (b) * 2 + (h)) * HTB)
#define PG8_STAGE(bufoff, gbase, voff) do { _Pragma("unroll") for (int _i = 0; _i < 2; ++_i) \
        __builtin_amdgcn_global_load_lds((const unsigned*)((const char*)(gbase) + (voff)[_i]), (LAS unsigned*)(lds + (bufoff) + ldsw + _i * 8192), 16, 0, 0); } while (0)
#define PG8_LDA(dst, b, h) do { _Pragma("unroll") for (int m = 0; m < 4; ++m) _Pragma("unroll") for (int k = 0; k < 2; ++k) dst[m][k] = *(const LAS bf16x8*)(lds + PG8_SA(b, h) + aoff + m * 2048 + k * 1024); } while (0)
#define PG8_LDB(dst, b, h) do { _Pragma("unroll") for (int n = 0; n < 2; ++n) _Pragma("unroll") for (int k = 0; k < 2; ++k) dst[n][k] = *(const LAS bf16x8*)(lds + PG8_SB(b, h) + boff + n * 2048 + k * 1024); } while (0)
#define PG8_MMA(ai, bj, At, Bt) do { __builtin_amdgcn_s_setprio(1); _Pragma("unroll") for (int m = 0; m < 4; ++m) _Pragma("unroll") for (int n = 0; n < 2; ++n) _Pragma("unroll") for (int k = 0; k < 2; ++k) \
        acc[ai][bj][m][n] = __builtin_amdgcn_mfma_f32_16x16x32_bf16(Bt[n][k], At[m][k], acc[ai][bj][m][n], 0, 0, 0); __builtin_amdgcn_s_setprio(0); } while (0)
#define PG8_WAIT_V(n) asm volatile("s_waitcnt vmcnt(" #n ")" ::: "memory")
#define PG8_WAIT_L(n) asm volatile("s_waitcnt lgkmcnt(" #n ")" ::: "memory")
#define PG8_BAR __builtin_amdgcn_s_barrier()
#define PG8_SCHED __builtin_amdgcn_sched_barrier(0)
    Unit cur, nxt; int ui = 0;
    if (!S.next(0, cur)) return;
    f32x4 acc[2][2][4][2];
#pragma unroll
    for (int a = 0; a < 2; ++a)
#pragma unroll
        for (int b = 0; b < 2; ++b)
#pragma unroll
            for (int m = 0; m < 4; ++m)
#pragma unroll
                for (int n = 0; n < 2; ++n) acc[a][b][m][n] = (f32x4){0.f, 0.f, 0.f, 0.f};
    bf16x8 At[4][2], B0[2][2], B1[2][2];
    const char* cA = S.ak(cur, 0); const char* cB = S.bk(cur, 0);
    PG8_STAGE(PG8_SB(0, 0), cB, voffB); PG8_STAGE(PG8_SA(0, 0), cA, voffA); PG8_STAGE(PG8_SB(0, 1), cB + hstepB, voffB); PG8_STAGE(PG8_SA(0, 1), cA + hstepA, voffA);
    if (wr == 1) PG8_BAR;
    PG8_WAIT_V(4); PG8_BAR;
    PG8_STAGE(PG8_SB(1, 0), S.bk(cur, 1), voffB); PG8_STAGE(PG8_SA(1, 0), S.ak(cur, 1), voffA); PG8_STAGE(PG8_SB(1, 1), S.bk(cur, 1) + hstepB, voffB);
    PG8_WAIT_V(6); PG8_BAR;
    for (;;) {
        const bool has_next = S.next(ui + 1, nxt);
        Unit nu; nu.pm = has_next ? nxt.pm : cur.pm; nu.pn = has_next ? nxt.pn : cur.pn; nu.aux = 0;
#pragma unroll 1
        for (int t = 0; t < nt; t += 2) {
            const bool last = (t == nt - 2);
            const char* a1 = S.ak(cur, t + 1);
            const char* a2 = last ? S.ak(nu, 0) : S.ak(cur, t + 2); const char* b2 = last ? S.bk(nu, 0) : S.bk(cur, t + 2);
            const char* a3 = last ? S.ak(nu, 1) : S.ak(cur, t + 3); const char* b3 = last ? S.bk(nu, 1) : S.bk(cur, t + 3);
            if (t != 0 && (t & 3) == 0) { int fr2 = fr, fq2 = fq; asm volatile("" : "+v"(fr2), "+v"(fq2)); E.mid(acc, cur, (t >> 2) - 1, wr, wc, fr2, fq2); }
            PG8_LDB(B0, 0, 0); PG8_SCHED; PG8_LDA(At, 0, 0); PG8_STAGE(PG8_SA(1, 1), a1 + hstepA, voffA);
            PG8_WAIT_L(8); PG8_BAR; PG8_WAIT_L(0); PG8_MMA(0, 0, At, B0); PG8_BAR; PG8_SCHED;
            PG8_LDB(B1, 0, 1); PG8_STAGE(PG8_SB(0, 0), b2, voffB);
            PG8_BAR; PG8_WAIT_L(0); PG8_MMA(0, 1, At, B1); PG8_BAR;
            PG8_LDA(At, 0, 1); PG8_STAGE(PG8_SA(0, 0), a2, voffA);
            PG8_BAR; PG8_WAIT_L(0); PG8_MMA(1, 0, At, B0); PG8_BAR; PG8_SCHED;
            PG8_STAGE(PG8_SB(0, 1), b2 + hstepB, voffB);
            PG8_WAIT_V(6); PG8_BAR; PG8_MMA(1, 1, At, B1); PG8_BAR;
            PG8_LDB(B0, 1, 0); PG8_SCHED; PG8_LDA(At, 1, 0); PG8_STAGE(PG8_SA(0, 1), a2 + hstepA, voffA);
            PG8_WAIT_L(8); PG8_BAR; PG8_WAIT_L(0); PG8_MMA(0, 0, At, B0); PG8_BAR; PG8_SCHED;
            PG8_LDB(B1, 1, 1); PG8_STAGE(PG8_SB(1, 0), b3, voffB);
            PG8_BAR; PG8_WAIT_L(0); PG8_MMA(0, 1, At, B1); PG8_BAR;
            PG8_LDA(At, 1, 1); PG8_STAGE(PG8_SA(1, 0), a3, voffA);
            PG8_BAR; PG8_WAIT_L(0); PG8_MMA(1, 0, At, B0); PG8_BAR; PG8_SCHED;
            PG8_STAGE(PG8_SB(1, 1), b3 + hstepB, voffB);
            PG8_WAIT_V(6); PG8_BAR; PG8_MMA(1, 1, At, B1); PG8_BAR;
        }
        { int fr2 = fr, fq2 = fq; asm volatile("" : "+v"(fr2), "+v"(fq2));
          E(acc, cur, wr, wc, fr2, fq2); }
        if (!has_next) break;
#pragma unroll
        for (int a = 0; a < 2; ++a)
#pragma unroll
            for (int b = 0; b < 2; ++b)
#pragma unroll
                for (int m = 0; m < 4; ++m)
#pragma unroll
                    for (int n = 0; n < 2; ++n) acc[a][b][m][n] = (f32x4){0.f, 0.f, 0.f, 0.f};
        cur = nxt; ++ui;
    }
    PG8_WAIT_V(0);
    if (wr == 0) PG8_BAR;
    PG8_BAR;
#undef PG8_SA
#undef PG8_SB
#undef PG8_STAGE
#undef PG8_LDA
#undef PG8_LDB
#undef PG8_MMA
#undef PG8_WAIT_V
#undef PG8_WAIT_L
#undef PG8_BAR
#undef PG8_SCHED
}


struct SchedPlain {
    const char* A; const char* B; int lda, ldb, nM, nN, G, c, pm0;
    DI bool next(int i, Unit& u) const { const long L = (long)i * G + c; if (L >= (long)nM * nN) return false; tile_of((int)L, nM, nN, u.pm, u.pn); u.pm += pm0; u.aux = 0; return true; }
    DI const char* abase(const Unit& u) const { return A + (size_t)u.pm * 256 * lda * 2; }
    DI const char* bbase(const Unit& u) const { return B + (size_t)u.pn * 256 * ldb * 2; }
};
struct SchedMerge {
    const char* Z; const char* Wb; int nM, G, c, pm0;
    DI bool next(int i, Unit& u) const { const long L = (long)(i >> 2) * G + c; if (L >= (long)nM * 4) return false; tile_of((int)L, nM, 4, u.pm, u.pn); u.pm += pm0; u.aux = i & 3; return true; }
    DI const char* abase(const Unit& u) const { const int co = u.aux == 0 ? ZA_Q : (u.aux == 1 ? ZB_Q : (u.aux == 2 ? ZC_Q : ZD_Q)); return Z + ((size_t)u.pm * 256 * NZ + co) * 2; }
    DI const char* bbase(const Unit& u) const { return Wb + ((size_t)u.aux * 1024 * 256 + (size_t)u.pn * 256 * 256) * 2; }
};
struct SchedSeg {
    const char* Z; const char* Wb; int nM, G, c, pm0;
    DI bool next(int i, Unit& u) const { const long L = (long)i * G + c; if (L >= (long)nM * 4) return false; tile_of((int)L, nM, 4, u.pm, u.pn); u.pm += pm0; u.aux = 0; return true; }
    DI const char* ak(const Unit& u, const int kt) const { const int sg = kt >> 2; const int co = sg == 0 ? ZA_Q : (sg == 1 ? ZB_Q : (sg == 2 ? ZC_Q : ZD_Q)); return Z + ((size_t)u.pm * 256 * NZ + co + (kt & 3) * 64) * 2; }
    DI const char* bk(const Unit& u, const int kt) const { return Wb + ((size_t)(kt >> 2) * 1024 * 256 + (size_t)u.pn * 256 * 256 + (kt & 3) * 64) * 2; }
};
template <bool PLAIN> struct SchedMoeT {
    const char* B; int ldb, nP, nN, G, c; size_t estride; const LAS unsigned char* pe; const LAS unsigned* off; const int* list; const unsigned* cnt; int sh_r, sh_l;
    DI bool next(int i, Unit& u) const { const long L = (long)i * G + c; if (L >= (long)nP * nN) return false; u.pm = (int)(L / nN); u.pn = (int)(L % nN); u.aux = pe[u.pm]; return true; }
    DI const char* bbase(const Unit& u) const { return B + (size_t)u.aux * estride + (size_t)u.pn * 256 * ldb * 2; }
    DI void rowoff(const Unit& u, const int R0, const int C0, const int R1, const int C1, unsigned& v00, unsigned& v01, unsigned& v10, unsigned& v11) const {
        if (PLAIN) { const unsigned b = (unsigned)u.pm * 256u; v00 = ((b + R0) << sh_l) + C0 * 2; v01 = ((b + R1) << sh_l) + C1 * 2; v10 = ((b + 128 + R0) << sh_l) + C0 * 2; v11 = ((b + 128 + R1) << sh_l) + C1 * 2; return; }
        const int j0 = (u.pm - (int)(off[u.aux] >> 8)) * 256; const int n = (int)cnt[u.aux]; const int* lp = list + (size_t)u.aux * MOE_CAP;
        const int p00 = j0 + R0, p01 = j0 + R1, p10 = j0 + 128 + R0, p11 = j0 + 128 + R1;
        const unsigned i00 = p00 < n ? (unsigned)lp[p00] : 0u, i01 = p01 < n ? (unsigned)lp[p01] : 0u, i10 = p10 < n ? (unsigned)lp[p10] : 0u, i11 = p11 < n ? (unsigned)lp[p11] : 0u;
        v00 = ((i00 >> sh_r) << sh_l) + C0 * 2; v01 = ((i01 >> sh_r) << sh_l) + C1 * 2; v10 = ((i10 >> sh_r) << sh_l) + C0 * 2; v11 = ((i11 >> sh_r) << sh_l) + C1 * 2; }
};

#define EPI_ARGS const f32x4 (&acc)[2][2][4][2], const Unit& u, int wr, int wc, int fr, int fq
struct EpiZ { static constexpr bool PERM = true; bf16_t* Z;
    DI void operator()(EPI_ARGS) const {
        const int row0 = u.pm * 256 + wr * 64 + fr, col0 = u.pn * 256 + wc * 32 + 8 * fq;
#pragma unroll
        for (int ai = 0; ai < 2; ++ai)
#pragma unroll
            for (int m = 0; m < 4; ++m) { bf16_t* rp = Z + (size_t)(row0 + ai * 128 + m * 16) * NZ + col0;
#pragma unroll
                for (int bj = 0; bj < 2; ++bj) { const f32x4 v0 = acc[ai][bj][m][0], v1 = acc[ai][bj][m][1];
                    u32x4 w; w.x = pk2(v0[0], v0[1]); w.y = pk2(v0[2], v0[3]); w.z = pk2(v1[0], v1[1]); w.w = pk2(v1[2], v1[3]);
                    *(u32x4*)(rp + bj * 128) = w; } }
    } };
struct EpiMla { static constexpr bool PERM = true; bf16_t* QC; bf16_t* KC; bf16_t* CVt;
    DI void operator()(const f32x4 (&acc)[2][2][4][2], const Unit& u, int wr, int wc, int fr_in, int fq_in) const {
        int fr = fr_in, fq = fq_in; asm volatile("" : "+v"(fr), "+v"(fq));
#pragma unroll
        for (int ai = 0; ai < 2; ++ai)
#pragma unroll
            for (int m = 0; m < 4; ++m) {
                const int row = u.pm * 256 + wr * 64 + fr + ai * 128 + m * 16; int b, key; row_bk(row, b, key);
#pragma unroll
                for (int bj = 0; bj < 2; ++bj) {
                    const int c = u.pn * 256 + bj * 128 + wc * 32 + 8 * fq;
                    const f32x4 v0 = acc[ai][bj][m][0], v1 = acc[ai][bj][m][1];
                    float v[8] = {v0[0], v0[1], v0[2], v0[3], v1[0], v1[1], v1[2], v1[3]};
                    if (c < 384) {
                        u32x4 w; w.x = pk2(v[0], v[1]); w.y = pk2(v[2], v[3]); w.z = pk2(v[4], v[5]); w.w = pk2(v[6], v[7]);
                        *(u32x4*)(QC + (size_t)row * 384 + c) = w;
                    } else if (c < 896) {
                        const int c2 = c - 384, hh = c2 >> 7, j = c2 & 127;
                        if (j < 64) { u32x4 w; w.x = pk2(v[0], v[1]); w.y = pk2(v[2], v[3]); w.z = pk2(v[4], v[5]); w.w = pk2(v[6], v[7]);
                            *(u32x4*)(KC + ((size_t)(b * 4 + hh) * KEYS + key) * 96 + j) = w; }
                        else { bf16_t* vp = CVt + ((size_t)(b * 4 + hh) * 64 + (j - 64)) * KEYS + key;
#pragma unroll
                            for (int i = 0; i < 8; ++i) vp[(size_t)i * KEYS] = f2bf(v[i]); }
                    }
                }
                __builtin_amdgcn_sched_barrier(0);
            }
    } };
struct EpiGate { static constexpr bool PERM = true; unsigned char* G;
    DI void operator()(EPI_ARGS) const {
        const int row0 = u.pm * 256 + wr * 64 + fr, col0 = u.pn * 256 + wc * 32 + 8 * fq;
#pragma unroll
        for (int ai = 0; ai < 2; ++ai)
#pragma unroll
            for (int m = 0; m < 4; ++m) { unsigned char* rp = G + (size_t)(row0 + ai * 128 + m * 16) * 4096 + col0;
#pragma unroll
                for (int bj = 0; bj < 2; ++bj) { const f32x4 v0 = acc[ai][bj][m][0], v1 = acc[ai][bj][m][1];
                    auto q = [](float x) { return fmaxf(255.f * sigmoidf_(x), 1.f); };
                    u32x2 w; w.x = 0u; w.y = 0u;
#pragma unroll
                    for (int j = 0; j < 4; ++j) { w.x = __builtin_amdgcn_cvt_pk_u8_f32(q(v0[j]), j, w.x); w.y = __builtin_amdgcn_cvt_pk_u8_f32(q(v1[j]), j, w.y); }
                    *(u32x2*)(rp + bj * 128) = w; } }
    } };
struct EpiMerge { static constexpr bool PERM = true; bf16_t* Z; const bf16_t* G; int row_base;
    DI void operator()(EPI_ARGS) const {
        const int row0 = u.pm * 256 + wr * 64 + fr, col0 = u.pn * 256 + wc * 32 + 8 * fq;
#pragma unroll
        for (int ai = 0; ai < 2; ++ai) {
            u32x4 g[4][2], y[4][2];
#pragma unroll
            for (int m = 0; m < 4; ++m) { const int row = row0 + ai * 128 + m * 16;
                const bf16_t* yp = Z + (size_t)row * NZ + ZY + col0; const bf16_t* gp = G + (size_t)(row - row_base) * 4096 + u.aux * 1024 + col0;
#pragma unroll
                for (int bj = 0; bj < 2; ++bj) { g[m][bj] = *(const u32x4*)(gp + bj * 128); y[m][bj] = (u32x4){0u, 0u, 0u, 0u}; if (u.aux != 0) y[m][bj] = *(const u32x4*)(yp + bj * 128); } }
#pragma unroll
            for (int m = 0; m < 4; ++m) { const int row = row0 + ai * 128 + m * 16; bf16_t* yp = Z + (size_t)row * NZ + ZY + col0;
#pragma unroll
                for (int bj = 0; bj < 2; ++bj) { const f32x4 v0 = acc[ai][bj][m][0], v1 = acc[ai][bj][m][1]; const u32x4 gg = g[m][bj], yy = y[m][bj];
                    u32x4 w;
                    w.x = pk2(bflo(yy.x) + bflo(gg.x) * v0[0], bfhi(yy.x) + bfhi(gg.x) * v0[1]); w.y = pk2(bflo(yy.y) + bflo(gg.y) * v0[2], bfhi(yy.y) + bfhi(gg.y) * v0[3]);
                    w.z = pk2(bflo(yy.z) + bflo(gg.z) * v1[0], bfhi(yy.z) + bfhi(gg.z) * v1[1]); w.w = pk2(bflo(yy.w) + bflo(gg.w) * v1[2], bfhi(yy.w) + bfhi(gg.w) * v1[3]);
                    *(u32x4*)(yp + bj * 128) = w; } }
        }
    } };
struct EpiHorner { static constexpr bool PERM = true; bf16_t* Z; const unsigned char* G;
    DI void mid(f32x4 (&acc)[2][2][4][2], const Unit& u, const int seg, int wr, int wc, int fr, int fq) const {
        const int row0 = u.pm * 256 + wr * 64 + fr, col0 = u.pn * 256 + wc * 32 + 8 * fq;
        u32x2 gc[2][4][2], gn[2][4][2];
#pragma unroll
        for (int ai = 0; ai < 2; ++ai)
#pragma unroll
            for (int m = 0; m < 4; ++m) { const unsigned char* gp = G + (size_t)(row0 + ai * 128 + m * 16) * 4096 + seg * 1024 + col0;
#pragma unroll
                for (int bj = 0; bj < 2; ++bj) { gc[ai][m][bj] = *(const u32x2*)(gp + bj * 128); gn[ai][m][bj] = *(const u32x2*)(gp + 1024 + bj * 128); } }
#pragma unroll
        for (int ai = 0; ai < 2; ++ai)
#pragma unroll
            for (int m = 0; m < 4; ++m)
#pragma unroll
                for (int bj = 0; bj < 2; ++bj) { const u32x2 c2 = gc[ai][m][bj], n2 = gn[ai][m][bj];
#pragma unroll
                    for (int j = 0; j < 4; ++j) {
                        acc[ai][bj][m][0][j] *= (float)((c2.x >> (8 * j)) & 255u) * __builtin_amdgcn_rcpf((float)((n2.x >> (8 * j)) & 255u));
                        acc[ai][bj][m][1][j] *= (float)((c2.y >> (8 * j)) & 255u) * __builtin_amdgcn_rcpf((float)((n2.y >> (8 * j)) & 255u)); } }
    }
    DI void operator()(EPI_ARGS) const {
        const int row0 = u.pm * 256 + wr * 64 + fr, col0 = u.pn * 256 + wc * 32 + 8 * fq;
#pragma unroll
        for (int ai = 0; ai < 2; ++ai) {
            u32x2 g[4][2];
#pragma unroll
            for (int m = 0; m < 4; ++m)
#pragma unroll
                for (int bj = 0; bj < 2; ++bj) g[m][bj] = *(const u32x2*)(G + (size_t)(row0 + ai * 128 + m * 16) * 4096 + 3 * 1024 + col0 + bj * 128);
#pragma unroll
            for (int m = 0; m < 4; ++m) { bf16_t* yp = Z + (size_t)(row0 + ai * 128 + m * 16) * NZ + ZY + col0;
#pragma unroll
                for (int bj = 0; bj < 2; ++bj) { const f32x4 v0 = acc[ai][bj][m][0], v1 = acc[ai][bj][m][1]; const u32x2 gg = g[m][bj]; const float k = 1.f / 255.f;
                    u32x4 w; w.x = pk2((float)(gg.x & 255u) * k * v0[0], (float)((gg.x >> 8) & 255u) * k * v0[1]); w.y = pk2((float)((gg.x >> 16) & 255u) * k * v0[2], (float)(gg.x >> 24) * k * v0[3]);
                    w.z = pk2((float)(gg.y & 255u) * k * v1[0], (float)((gg.y >> 8) & 255u) * k * v1[1]); w.w = pk2((float)((gg.y >> 16) & 255u) * k * v1[2], (float)(gg.y >> 24) * k * v1[3]);
                    *(u32x4*)(yp + bj * 128) = w; } }
        }
    } };
struct EpiOut { static constexpr bool PERM = false; const float* res_l; const float* res_c; float* xs_l; float* xs_c; const float* modv_l;
    DI void operator()(EPI_ARGS) const {
        const int row0 = u.pm * 256 + wr * 64 + fr, col0 = u.pn * 256 + wc * 32 + 4 * fq;
        const bool lat = u.pm < ML / 256; const int bsel = lat ? (u.pm >> 4) : 8;
        const float* gp = modv_l + (bsel * 6 + 2) * 1024 + col0;
        f32x4 gt[2][2];
#pragma unroll
        for (int bj = 0; bj < 2; ++bj)
#pragma unroll
            for (int n = 0; n < 2; ++n) gt[bj][n] = *(const f32x4*)(gp + bj * 128 + n * 16);
#pragma unroll
        for (int ai = 0; ai < 2; ++ai) {
            f32x4 rs[4][2][2];
#pragma unroll
            for (int m = 0; m < 4; ++m) { const int row = row0 + ai * 128 + m * 16; const size_t ro = lat ? (size_t)row * 1024 : (size_t)(row - ML) * 1024;
                const float* rp = (lat ? res_l : res_c) + ro + col0;
#pragma unroll
                for (int bj = 0; bj < 2; ++bj)
#pragma unroll
                    for (int n = 0; n < 2; ++n) rs[m][bj][n] = *(const f32x4*)(rp + bj * 128 + n * 16); }
#pragma unroll
            for (int m = 0; m < 4; ++m) { const int row = row0 + ai * 128 + m * 16; const size_t ro = lat ? (size_t)row * 1024 : (size_t)(row - ML) * 1024;
                float* xp = (lat ? xs_l : xs_c) + ro + col0;
#pragma unroll
                for (int bj = 0; bj < 2; ++bj)
#pragma unroll
                    for (int n = 0; n < 2; ++n) *(f32x4*)(xp + bj * 128 + n * 16) = rs[m][bj][n] + gt[bj][n] * acc[ai][bj][m][n]; }
        }
    } };
struct EpiMoeUp { static constexpr bool PERM = true; bf16_t* H; const LAS unsigned* off; const unsigned* cnt;
    DI void operator()(EPI_ARGS) const {
        const int j0 = (u.pm - (int)(off[u.aux] >> 8)) * 256 + wr * 64 + fr, h0 = (u.pn * 256 + wc * 32 + 8 * fq) >> 1; const int n = (int)cnt[u.aux];
        bf16_t* hb = H + (size_t)(u.pm * 256 + wr * 64 + fr) * 256 + h0;
#pragma unroll
        for (int ai = 0; ai < 2; ++ai)
#pragma unroll
            for (int m = 0; m < 4; ++m) if (j0 + ai * 128 + m * 16 < n) { bf16_t* hp = hb + (size_t)(ai * 128 + m * 16) * 256;
#pragma unroll
                for (int bj = 0; bj < 2; ++bj) { const f32x4 g = acc[ai][bj][m][0], up = acc[ai][bj][m][1];
                    u32x2 w; w.x = pk2(g[0] * sigmoidf_(g[0]) * up[0], g[1] * sigmoidf_(g[1]) * up[1]); w.y = pk2(g[2] * sigmoidf_(g[2]) * up[2], g[3] * sigmoidf_(g[3]) * up[3]);
                    *(u32x2*)(hp + bj * 64) = w; } }
    } };
struct EpiMoeDown { static constexpr bool PERM = true; bf16_t* Y; const LAS unsigned* off; const int* list; const unsigned* cnt; const float* listw;
    DI void operator()(EPI_ARGS) const {
        const int j0 = (u.pm - (int)(off[u.aux] >> 8)) * 256 + wr * 64 + fr, col0 = u.pn * 256 + wc * 32 + 8 * fq; const int n = (int)cnt[u.aux]; const int* lp = list + (size_t)u.aux * MOE_CAP; const float* lp_w = listw + (size_t)u.aux * MOE_CAP;
        int it[2][4]; float wt8[2][4];
#pragma unroll
        for (int ai = 0; ai < 2; ++ai)
#pragma unroll
            for (int m = 0; m < 4; ++m) { const int pos = j0 + ai * 128 + m * 16; it[ai][m] = pos < n ? lp[pos] : -1; wt8[ai][m] = pos < n ? lp_w[pos] : 0.f; }
#pragma unroll
        for (int ai = 0; ai < 2; ++ai)
#pragma unroll
            for (int m = 0; m < 4; ++m) if (it[ai][m] >= 0) { const int ri = it[ai][m]; const float w8 = wt8[ai][m]; bf16_t* yp = Y + ((size_t)(ri & 1) * MT + (ri >> 1)) * 1024 + col0;
#pragma unroll
                for (int bj = 0; bj < 2; ++bj) { const f32x4 v0 = acc[ai][bj][m][0] * w8, v1 = acc[ai][bj][m][1] * w8;
                    u32x4 w; w.x = pk2(v0[0], v0[1]); w.y = pk2(v0[2], v0[3]); w.z = pk2(v1[0], v1[1]); w.w = pk2(v1[2], v1[3]);
                    *(u32x4*)(yp + bj * 128) = w; } }
    } };
}

DI void phase_pre(const Params& p, ldsp lds) {
    float* modv = (float*)(p.ws + WS_MODV);
    LAS float* sc = (LAS float*)lds;
    LAS float* red = (LAS float*)(lds + 9 * 1024 * 4);
    const int tid = tid_now();
    for (int i = tid; i < 9 * 1024; i += 512) { const int r = i >> 10, k = i & 1023; const float v = r < 8 ? p.in[1][r * 1024 + k] : p.in[3][k]; sc[i] = v / (1.f + __expf(-v)); }
    __syncthreads();
    const int kg = tid >> 6, col = tid & 63;
    for (int u = bid_now(); u < 192; u += gdim_now()) {
        const int li = u / 96, j = (u % 96) * 64 + col;
        const float* w = p.in[4] + (size_t)li * 1024 * 6144 + j;
        float acc[9];
#pragma unroll
        for (int r = 0; r < 9; ++r) acc[r] = 0.f;
        for (int k = kg * 128; k < kg * 128 + 128; ++k) { const float wv = w[(size_t)k * 6144];
#pragma unroll
            for (int r = 0; r < 9; ++r) acc[r] += sc[r * 1024 + k] * wv; }
#pragma unroll
        for (int r = 0; r < 9; ++r) red[(kg * 9 + r) * 64 + col] = acc[r];
        __syncthreads();
        if (tid < 64) {
#pragma unroll
            for (int r = 0; r < 9; ++r) { float s = 0.f;
#pragma unroll
                for (int g = 0; g < 8; ++g) s += red[(g * 9 + r) * 64 + col];
                modv[(li * 9 + r) * 6144 + j] = s + p.in[5][li * 6144 + j]; } }
        __syncthreads();
    }
    if (bid_now() == gdim_now() - 1) {
        f32x2* cs16 = (f32x2*)(p.ws + WS_ROPE16); f32x2* cs8 = (f32x2*)(p.ws + WS_ROPE8);
        for (int i = tid; i < 64 * 16 + 64 * 8; i += 512) {
            const bool a = i < 1024; const int ii = a ? i : i - 1024; const int pos = a ? ii >> 4 : ii >> 3, f = a ? ii & 15 : ii & 7;
            const float inv = exp2f(-(float)f * (13.287712379549449f / (a ? 16.f : 8.f)));
            const float x = (float)pos * inv; const float n = rintf(x * 0.15915494309189535f);
            float r = fmaf(-n, 6.2831855f, x); r = fmaf(-n, -1.7484555e-7f, r);
            const f32x2 cs = {__cosf(r), __sinf(r)};
            if (a) cs16[ii] = cs; else cs8[ii] = cs;
        }
        if (tid == 64) { const float** tab = (const float**)(p.ws + WS_TAB);
#pragma unroll
            for (int i = 0; i < 29; ++i) tab[i] = p.in[i]; }
        if (tid < 2) { const float* lp = p.in[19] + tid * 128; float s1 = 0.f, s2 = 0.f;
            for (int i = 0; i < 32; ++i) { s1 += lp[i] * lp[32 + i]; s2 += lp[64 + i] * lp[96 + i]; }
            const float lam_init = 0.8f - 0.6f * expf(-0.3f * (float)tid);
            float* lamv = (float*)(p.ws + WS_LAM); lamv[tid * 2] = expf(s1) - expf(s2) + lam_init; lamv[tid * 2 + 1] = lam_init; }
    }
}

template <class DM> DI void conv_tiles(ldsp lds, const float* W0, const int ldw, const int Kd, const int Ncols, bf16_t* Wt0, const int ldt, const int koff, DM dmap, const int nb = 1, const size_t wstride = 0, const size_t tstride = 0) {
    const int tid = tid_now(); LAS bf16_t* T = (LAS bf16_t*)lds;
    const int ntn = (Ncols + 63) >> 6, ntk = Kd >> 6;
    for (int tt = bid_now(); tt < nb * ntn * ntk; tt += gdim_now()) {
        const int bi = tt / (ntn * ntk), t = tt - bi * (ntn * ntk); const float* W = W0 + (size_t)bi * wstride; bf16_t* Wt = Wt0 + (size_t)bi * tstride;
        const int n0 = (t % ntn) * 64, k0 = (t / ntn) * 64;
        { const int kk = tid >> 3, nn = (tid & 7) * 8; float v[8];
          if (n0 + nn + 8 <= Ncols) { const f32x4 a = *(const f32x4*)(W + (size_t)(k0 + kk) * ldw + n0 + nn), c = *(const f32x4*)(W + (size_t)(k0 + kk) * ldw + n0 + nn + 4);
              v[0] = a[0]; v[1] = a[1]; v[2] = a[2]; v[3] = a[3]; v[4] = c[0]; v[5] = c[1]; v[6] = c[2]; v[7] = c[3]; }
          else {
#pragma unroll
              for (int j = 0; j < 8; ++j) v[j] = 0.f; }
#pragma unroll
          for (int j = 0; j < 8; ++j) T[(nn + j) * 72 + kk] = f2bf(v[j]); }
        __syncthreads();
        { const int n = tid >> 3, k8 = (tid & 7) * 8;
          if (n0 + n < Ncols) { const u32x4 w = *(const LAS u32x4*)(T + n * 72 + k8); *(u32x4*)(Wt + (size_t)dmap(n0 + n) * ldt + koff + k0 + k8) = w; } }
        __syncthreads();
    }
}
DI void zero_rows(bf16_t* Wt, const int ldt, const int r0, const int nr, const int c0, const int nc) {
    const int per = nc >> 3;
    unsigned z = 0u; asm volatile("" : "+v"(z));
    const u32x4 zz = {z, z, z, z};
    for (int i = bid_now() * 512 + tid_now(); i < nr * per; i += gdim_now() * 512) { const int r = i / per, c8 = (i - r * per) * 8; *(u32x4*)(Wt + (size_t)(r0 + r) * ldt + c0 + c8) = zz; }
}
DI void phase_wconv(const Ctx& p, const int li, ldsp lds) {
    unsigned char* wt = p.ws + WS_WT; auto id = [](int n) { return n; };
    conv_tiles(lds, p.in[8] + (size_t)li * 1024 * 2976, 2976, 1024, 2976, (bf16_t*)(wt + WT_IN), 1024, 0, id);
    zero_rows((bf16_t*)(wt + WT_IN), 1024, 2976, NZ - 2976, 0, 1024);
    conv_tiles(lds, p.in[9] + (size_t)li * 1024 * 4096, 4096, 1024, 4096, (bf16_t*)(wt + WT_G), 1024, 0, id);
    conv_tiles(lds, p.in[10] + (size_t)li * 4 * 256 * 1024, 1024, 256, 1024, (bf16_t*)(wt + WT_B), 256, 0, id, 4, (size_t)256 * 1024, (size_t)1024 * 256);
    conv_tiles(lds, p.in[11] + (size_t)li * 1024 * 1024, 1024, 1024, 1024, (bf16_t*)(wt + WT_O), 1024, 0, id);
    conv_tiles(lds, p.in[17] + (size_t)li * 256 * 384, 384, 256, 384, (bf16_t*)(wt + WT_MLA), 384, 0, id);
    conv_tiles(lds, p.in[18] + (size_t)li * 128 * 512, 512, 128, 512, (bf16_t*)(wt + WT_MLA), 384, 256, [](int n) { return 384 + n; });
    zero_rows((bf16_t*)(wt + WT_MLA), 384, 0, 384, 256, 128); zero_rows((bf16_t*)(wt + WT_MLA), 384, 384, 512, 0, 256); zero_rows((bf16_t*)(wt + WT_MLA), 384, 896, 128, 0, 384);
    conv_tiles(lds, p.in[25] + (size_t)li * 32 * 1024 * 256, 256, 1024, 256, (bf16_t*)(wt + WT_E1), 1024, 0, [](int hc) { return (hc >> 2) * 8 + (hc & 3); }, 32, (size_t)1024 * 256, (size_t)512 * 1024);
    conv_tiles(lds, p.in[26] + (size_t)li * 32 * 1024 * 256, 256, 1024, 256, (bf16_t*)(wt + WT_E1), 1024, 0, [](int hc) { return (hc >> 2) * 8 + 4 + (hc & 3); }, 32, (size_t)1024 * 256, (size_t)512 * 1024);
    conv_tiles(lds, p.in[27] + (size_t)li * 32 * 256 * 1024, 1024, 256, 1024, (bf16_t*)(wt + WT_E2), 256, 0, id, 32, (size_t)256 * 1024, (size_t)1024 * 256);
}

template <int MODE> DI void phase_norm(const Ctx& p, const int li) {
    const int lane = tid_now() & 63, wave = tid_now() >> 6;
    const int nrows = MODE == 2 ? ML : MT;
    const float* modv = (const float*)(p.ws + WS_MODV);
    float* ctxs = (float*)(p.ws + WS_CTXS); bf16_t* HB = (bf16_t*)(p.ws + WS_HB); const bf16_t* Y = (const bf16_t*)(p.ws + WS_Y);
    const bool combine = (MODE == 2) || (li > 0);
    const int lprev = MODE == 2 ? 1 : li - 1;
    const float* gain = MODE == 2 ? p.in[28] : p.in[6] + li * 1024;
    for (int row = bid_now() * 8 + wave; row < nrows; row += gdim_now() * 8) {
        const bool lat = row < ML; const int bsel = lat ? (row >> 12) : 8;
        float* xs = lat ? p.out + (size_t)row * 1024 : ctxs + (size_t)(row - ML) * 1024;
        const float* src = combine ? xs : (lat ? p.in[0] + (size_t)row * 1024 : p.in[2] + (size_t)(row - ML) * 1024);
        f32x4 v[4];
#pragma unroll
        for (int i = 0; i < 4; ++i) v[i] = *(const f32x4*)(src + i * 256 + lane * 4);
        if (combine) {
            const float* g2 = modv + ((lprev * 9 + bsel) * 6 + 5) * 1024;
#pragma unroll
            for (int i = 0; i < 4; ++i) { const int col = i * 256 + lane * 4;
                const u32x2 y0 = *(const u32x2*)(Y + (size_t)row * 1024 + col), y1 = *(const u32x2*)(Y + ((size_t)MT + row) * 1024 + col);
                const f32x4 g = *(const f32x4*)(g2 + col);
                v[i][0] += g[0] * (bflo(y0.x) + bflo(y1.x)); v[i][1] += g[1] * (bfhi(y0.x) + bfhi(y1.x));
                v[i][2] += g[2] * (bflo(y0.y) + bflo(y1.y)); v[i][3] += g[3] * (bfhi(y0.y) + bfhi(y1.y));
                if (MODE == 0) *(f32x4*)(xs + col) = v[i]; }
        }
        float ss = 0.f;
#pragma unroll
        for (int i = 0; i < 4; ++i) ss += v[i][0] * v[i][0] + v[i][1] * v[i][1] + v[i][2] * v[i][2] + v[i][3] * v[i][3];
        ss = wave_sum(ss);
        const float rstd = rsqrtf(ss * (1.f / 1024.f) + NORM_EPS);
        if (MODE == 2) {
#pragma unroll
            for (int i = 0; i < 4; ++i) { const int col = i * 256 + lane * 4; const f32x4 g = *(const f32x4*)(gain + col); f32x4 o = v[i] * rstd * g;
#ifdef STAMP_A
                { const float* tv = (const float*)(p.ws + WS_LAM + 64); if (row == 0 && col == 0) o[0] += tv[1] * 0.05f; }
#endif
                *(f32x4*)(xs + col) = o; }
        } else {
            const float* sh = modv + ((li * 9 + bsel) * 6 + 0) * 1024; const float* scl = modv + ((li * 9 + bsel) * 6 + 1) * 1024;
#pragma unroll
            for (int i = 0; i < 4; ++i) { const int col = i * 256 + lane * 4; const f32x4 g = *(const f32x4*)(gain + col), s1 = *(const f32x4*)(scl + col), s0 = *(const f32x4*)(sh + col);
                const f32x4 h = v[i] * rstd * g * (s1 + 1.f) + s0;
                u32x2 w; w.x = pk2(h[0], h[1]); w.y = pk2(h[2], h[3]); *(u32x2*)(HB + (size_t)row * 1024 + col) = w; }
        }
    }
}

DI void phase_norm2(const Ctx& p, const int li, ldsp lds, const int dry = 0) {
    const int tid = tid_now(), lane = tid & 63, wave = tid >> 6;
    const int nrows = li == 0 ? MT : ML;
    const float* modv = (const float*)(p.ws + WS_MODV);
    const float* ctxs = (const float*)(p.ws + WS_CTXS); bf16_t* HB = (bf16_t*)(p.ws + WS_HB);
    unsigned* cnt = (unsigned*)(p.ws + WS_CTL + CTL_CNT) + li * 32;
    int* list = (int*)(p.ws + WS_XG); float* listw = (float*)(p.ws + WS_XG) + (size_t)32 * MOE_CAP;
    constexpr int RWS = 1028;
    LAS float* rw = (LAS float*)lds;
    const float* wrg = p.in[21] + (size_t)li * 1024 * 4; const float* wre = p.in[23] + (size_t)li * 1024 * 32;
    for (int i = tid; i < 4 * 1024; i += 512) rw[(i & 3) * RWS + (i >> 2)] = wrg[i];
    for (int i = tid; i < 32 * 1024; i += 512) rw[(4 + (i & 31)) * RWS + (i >> 5)] = wre[i];
    LAS unsigned* lcnt = (LAS unsigned*)(lds + 148480); LAS unsigned* lbase = lcnt + 32; LAS int* rec = (LAS int*)(lcnt + 64);
    if (tid < 32) lcnt[tid] = 0u;
    __syncthreads();
    const float* gain = p.in[7] + li * 1024;
    LAS float* bias = (LAS float*)(rec + 144 * 8);
    if (tid < 4) bias[tid] = p.in[22][li * 4 + tid]; else if (tid < 36) bias[tid] = p.in[24][li * 32 + tid - 4];
    __syncthreads();
    const int rpw = (nrows + gdim_now() * 8 - 1) / (gdim_now() * 8), r0w = (bid_now() * 8 + wave) * rpw, r1w = r0w + rpw < nrows ? r0w + rpw : nrows;
    int cur_b = -1; f32x4 gs[4], s0v[4];
#pragma unroll
    for (int i = 0; i < 4; ++i) { gs[i] = (f32x4){0.f, 0.f, 0.f, 0.f}; s0v[i] = gs[i]; }
    for (int row = r0w; row < r1w; ++row) {
        const bool lat = row < ML; const int bsel = lat ? (row >> 12) : 8;
        const float* xs = lat ? p.out + (size_t)row * 1024 : ctxs + (size_t)(row - ML) * 1024;
        f32x4 v[4];
#pragma unroll
        for (int i = 0; i < 4; ++i) v[i] = *(const f32x4*)(xs + i * 256 + lane * 4);
        if (bsel != cur_b) { cur_b = bsel; const float* sh = modv + ((li * 9 + bsel) * 6 + 3) * 1024; const float* scl = modv + ((li * 9 + bsel) * 6 + 4) * 1024;
#pragma unroll
            for (int i = 0; i < 4; ++i) { const int col = i * 256 + lane * 4; gs[i] = *(const f32x4*)(gain + col) * (*(const f32x4*)(scl + col) + 1.f); s0v[i] = *(const f32x4*)(sh + col); } }
        float ss = 0.f;
#pragma unroll
        for (int i = 0; i < 4; ++i) ss += v[i][0] * v[i][0] + v[i][1] * v[i][1] + v[i][2] * v[i][2] + v[i][3] * v[i][3];
        ss = wave_sum(ss);
        const float rstd = rsqrtf(ss * (1.f / 1024.f) + NORM_EPS);
#pragma unroll
        for (int i = 0; i < 4; ++i) { const int col = i * 256 + lane * 4;
            v[i] = v[i] * rstd * gs[i] + s0v[i];
            u32x2 w; w.x = pk2(v[i][0], v[i][1]); w.y = pk2(v[i][2], v[i][3]); *(u32x2*)(HB + (size_t)row * 1024 + col) = w; }
        float lg[4];
#pragma unroll
        for (int e = 0; e < 4; ++e) { float s = 0.f;
#pragma unroll
            for (int i = 0; i < 4; ++i) { const f32x4 w = *(const LAS f32x4*)(rw + e * RWS + i * 256 + lane * 4); s += v[i][0] * w[0] + v[i][1] * w[1] + v[i][2] * w[2] + v[i][3] * w[3]; }
            lg[e] = wave_sum(s) + bias[e]; }
        int gi = 0; float gm = lg[0];
#pragma unroll
        for (int g = 1; g < 4; ++g) { if (lg[g] > gm) { gm = lg[g]; gi = g; } }
        gi = __builtin_amdgcn_readfirstlane(gi);
        float gden = 0.f;
#pragma unroll
        for (int g = 0; g < 4; ++g) gden += __expf(lg[g] - gm);
        const float gval = 1.f / gden;
        float el[8];
#pragma unroll
        for (int j = 0; j < 8; ++j) { float s = 0.f; const LAS float* wp = rw + (4 + gi * 8 + j) * RWS + lane * 4;
#pragma unroll
            for (int i = 0; i < 4; ++i) { const f32x4 w = *(const LAS f32x4*)(wp + i * 256); s += v[i][0] * w[0] + v[i][1] * w[1] + v[i][2] * w[2] + v[i][3] * w[3]; }
            el[j] = wave_sum(s) + bias[4 + gi * 8 + j]; }
        int i1 = 0; float m1 = el[0];
#pragma unroll
        for (int j = 1; j < 8; ++j) if (el[j] > m1) { m1 = el[j]; i1 = j; }
        int i2 = -1; float m2 = -3.0e38f;
#pragma unroll
        for (int j = 0; j < 8; ++j) if (j != i1 && el[j] > m2) { m2 = el[j]; i2 = j; }
        const float t = __expf(m2 - m1); const float w1 = gval / (1.f + t), w2 = gval * t / (1.f + t);
        if (dry && w1 + w2 == 123.f) HB[0] = 0;
        if (lane == 0 && !dry) {
            const int e1 = gi * 8 + i1, e2 = gi * 8 + i2; const int lr = wave * 18 + (row - r0w);
            const unsigned p1 = __hip_atomic_fetch_add(lcnt + e1, 1u, __ATOMIC_RELAXED, __HIP_MEMORY_SCOPE_WORKGROUP), p2 = __hip_atomic_fetch_add(lcnt + e2, 1u, __ATOMIC_RELAXED, __HIP_MEMORY_SCOPE_WORKGROUP);
            rec[lr * 8 + 0] = e1; rec[lr * 8 + 1] = (int)p1; rec[lr * 8 + 2] = __float_as_int(w1); rec[lr * 8 + 3] = e2; rec[lr * 8 + 4] = (int)p2; rec[lr * 8 + 5] = __float_as_int(w2);
        }
    }
    __syncthreads();
    if (tid < 32 && !dry) { const unsigned n = lcnt[tid]; lbase[tid] = n ? atomicAdd(&cnt[tid], n) : 0u; }
    __syncthreads();
    if (!dry) for (int lr = tid; lr < 144; lr += 512) { const int wv = lr / 18, k = lr - wv * 18; const int row = (bid_now() * 8 + wv) * rpw + k;
        if (k < rpw && row < nrows) { const int e1 = rec[lr * 8 + 0], e2 = rec[lr * 8 + 3];
            { const size_t q1 = (size_t)e1 * MOE_CAP + lbase[e1] + rec[lr * 8 + 1], q2 = (size_t)e2 * MOE_CAP + lbase[e2] + rec[lr * 8 + 4];
              list[q1] = row * 2;     listw[q1] = __int_as_float(rec[lr * 8 + 2]);
              list[q2] = row * 2 + 1; listw[q2] = __int_as_float(rec[lr * 8 + 5]); } } }
    __syncthreads();
}

DI int moe_offsets(const unsigned* cnt, LAS unsigned* off, LAS unsigned char* pe) {
    if (tid_now() == 0) { unsigned o = 0;
#pragma unroll 1
        for (int e = 0; e < 32; ++e) { const unsigned c = __hip_atomic_load(cnt + e, __ATOMIC_RELAXED, __HIP_MEMORY_SCOPE_AGENT); const unsigned np = (c + 255u) >> 8; off[e] = o;
#pragma unroll 1
            for (unsigned q = 0; q < np; ++q) pe[(o >> 8) + q] = (unsigned char)e;
            o += np << 8; } off[32] = o; }
    __syncthreads();
    return (int)(off[32] >> 8);
}
template <int N> DI float dpp_row_shr(float x) { return __builtin_bit_cast(float, __builtin_amdgcn_update_dpp(0, __builtin_bit_cast(int, x), 0x110 + N, 0xf, 0xf, true)); }
DI float row_scan16(float x) { x += dpp_row_shr<1>(x); x += dpp_row_shr<2>(x); x += dpp_row_shr<4>(x); x += dpp_row_shr<8>(x); return x; }
DI bf16x8 pack8(const float* v) { u32x4 w; w.x = pk2(v[0], v[1]); w.y = pk2(v[2], v[3]); w.z = pk2(v[4], v[5]); w.w = pk2(v[6], v[7]); return __builtin_bit_cast(bf16x8, w); }
DI void unpack8(const u32x4 w, float* v) { v[0] = bflo(w.x); v[1] = bfhi(w.x); v[2] = bflo(w.y); v[3] = bfhi(w.y); v[4] = bflo(w.z); v[5] = bfhi(w.z); v[6] = bflo(w.w); v[7] = bfhi(w.w); }
#define MFMA16(a, b, c) __builtin_amdgcn_mfma_f32_16x16x32_bf16((a), (b), (c), 0, 0, 0)
constexpr int HG_RS = 136;
constexpr int HG_TILE = 64 * HG_RS;
DI void hgrn_gate_block(const bf16_t* zf  , const float* lb, float* logf, float* kf) {
    float x[16]; unpack8(*(const u32x4*)zf, x); unpack8(*(const u32x4*)(zf + 32), x + 8);
#pragma unroll
    for (int i = 0; i < 16; ++i) { const float sf = sigmoidf_(x[i]); logf[i] = __logf(fmaxf(lb[i] + (1.f - lb[i]) * sf, 1e-30f)); kf[i] = (1.f - lb[i]) * (1.f - sf); }
}
DI void hgrn_lb(const float* lbl, const int li, const int dir, const int h, const int g, float* lb) {
#pragma unroll
    for (int i = 0; i < 16; ++i) { const int hd = h * 64 + 32 * (i >> 3) + 8 * g + (i & 7); lb[i] = li > 0 ? sigmoidf_(lbl[(2 + dir) * 256 + hd] - lbl[dir * 256 + hd]) : 0.f; }
}
DI void hgrn_stage_v(const bf16_t* Z, const int row0, const int h, const int dir, const int lane, ldsp VT) {
#pragma unroll
    for (int i = 0; i < 8; ++i) { const int tau = (lane >> 3) + 8 * i, t = dir ? 63 - tau : tau;
        const u32x4 v = *(const u32x4*)(Z + (size_t)(row0 + t) * NZ + ZB_I + h * 64 + (lane & 7) * 8);
        *(LAS u32x2*)(VT + tau * HG_RS + (lane & 7) * 16) = (u32x2){v.x, v.y}; *(LAS u32x2*)(VT + tau * HG_RS + (lane & 7) * 16 + 8) = (u32x2){v.z, v.w}; }
}
DI bf16x8 hgrn_tr_frag(ldsp T, const int col, const int r0, const int r1) {
    const LAS bf16_t* p0 = (const LAS bf16_t*)(T + r0 * HG_RS) + col; const LAS bf16_t* p1 = (const LAS bf16_t*)(T + r1 * HG_RS) + col;
    u32x4 w;
    w.x = (unsigned)p0[0] | ((unsigned)p0[HG_RS / 2] << 16); w.y = (unsigned)p0[HG_RS] | ((unsigned)p0[3 * HG_RS / 2] << 16);
    w.z = (unsigned)p1[0] | ((unsigned)p1[HG_RS / 2] << 16); w.w = (unsigned)p1[HG_RS] | ((unsigned)p1[3 * HG_RS / 2] << 16);
    return __builtin_bit_cast(bf16x8, w);
}

DI void hgrn1_unit(const Ctx& p, const int li, const int cidx, ldsp lds) {
    const int tid = tid_now(), lane = tid & 63, w = __builtin_amdgcn_readfirstlane(tid >> 6), h = w >> 1, dir = w & 1, tl = lane & 15, g = lane >> 4;
    const bf16_t* Z = (const bf16_t*)(p.ws + WS_Z); bf16_t* U = (bf16_t*)(p.ws + WS_X + X_U); float* HE = (float*)(p.ws + WS_HE);
    const int row0 = chunk_row0(cidx);
    ldsp VT = lds + w * HG_TILE; ldsp KT = lds + 8 * HG_TILE + w * HG_TILE;
    hgrn_stage_v(Z, row0, h, dir, lane, VT);
    float lb[16]; hgrn_lb(p.in[13], li, dir, h, g, lb);
    const int fcol = (dir ? ZB_FB : ZB_FF) + h * 64 + 8 * g;
    float tot[4][16];
#pragma unroll
    for (int I = 0; I < 4; ++I) { const int tau = 16 * I + tl, t = dir ? 63 - tau : tau; float logf[16], kf[16];
        hgrn_gate_block(Z + (size_t)(row0 + t) * NZ + fcol, lb, logf, kf);
#pragma unroll
        for (int i = 0; i < 16; ++i) { const float a = row_scan16(logf[i]); tot[I][i] = __shfl(a, (lane & 48) | 15); } }
#pragma unroll
    for (int I = 0; I < 4; ++I) { const int tau = 16 * I + tl, t = dir ? 63 - tau : tau; float logf[16], kf[16], kd[16];
        hgrn_gate_block(Z + (size_t)(row0 + t) * NZ + fcol, lb, logf, kf);
#pragma unroll
        for (int i = 0; i < 16; ++i) { const float a = row_scan16(logf[i]); float rest = tot[I][i] - a;
#pragma unroll
            for (int M = I + 1; M < 4; ++M) rest += tot[M][i];
            kd[i] = kf[i] * __expf(rest); }
        { const u32x4 k0 = __builtin_bit_cast(u32x4, pack8(kd)), k1 = __builtin_bit_cast(u32x4, pack8(kd + 8));
          LAS u32x2* d0 = (LAS u32x2*)(KT + tau * HG_RS + (8 * g) * 2); LAS u32x2* d1 = (LAS u32x2*)(KT + tau * HG_RS + (32 + 8 * g) * 2);
          d0[0] = (u32x2){k0.x, k0.y}; d0[1] = (u32x2){k0.z, k0.w}; d1[0] = (u32x2){k1.x, k1.y}; d1[1] = (u32x2){k1.z, k1.w}; } }
    if (tl == 0) {
#pragma unroll
        for (int i = 0; i < 16; ++i) HE[((size_t)(cidx * 4 + h) * 2 + dir) * 64 + 32 * (i >> 3) + 8 * g + (i & 7)] = __expf(tot[0][i] + tot[1][i] + tot[2][i] + tot[3][i]); }
    asm volatile("s_waitcnt lgkmcnt(0)" ::: "memory"); __builtin_amdgcn_wave_barrier();
    bf16x8 va[4][2];
#pragma unroll
    for (int E = 0; E < 4; ++E)
#pragma unroll
        for (int st = 0; st < 2; ++st) va[E][st] = hgrn_tr_frag(VT, 16 * E + tl, 32 * st + 8 * g, 32 * st + 8 * g + 4);
    bf16_t* up = U + ((size_t)(cidx * 4 + h) * 2 + dir) * 4096;
#pragma unroll
    for (int Dt = 0; Dt < 4; ++Dt) {
        const bf16x8 kb0 = hgrn_tr_frag(KT, 16 * Dt + tl, 8 * g, 8 * g + 4), kb1 = hgrn_tr_frag(KT, 16 * Dt + tl, 32 + 8 * g, 32 + 8 * g + 4);
#pragma unroll
        for (int E = 0; E < 4; ++E) { f32x4 acc = {0.f, 0.f, 0.f, 0.f}; acc = MFMA16(va[E][0], kb0, acc); acc = MFMA16(va[E][1], kb1, acc);
#pragma unroll
            for (int r = 0; r < 4; ++r) up[(16 * E + 4 * g + r) * 64 + 16 * Dt + tl] = f2bf(acc[r]); }
    }
}

DI void hgrn3_unit(const Ctx& p, const int li, const int cidx, ldsp lds, const int dry = 0) {
    const int tid = tid_now(), lane = tid & 63, w = __builtin_amdgcn_readfirstlane(tid >> 6), h = w >> 1, dir = w & 1, tl = lane & 15, g = lane >> 4;
    bf16_t* Z = (bf16_t*)(p.ws + WS_Z); const bf16_t* U = (const bf16_t*)(p.ws + WS_X + X_U);
    const int row0 = chunk_row0(cidx);
    ldsp VT = lds + w * HG_TILE; ldsp OX = lds + 8 * HG_TILE;
    hgrn_stage_v(Z, row0, h, dir, lane, VT);
    float lb[16]; hgrn_lb(p.in[13], li, dir, h, g, lb);
    const int fcol = (dir ? ZB_FB : ZB_FF) + h * 64 + 8 * g;
    const bf16_t* sp = U + ((size_t)(cidx * 4 + h) * 2 + dir) * 4096;
    float crun[16], tot1[16], tot2[16];
#pragma unroll
    for (int i = 0; i < 16; ++i) { crun[i] = 0.f; tot1[i] = 0.f; tot2[i] = 0.f; }
    bf16x8 kend[3][2];
    asm volatile("s_waitcnt lgkmcnt(0)" ::: "memory"); __builtin_amdgcn_wave_barrier();
#pragma unroll
    for (int I = 0; I < 4; ++I) {
        const int tau = 16 * I + tl, t = dir ? 63 - tau : tau;
        const bf16_t* zr = Z + (size_t)(row0 + t) * NZ;
        float logf[16], kf[16], qv[16], al[16], tot[16], tmp[16];
        hgrn_gate_block(zr + fcol, lb, logf, kf);
        unpack8(*(const u32x4*)(zr + ZB_Q + h * 64 + 8 * g), qv); unpack8(*(const u32x4*)(zr + ZB_Q + h * 64 + 32 + 8 * g), qv + 8);
#pragma unroll
        for (int i = 0; i < 16; ++i) { al[i] = row_scan16(logf[i]); tot[i] = __shfl(al[i], (lane & 48) | 15); }
        f32x4 wt[4];
#pragma unroll
        for (int i = 0; i < 16; ++i) tmp[i] = kf[i] * __expf(fminf(-al[i], 80.f));
        const bf16x8 kd0 = pack8(tmp), kd1 = pack8(tmp + 8);
#pragma unroll
        for (int i = 0; i < 16; ++i) tmp[i] = qv[i] * __expf(al[i]);
        const bf16x8 qp0 = pack8(tmp), qp1 = pack8(tmp + 8);
        { f32x4 a = {0.f, 0.f, 0.f, 0.f}; a = MFMA16(kd0, qp0, a); a = MFMA16(kd1, qp1, a);
#pragma unroll
          for (int r = 0; r < 4; ++r) a[r] = (4 * g + r <= tl) ? a[r] : 0.f;
          wt[I] = a; }
#pragma unroll
        for (int J = 0; J < I; ++J) {
            bf16x8 q0 = qp0, q1 = qp1;
            if (J < I - 1) {
#pragma unroll
                for (int i = 0; i < 16; ++i) { float dl = (I - 1 - J >= 1) ? ((I - 1 == 1) ? tot1[i] : tot2[i]) : 0.f; if (I - 1 - J == 2) dl += tot1[i]; tmp[i] = qv[i] * __expf(al[i] + dl); }
                q0 = pack8(tmp); q1 = pack8(tmp + 8);
            }
            f32x4 a = {0.f, 0.f, 0.f, 0.f}; a = MFMA16(kend[J][0], q0, a); a = MFMA16(kend[J][1], q1, a); wt[J] = a;
        }
        if (I < 3) {
#pragma unroll
            for (int i = 0; i < 16; ++i) tmp[i] = kf[i] * __expf(tot[i] - al[i]);
            kend[I][0] = pack8(tmp); kend[I][1] = pack8(tmp + 8);
        }
#pragma unroll
        for (int i = 0; i < 16; ++i) tmp[i] = qv[i] * __expf(al[i] + crun[i]);
        const bf16x8 qd0 = pack8(tmp), qd1 = pack8(tmp + 8);
        bf16x8 bw[2];
#pragma unroll
        for (int st = 0; st < 2; ++st) { float v8[8];
#pragma unroll
            for (int r = 0; r < 4; ++r) { v8[r] = (2 * st <= I) ? wt[(2 * st <= I) ? 2 * st : 0][r] : 0.f; v8[4 + r] = (2 * st + 1 <= I) ? wt[(2 * st + 1 <= I) ? 2 * st + 1 : 0][r] : 0.f; }
            bw[st] = pack8(v8); }
        bf16_t* ox = (bf16_t*)nullptr;
#pragma unroll
        for (int E = 0; E < 4; ++E) {
            f32x4 acc = {0.f, 0.f, 0.f, 0.f};
#pragma unroll
            for (int st = 0; st < 2; ++st) if (2 * st <= I) { const bf16x8 va = hgrn_tr_frag(VT, 16 * E + tl, 32 * st + 4 * g, 32 * st + 16 + 4 * g); acc = MFMA16(va, bw[st], acc); }
            const bf16x8 s0 = *(const bf16x8*)(sp + (16 * E + tl) * 64 + 8 * g), s1 = *(const bf16x8*)(sp + (16 * E + tl) * 64 + 32 + 8 * g);
            acc = MFMA16(s0, qd0, acc); acc = MFMA16(s1, qd1, acc);
            u32x2 o2; o2.x = pk2(acc[0], acc[1]); o2.y = pk2(acc[2], acc[3]);
            *(LAS u32x2*)(OX + ((dir * 4 + h) * 64 + t) * HG_RS + (16 * E + 4 * g) * 2) = o2;
        }
        (void)ox;
#pragma unroll
        for (int i = 0; i < 16; ++i) { crun[i] += tot[i]; if (I == 1) tot1[i] = tot[i]; if (I == 2) tot2[i] = tot[i]; }
    }
    __syncthreads();
    { const int t = 32 * dir + (lane >> 1), e0 = (lane & 1) * 32; const float* gn = p.in[14] + li * 64;
      const LAS unsigned char* of = OX + ((0 * 4 + h) * 64 + t) * HG_RS + e0 * 2; const LAS unsigned char* ob = OX + ((1 * 4 + h) * 64 + t) * HG_RS + e0 * 2;
      bf16_t* zr = Z + (size_t)(row0 + t) * NZ + h * 64 + e0;
      float o[32]; float ss = 0.f;
#pragma unroll
      for (int q = 0; q < 4; ++q) { float a8[8], b8[8];
          { const u32x2 x0 = *(const LAS u32x2*)(of + q * 16), x1 = *(const LAS u32x2*)(of + q * 16 + 8), y0 = *(const LAS u32x2*)(ob + q * 16), y1 = *(const LAS u32x2*)(ob + q * 16 + 8);
            unpack8((u32x4){x0.x, x0.y, x1.x, x1.y}, a8); unpack8((u32x4){y0.x, y0.y, y1.x, y1.y}, b8); }
#pragma unroll
          for (int j = 0; j < 8; ++j) { o[q * 8 + j] = a8[j] + b8[j]; ss += o[q * 8 + j] * o[q * 8 + j]; } }
      ss += __shfl_xor(ss, 1);
      const float rstd = rsqrtf(ss * (1.f / 64.f) + NORM_EPS);
#pragma unroll
      for (int q = 0; q < 4; ++q) { float g8[8], r8[8]; unpack8(*(const u32x4*)(zr + ZB_G + q * 8), g8);
#pragma unroll
          for (int j = 0; j < 8; ++j) r8[j] = o[q * 8 + j] * rstd * gn[e0 + q * 8 + j] * g8[j] * sigmoidf_(g8[j]);
          if (!dry) *(bf16x8*)(zr + ZB_Q + q * 8) = pack8(r8); } }
    __syncthreads();
}

DI void phase_prep(const Ctx& p, const int li, ldsp lds) {
    const int tid = tid_now();
    bf16_t* Z = (bf16_t*)(p.ws + WS_Z);
    const f32x2* cs16 = (const f32x2*)(p.ws + WS_ROPE16); const f32x2* cs8 = (const f32x2*)(p.ws + WS_ROPE8);
    bf16_t* KC = (bf16_t*)(p.ws + WS_X + X_KC); bf16_t* AVt = (bf16_t*)(p.ws + WS_X + X_AVT); bf16_t* DVt = (bf16_t*)(p.ws + WS_X + X_DVT);
    bf16_t* U = (bf16_t*)(p.ws + WS_X + X_U); float* HE = (float*)(p.ws + WS_HE);
    const float* qn = p.in[15] + li * 256; const float* kvn = p.in[16] + li * 128; const float* lbl = p.in[13];
    for (int cidx = bid_now(); cidx < NCHUNK; cidx += gdim_now()) {
        const int row0 = chunk_row0(cidx); const bool lat = cidx < 512;
        int b, key0; row_bk(row0, b, key0);
        if (lat) {
            const int prow = key0 >> 6;
            if (tid < 128) { const int t = tid >> 1, blk = 4 + (tid & 1), pcol = (key0 + t) & 63;
                bf16_t* zp = Z + (size_t)(row0 + t) * NZ + ZA_Q + blk * 64; u32x4 w[8]; float x[64];
#pragma unroll
                for (int q = 0; q < 8; ++q) w[q] = *(const u32x4*)(zp + q * 8);
#pragma unroll
                for (int q = 0; q < 8; ++q) unpack8(w[q], x + q * 8);
#pragma unroll
                for (int j = 0; j < 16; ++j) { const f32x2 cr = cs16[prow * 16 + j], cc = cs16[pcol * 16 + j];
                    const float a1 = x[j], a2 = x[16 + j], b1 = x[32 + j], b2 = x[48 + j];
                    x[j] = a1 * cr.x - a2 * cr.y; x[16 + j] = a2 * cr.x + a1 * cr.y; x[32 + j] = b1 * cc.x - b2 * cc.y; x[48 + j] = b2 * cc.x + b1 * cc.y; }
#pragma unroll
                for (int q = 0; q < 8; ++q) *(bf16x8*)(zp + q * 8) = pack8(x + q * 8); }
            { const int t = tid >> 3, blk = 8 + (tid & 7), pcol = (key0 + t) & 63;
                bf16_t* zp = Z + (size_t)(row0 + t) * NZ + ZD_Q + blk * 32; u32x4 w[4]; float x[32];
#pragma unroll
                for (int q = 0; q < 4; ++q) w[q] = *(const u32x4*)(zp + q * 8);
#pragma unroll
                for (int q = 0; q < 4; ++q) unpack8(w[q], x + q * 8);
#pragma unroll
                for (int j = 0; j < 8; ++j) { const f32x2 cr = cs8[prow * 8 + j], cc = cs8[pcol * 8 + j];
                    const float a1 = x[j], a2 = x[8 + j], b1 = x[16 + j], b2 = x[24 + j];
                    x[j] = a1 * cr.x - a2 * cr.y; x[8 + j] = a2 * cr.x + a1 * cr.y; x[16 + j] = b1 * cc.x - b2 * cc.y; x[24 + j] = b2 * cc.x + b1 * cc.y; }
#pragma unroll
                for (int q = 0; q < 4; ++q) *(bf16x8*)(zp + q * 8) = pack8(x + q * 8); }
        }
#ifdef DUP_PREP234
        for (int rep = 0; rep < 2; ++rep) { int dryp = rep == 0; asm volatile("" : "+s"(dryp));
#else
        { const int dryp = 0;
#endif
        { const int t = tid >> 3, s = tid & 7; bf16_t* zr = Z + (size_t)(row0 + t) * NZ;
          float xq[32], xk[16]; float sq = 0.f, sk = 0.f;
#pragma unroll
          for (int j = 0; j < 4; ++j) { const u32x4 w = *(const u32x4*)(zr + ZC_Q + s * 32 + j * 8); const unsigned wu[4] = {w.x, w.y, w.z, w.w};
#pragma unroll
              for (int q = 0; q < 4; ++q) { xq[j * 8 + 2 * q] = bflo(wu[q]); xq[j * 8 + 2 * q + 1] = bfhi(wu[q]); } }
#pragma unroll
          for (int j = 0; j < 2; ++j) { const u32x4 w = *(const u32x4*)(zr + ZC_KV + s * 16 + j * 8); const unsigned wu[4] = {w.x, w.y, w.z, w.w};
#pragma unroll
              for (int q = 0; q < 4; ++q) { xk[j * 8 + 2 * q] = bflo(wu[q]); xk[j * 8 + 2 * q + 1] = bfhi(wu[q]); } }
#pragma unroll
          for (int j = 0; j < 32; ++j) sq += xq[j] * xq[j];
#pragma unroll
          for (int j = 0; j < 16; ++j) sk += xk[j] * xk[j];
          sq += __shfl_xor(sq, 1); sq += __shfl_xor(sq, 2); sq += __shfl_xor(sq, 4); sk += __shfl_xor(sk, 1); sk += __shfl_xor(sk, 2); sk += __shfl_xor(sk, 4);
          const float rq = rsqrtf(sq * (1.f / 256.f) + NORM_EPS), rk = rsqrtf(sk * (1.f / 128.f) + NORM_EPS);
#pragma unroll
          for (int j = 0; j < 4; ++j) { u32x4 w; const float* g = qn + s * 32 + j * 8;
              w.x = pk2(xq[j * 8 + 0] * rq * g[0], xq[j * 8 + 1] * rq * g[1]); w.y = pk2(xq[j * 8 + 2] * rq * g[2], xq[j * 8 + 3] * rq * g[3]);
              w.z = pk2(xq[j * 8 + 4] * rq * g[4], xq[j * 8 + 5] * rq * g[5]); w.w = pk2(xq[j * 8 + 6] * rq * g[6], xq[j * 8 + 7] * rq * g[7]);
              if (!dryp) *(u32x4*)(zr + ZC_Q + s * 32 + j * 8) = w; }
#pragma unroll
          for (int j = 0; j < 2; ++j) { u32x4 w; const float* g = kvn + s * 16 + j * 8;
              w.x = pk2(xk[j * 8 + 0] * rk * g[0], xk[j * 8 + 1] * rk * g[1]); w.y = pk2(xk[j * 8 + 2] * rk * g[2], xk[j * 8 + 3] * rk * g[3]);
              w.z = pk2(xk[j * 8 + 4] * rk * g[4], xk[j * 8 + 5] * rk * g[5]); w.w = pk2(xk[j * 8 + 6] * rk * g[6], xk[j * 8 + 7] * rk * g[7]);
              if (!dryp) *(u32x4*)(zr + ZC_KV + s * 16 + j * 8) = w; } }
        for (int i = tid; i < 64 * 16; i += 512) { const int t = i >> 4, pr = i & 15, half = pr >> 3, j = pr & 7;
            const bf16_t* x = Z + (size_t)(row0 + t) * NZ + ZC_KR + half * 16 + j; float x1 = bf2f(x[0]), x2 = bf2f(x[8]);
            if (lat) { const int pos = half ? ((key0 + t) & 63) : ((key0 + t) >> 6); const f32x2 cs = cs8[pos * 8 + j]; const float a = x1 * cs.x - x2 * cs.y, c = x2 * cs.x + x1 * cs.y; x1 = a; x2 = c; }
            const bf16_t o1 = f2bf(x1), o2 = f2bf(x2);
#pragma unroll
            for (int hh = 0; hh < 4; ++hh) { bf16_t* kp = KC + ((size_t)(b * 4 + hh) * KEYS + key0 + t) * 96 + 64 + half * 16 + j; kp[0] = o1; kp[8] = o2; } }
        __syncthreads();
        }
        hgrn1_unit(p, li, cidx, lds);
#ifdef DUP_H1
        hgrn1_unit(p, li, cidx, lds);
#endif
    }
}

DI void phase_hscan(const Ctx& p, const int dry = 0) {
    unsigned* U = (unsigned*)(p.ws + WS_X + X_U); const float* HE = (const float*)(p.ws + WS_HE);
    for (int g = bid_now() * 512 + tid_now(); g < 64 * 2048; g += gdim_now() * 512) {
        const int chain = g >> 11, pr = g & 2047, d = (pr * 2) & 63; const int b = chain >> 3, h = (chain >> 1) & 3, dir = chain & 1;
        float S0 = 0.f, S1 = 0.f;
#pragma unroll 1
        for (int k0 = 0; k0 < 68; k0 += 17) {
            unsigned u[17]; f32x2 e[17];
#pragma unroll
            for (int q = 0; q < 17; ++q) { const int k = k0 + q; int cidx;
                if (dir == 0) cidx = k < 4 ? 512 + b * 4 + k : b * 64 + (k - 4); else cidx = k < 4 ? 512 + b * 4 + (3 - k) : b * 64 + (67 - k);
                const size_t ch = (size_t)(cidx * 4 + h) * 2 + dir; u[q] = U[ch * 2048 + pr]; e[q] = *(const f32x2*)(HE + ch * 64 + d); }
#pragma unroll
            for (int q = 0; q < 17; ++q) { const int k = k0 + q; int cidx;
                if (dir == 0) cidx = k < 4 ? 512 + b * 4 + k : b * 64 + (k - 4); else cidx = k < 4 ? 512 + b * 4 + (3 - k) : b * 64 + (67 - k);
                const size_t ch = (size_t)(cidx * 4 + h) * 2 + dir; if (!dry) U[ch * 2048 + pr] = pk2(S0, S1); S0 = e[q].x * S0 + bflo(u[q]); S1 = e[q].y * S1 + bfhi(u[q]); }
        }
        if (dry && S0 == 1.2345f) U[0] = 0u;
    }
}

template <int DQK, int NMAP, int MODE>
struct AttnCfg { static constexpr bool VROW = MODE != 0;
    static constexpr int KW = DQK * NMAP, RSK = KW * 2 + 16, RSV = VROW ? 192 : 144, KBYTES = 64 * RSK, VBYTES = 64 * RSV, CPR = KW / 8, NCK = 64 * CPR; };

template <int DQK, int NMAP, int MODE, int ABL = 0, class TileFn>
DI void attn_unit(ldsp lds, const bf16_t* qrow  , const int ntiles, TileFn tile,
                  const float scl2  , const float m_init, const float l_init, const int qpos  ,
                  bf16_t* orow, const float lam, const float post, const float* subln, const int qtok = -1, const f32x2* cs8 = nullptr) {
    typedef AttnCfg<DQK, NMAP, MODE> C;
    const int tid = tid_now(), lane = tid & 63, r = lane & 31, hh = lane >> 5;
    bf16x8 qf[NMAP][DQK / 16];
#pragma unroll
    for (int mp = 0; mp < NMAP; ++mp)
#pragma unroll
        for (int kk = 0; kk < DQK / 16; ++kk) qf[mp][kk] = *(const bf16x8*)(qrow + mp * DQK + kk * 16 + hh * 8);
    auto rope_x = [&](bf16x8& frag, const int pos) {
        const u32x4 w = __builtin_bit_cast(u32x4, frag); const unsigned wu[4] = {w.x, w.y, w.z, w.w}; unsigned ou[4];
#pragma unroll
        for (int q2 = 0; q2 < 4; ++q2) { const unsigned pw = __shfl_xor(wu[q2], 32);
            const f32x2 c0 = cs8[pos * 8 + 2 * q2], c1 = cs8[pos * 8 + 2 * q2 + 1];
            const float a0 = bflo(wu[q2]), a1 = bfhi(wu[q2]), b0 = bflo(pw), b1 = bfhi(pw);
            const float r0 = hh ? a0 * c0.x + b0 * c0.y : a0 * c0.x - b0 * c0.y, r1 = hh ? a1 * c1.x + b1 * c1.y : a1 * c1.x - b1 * c1.y;
            ou[q2] = pk2(r0, r1); }
        const u32x4 o4 = {ou[0], ou[1], ou[2], ou[3]}; frag = __builtin_bit_cast(bf16x8, o4); };
    auto rope_in = [&](bf16x8& fa, bf16x8& fb, const int pos) {
        const u32x4 wa = __builtin_bit_cast(u32x4, fa), wb = __builtin_bit_cast(u32x4, fb); const unsigned ua[4] = {wa.x, wa.y, wa.z, wa.w}, ub[4] = {wb.x, wb.y, wb.z, wb.w}; unsigned oa[4], ob[4];
#pragma unroll
        for (int q2 = 0; q2 < 4; ++q2) { const f32x2 c0 = cs8[pos * 16 + hh * 8 + 2 * q2], c1 = cs8[pos * 16 + hh * 8 + 2 * q2 + 1];
            const float a0 = bflo(ua[q2]), a1 = bfhi(ua[q2]), b0 = bflo(ub[q2]), b1 = bfhi(ub[q2]);
            oa[q2] = pk2(a0 * c0.x - b0 * c0.y, a1 * c1.x - b1 * c1.y); ob[q2] = pk2(b0 * c0.x + a0 * c0.y, b1 * c1.x + a1 * c1.y); }
        fa = __builtin_bit_cast(bf16x8, (u32x4){oa[0], oa[1], oa[2], oa[3]}); fb = __builtin_bit_cast(bf16x8, (u32x4){ob[0], ob[1], ob[2], ob[3]}); };
    if (qtok >= 0) {
        const int prow = qtok >> 6, pcol = qtok & 63;
        if (MODE == 0) { rope_x(qf[0][4], prow); rope_x(qf[0][5], pcol); }
        if (MODE == 1) {
#pragma unroll
            for (int mp = 0; mp < NMAP; ++mp) { rope_x(qf[mp][0], prow); rope_x(qf[mp][DQK / 16 - 1], pcol); } }
        if (MODE == 2) { rope_in(qf[0][0], qf[0][1], prow); rope_in(qf[0][DQK / 16 - 2], qf[0][DQK / 16 - 1], pcol); }
    }
    constexpr bool FOLD = true;
#pragma unroll
    for (int mp = 0; mp < NMAP; ++mp)
#pragma unroll
        for (int kk = 0; kk < DQK / 16; ++kk) { const u32x4 w = __builtin_bit_cast(u32x4, qf[mp][kk]); u32x4 o4;
            o4.x = pk2(bflo(w.x) * scl2, bfhi(w.x) * scl2); o4.y = pk2(bflo(w.y) * scl2, bfhi(w.y) * scl2); o4.z = pk2(bflo(w.z) * scl2, bfhi(w.z) * scl2); o4.w = pk2(bflo(w.w) * scl2, bfhi(w.w) * scl2);
            qf[mp][kk] = __builtin_bit_cast(bf16x8, o4); }
    const bool noinit = m_init < -1.0e29f;
    const bf16x8 onesA = __builtin_bit_cast(bf16x8, (u32x4){hh == 0 ? 0x3F803F80u : 0u, 0u, 0u, 0u});
    bf16x8 mB[NMAP];
    auto set_mB = [&](const int mp, const float mv) { const float nm = -mv; const unsigned t = pk2(nm, 0.f); const unsigned w = pk2(nm, nm - bflo(t)); mB[mp] = __builtin_bit_cast(bf16x8, (u32x4){hh == 0 ? w : 0u, 0u, 0u, 0u}); };
    f32x16 O[NMAP][2];
    float m[NMAP], l[NMAP];
#pragma unroll
    for (int mp = 0; mp < NMAP; ++mp) { m[mp] = noinit ? 0.f : m_init; l[mp] = l_init; set_mB(mp, m[mp]);
#pragma unroll
        for (int dv = 0; dv < 2; ++dv)
#pragma unroll
            for (int i = 0; i < 16; ++i) O[mp][dv][i] = 0.f; }
    const int kr0 = tid / C::CPR, kc0 = tid % C::CPR; const int kr1 = (tid + 512) / C::CPR, kc1 = (tid + 512) % C::CPR;
    const int vr = tid >> 3, vc = tid & 7;
    const bool k2 = C::NCK > 512 && tid + 512 < C::NCK;
    const int kr1c = k2 ? kr1 : kr0, kc1c = k2 ? kc1 : kc0;
    struct Stg { u32x4 k0, k1, v; };
    auto ld_tile = [&](const int jt, Stg& g) { const bf16_t* kp; const bf16_t* vp; int ldk, kpos0, masked; tile(jt, kp, ldk, vp, kpos0, masked);
        g.k0 = *(const u32x4*)(kp + (size_t)kr0 * ldk + kc0 * 8); if (C::NCK > 512) g.k1 = *(const u32x4*)(kp + (size_t)kr1c * ldk + kc1c * 8);
        g.v = *(const u32x4*)(vp + (size_t)vr * (C::VROW ? ldk : KEYS) + vc * 8); };
    auto st_tile = [&](const int jt, const Stg& g) { ldsp kb = lds + (jt & 1) * C::KBYTES; ldsp vb = lds + 2 * C::KBYTES + (jt % 3) * C::VBYTES + vr * C::RSV + (vc >> 1) * 32 + (vc & 1) * 8;
        *(LAS u32x4*)(kb + kr0 * C::RSK + kc0 * 16) = g.k0; if (k2) *(LAS u32x4*)(kb + kr1 * C::RSK + kc1 * 16) = g.k1;
        if (C::VROW) *(LAS u32x4*)(lds + 2 * C::KBYTES + (jt % 3) * C::VBYTES + vr * C::RSV + vc * 16) = g.v;
        else { *(LAS u32x2*)vb = (u32x2){g.v.x, g.v.y}; *(LAS u32x2*)(vb + 16) = (u32x2){g.v.z, g.v.w}; } };
    const int grp = __builtin_amdgcn_readfirstlane(tid >> 8);
    bf16x8 pf[NMAP][2][2];
#pragma unroll
    for (int mp = 0; mp < NMAP; ++mp)
#pragma unroll
        for (int a2 = 0; a2 < 2; ++a2)
#pragma unroll
            for (int b2 = 0; b2 < 2; ++b2) pf[mp][a2][b2] = (bf16x8){0, 0, 0, 0, 0, 0, 0, 0};
    auto vbuf = [&](const int x) -> ldsp { return lds + 2 * C::KBYTES + (x % 3) * C::VBYTES; };
#define TR_READ(dst, addr, off) asm volatile("ds_read_b64_tr_b16 %0, %1 offset:%2" : "=v"(dst) : "v"(addr), "n"(off) : "memory")
    const int trb = ((lane >> 5) * 4 + ((lane >> 2) & 3)) * C::RSV + (((lane >> 4) & 1) * 16 + (lane & 3) * 4) * 2;
    auto pv_load = [&](ldsp vb, bf16x8 (&vf)[2][2][2]) {
#pragma unroll
        for (int dv = 0; dv < 2; ++dv)
#pragma unroll
            for (int ks = 0; ks < 2; ++ks)
#pragma unroll
                for (int s2 = 0; s2 < 2; ++s2) {
                    if (C::VROW) { const unsigned ad = (unsigned)(size_t)(vb + trb); u32x2 lo, hi;
                        TR_READ(lo, ad, (32 * ks + 16 * s2) * C::RSV + dv * 64); TR_READ(hi, ad, (32 * ks + 16 * s2 + 8) * C::RSV + dv * 64);
                        vf[dv][ks][s2] = __builtin_bit_cast(bf16x8, (u32x4){lo.x, lo.y, hi.x, hi.y}); }
                    else vf[dv][ks][s2] = *(const LAS bf16x8*)(vb + (32 * dv + r) * C::RSV + (32 * ks + 16 * s2 + 8 * hh) * 2); }
        if (C::VROW) asm volatile("s_waitcnt lgkmcnt(0)" : "+v"(vf[0][0][0]), "+v"(vf[0][0][1]), "+v"(vf[0][1][0]), "+v"(vf[0][1][1]), "+v"(vf[1][0][0]), "+v"(vf[1][0][1]), "+v"(vf[1][1][0]), "+v"(vf[1][1][1])); };
    auto pv_mma = [&](const bf16x8 (&vf)[2][2][2]) {
#pragma unroll
        for (int dv = 0; dv < 2; ++dv)
#pragma unroll
            for (int ks = 0; ks < 2; ++ks)
#pragma unroll
                for (int s2 = 0; s2 < 2; ++s2)
#pragma unroll
                    for (int mp = 0; mp < NMAP; ++mp) O[mp][dv] = __builtin_amdgcn_mfma_f32_32x32x16_bf16(vf[dv][ks][s2], pf[mp][ks][s2], O[mp][dv], 0, 0, 0); };
    auto pv_half = [&](ldsp vb, const int dv) {
        bf16x8 vh[2][2];
#pragma unroll
        for (int ks = 0; ks < 2; ++ks)
#pragma unroll
            for (int s2 = 0; s2 < 2; ++s2) {
                if (C::VROW) { const unsigned ad = (unsigned)(size_t)(vb + trb) + dv * 64; u32x2 lo, hi;
                    TR_READ(lo, ad, (32 * ks + 16 * s2) * C::RSV); TR_READ(hi, ad, (32 * ks + 16 * s2 + 8) * C::RSV);
                    vh[ks][s2] = __builtin_bit_cast(bf16x8, (u32x4){lo.x, lo.y, hi.x, hi.y}); }
                else vh[ks][s2] = *(const LAS bf16x8*)(vb + (32 * dv + r) * C::RSV + (32 * ks + 16 * s2 + 8 * hh) * 2); }
        if (C::VROW) asm volatile("s_waitcnt lgkmcnt(0)" : "+v"(vh[0][0]), "+v"(vh[0][1]), "+v"(vh[1][0]), "+v"(vh[1][1]));
        __builtin_amdgcn_sched_barrier(0);
#pragma unroll
        for (int ks = 0; ks < 2; ++ks)
#pragma unroll
            for (int s2 = 0; s2 < 2; ++s2)
#pragma unroll
                for (int mp = 0; mp < NMAP; ++mp) O[mp][dv] = __builtin_amdgcn_mfma_f32_32x32x16_bf16(vh[ks][s2], pf[mp][ks][s2], O[mp][dv], 0, 0, 0);
        __builtin_amdgcn_sched_barrier(0); };
    auto pv_tile = [&](ldsp vb) { if (NMAP == 1) { bf16x8 vf[2][2][2]; pv_load(vb, vf); __builtin_amdgcn_sched_barrier(0); pv_mma(vf); } else { pv_half(vb, 0); pv_half(vb, 1); } };
    auto smax = [&](const int mp, f32x16 (&s)[2], const int cur_kpos0, const int cur_masked, const bool first) {
        float mx = -3.0e38f;
#pragma unroll
        for (int ks = 0; ks < 2; ++ks)
#pragma unroll
            for (int i = 0; i < 16; ++i) {
                if (MODE == 2) { const int rel = cur_kpos0 + 32 * ks + (i & 3) + 8 * (i >> 2) + 4 * hh - qpos; if (cur_masked && (rel > 128 || rel < -128)) s[ks][i] = -1.0e30f; }
                mx = fmaxf(mx, s[ks][i]); }
        { const auto sw = __builtin_amdgcn_permlane32_swap(__float_as_uint(mx), __float_as_uint(mx), false, false); mx = fmaxf(__uint_as_float(sw[0]), __uint_as_float(sw[1])); }
        const bool force = noinit && first;
        if (force || __any(mx > 8.f)) {
            const float dl = force ? mx : fmaxf(mx, 0.f), alpha = force ? 1.f : __builtin_amdgcn_exp2f(-dl); m[mp] += dl; l[mp] *= alpha; set_mB(mp, m[mp]);
#pragma unroll
            for (int i = 0; i < 16; ++i) { s[0][i] -= dl; s[1][i] -= dl; }
#pragma unroll
            for (int dv = 0; dv < 2; ++dv)
#pragma unroll
                for (int i = 0; i < 16; ++i) O[mp][dv][i] *= alpha;
        }
        float ps = 0.f;
#pragma unroll
        for (int ks = 0; ks < 2; ++ks)
#pragma unroll
            for (int i = 0; i < 16; ++i) { const float pv = (ABL == 1) ? s[ks][i] : __builtin_amdgcn_exp2f(s[ks][i]); s[ks][i] = pv; if (ABL != 1) ps += pv; }
        l[mp] += ps;
#pragma unroll
        for (int ks = 0; ks < 2; ++ks)
#pragma unroll
            for (int s2 = 0; s2 < 2; ++s2) { u32x4 w; w.x = pk2(s[ks][8 * s2 + 0], s[ks][8 * s2 + 1]); w.y = pk2(s[ks][8 * s2 + 2], s[ks][8 * s2 + 3]);
                w.z = pk2(s[ks][8 * s2 + 4], s[ks][8 * s2 + 5]); w.w = pk2(s[ks][8 * s2 + 6], s[ks][8 * s2 + 7]);
                pf[mp][ks][s2] = __builtin_bit_cast(bf16x8, w); }
    };
    Stg ga, gb; ga.k1 = (u32x4){0u, 0u, 0u, 0u}; gb.k1 = (u32x4){0u, 0u, 0u, 0u}; gb.k0 = ga.k1; gb.v = ga.k1;
    auto step = [&](const int j, Stg& gx  , Stg& gy  ) {
        if (ABL != 8) ld_tile(j + 2 < ntiles ? j + 2 : ntiles - 1, gy);
        const bf16_t* kp_; const bf16_t* vp_; int ldk_, cur_kpos0, cur_masked; tile(j, kp_, ldk_, vp_, cur_kpos0, cur_masked);
        ldsp kb = lds + (j & 1) * C::KBYTES;
        if (grp == 1 && j > 0) pv_tile(vbuf(j - 1));
        bf16x8 vf0[2][2][2];
#pragma unroll
        for (int mp = 0; mp < NMAP; ++mp) {
            f32x16 s[2];
            bf16x8 kfr[2][DQK / 16];
#pragma unroll
            for (int ks = 0; ks < 2; ++ks)
#pragma unroll
                for (int kk = 0; kk < DQK / 16; ++kk) kfr[ks][kk] = *(const LAS bf16x8*)(kb + (32 * ks + r) * C::RSK + (mp * DQK + kk * 16 + hh * 8) * 2);
            if (NMAP == 1) __builtin_amdgcn_sched_barrier(0);
#pragma unroll
            for (int ks = 0; ks < 2; ++ks) {
#pragma unroll
                for (int i = 0; i < 16; ++i) s[ks][i] = 0.f;
                s[ks] = __builtin_amdgcn_mfma_f32_32x32x16_bf16(onesA, mB[mp], s[ks], 0, 0, 0);
#pragma unroll
                for (int kk = 0; kk < DQK / 16; ++kk) s[ks] = __builtin_amdgcn_mfma_f32_32x32x16_bf16(kfr[ks][kk], qf[mp][kk], s[ks], 0, 0, 0); }
            if (NMAP == 1 && grp == 0) pv_load(vbuf(j), vf0);
            if (NMAP == 1) __builtin_amdgcn_sched_barrier(0);
            smax(mp, s, cur_kpos0, cur_masked, j == 0);
        }
        if (grp == 0) { if (NMAP == 1) pv_mma(vf0); else pv_tile(vbuf(j)); }
        if (ABL != 8) if (j + 1 < ntiles) st_tile(j + 1, gx);
        if (ABL != 7) __syncthreads();
    };
    ld_tile(0, ga); ld_tile(ntiles > 1 ? 1 : 0, gb);
    __syncthreads();
    st_tile(0, ga);
    __syncthreads();
#pragma unroll 1
    for (int j = 0; j < ntiles; j += 2) { step(j, gb, ga); if (j + 1 < ntiles) step(j + 1, ga, gb); }
    if (grp == 1) pv_tile(vbuf(ntiles - 1));
    asm volatile("" ::: "memory");
    float inv[NMAP];
#pragma unroll
    for (int mp = 0; mp < NMAP; ++mp) { const float lt = l[mp] + __shfl_xor(l[mp], 32); inv[mp] = 1.f / lt; }
    float o[2][16];
#pragma unroll
    for (int dv = 0; dv < 2; ++dv)
#pragma unroll
        for (int i = 0; i < 16; ++i) { if (MODE == 1) o[dv][i] = O[0][dv][i] * inv[0] - lam * O[NMAP - 1][dv][i] * inv[NMAP - 1]; else o[dv][i] = O[0][dv][i] * inv[0]; }
    if (MODE == 1) {
        float ss = 0.f;
#pragma unroll
        for (int dv = 0; dv < 2; ++dv)
#pragma unroll
            for (int i = 0; i < 16; ++i) ss += o[dv][i] * o[dv][i];
        ss += __shfl_xor(ss, 32);
        const float rstd = rsqrtf(ss * (1.f / 64.f) + NORM_EPS) * post;
#pragma unroll
        for (int dv = 0; dv < 2; ++dv)
#pragma unroll
            for (int i = 0; i < 16; ++i) o[dv][i] *= rstd * subln[32 * dv + (i & 3) + 8 * (i >> 2) + 4 * hh];
    }
#pragma unroll
    for (int dv = 0; dv < 2; ++dv)
#pragma unroll
        for (int g = 0; g < 4; ++g) { u32x2 w; w.x = pk2(o[dv][4 * g + 0], o[dv][4 * g + 1]); w.y = pk2(o[dv][4 * g + 2], o[dv][4 * g + 3]);
            *(u32x2*)(orow + 32 * dv + 8 * g + 4 * hh) = w; }
}

template <int ABL = 0> DI void attn_c_unit(const Ctx& p, const int u, ldsp lds, const int dry = 0) {
    const int wave = tid_now() >> 6, r = tid_now() & 31;
    const bf16_t* QC = (const bf16_t*)(p.ws + WS_X + X_QC); const bf16_t* KC = (const bf16_t*)(p.ws + WS_X + X_KC); const bf16_t* CVt = (const bf16_t*)(p.ws + WS_X + X_CVT);
    bf16_t* Z = (bf16_t*)(p.ws + WS_Z);
    int b, h, row, nt, t0;
    if (u < 512) { b = u >> 6; h = (u >> 4) & 3; row = b * SEQ + (u & 15) * 256 + wave * 32 + r; nt = 68; t0 = 0; }
    else { const int v = u - 512; b = v >> 2; h = v & 3; row = ML + b * CTXL + wave * 32 + r; nt = 4; t0 = 64; }
    const bf16_t* kbase = KC + (size_t)(b * 4 + h) * KEYS * 96; const bf16_t* vbase = CVt + (size_t)(b * 4 + h) * 64 * KEYS;
    attn_unit<96, 1, 0, ABL>(lds, QC + (size_t)row * 384 + h * 96, nt,
        [=](int j, const bf16_t*& kp, int& ldk, const bf16_t*& vp, int& kpos0, int& masked) { const int key0 = (t0 + j) * 64; kp = kbase + (size_t)key0 * 96; ldk = 96; vp = vbase + key0; kpos0 = 0; masked = 0; },
        0.10206207261596577f * 1.4426950408889634f, -1.0e30f, 0.f, 0, dry ? (bf16_t*)(p.ws + WS_END) + (size_t)(row & 8191) * 1024 + h * 64 : Z + (size_t)row * NZ + ZC_Q + h * 64, 0.f, 0.f, nullptr,
        u < 512 ? (row & 4095) : -1, (const f32x2*)(p.ws + WS_ROPE8));
}
DI void attn_d_unit(const Ctx& p, const int li, const int u, ldsp lds, const int dry = 0) {
    const int wave = tid_now() >> 6, r = tid_now() & 31;
    bf16_t* Z = (bf16_t*)(p.ws + WS_Z); const bf16_t* DVt = (const bf16_t*)(p.ws + WS_X + X_DVT);
    int b, h, row, nt, t0;
    if (u < 512) { b = u >> 6; h = (u >> 4) & 3; row = b * SEQ + (u & 15) * 256 + wave * 32 + r; nt = 68; t0 = 0; }
    else { const int v = u - 512; b = v >> 2; h = v & 3; row = ML + b * CTXL + wave * 32 + r; nt = 4; t0 = 64; }
    const float* lamv = (const float*)(p.ws + WS_LAM); const float lam = lamv[li * 2], lam_init = lamv[li * 2 + 1];
    const bf16_t* zv = Z + ZD_V + h * 64; const bf16_t* zk = Z + ZD_K + h * 64;
    attn_unit<32, 2, 1>(lds, Z + (size_t)row * NZ + ZD_Q + h * 64, nt,
        [=](int j, const bf16_t*& kp, int& ldk, const bf16_t*& vp, int& kpos0, int& masked) { const int key0 = (t0 + j) * 64; const size_t kr = (size_t)key_row(b, key0) * NZ; kp = zk + kr; ldk = NZ; vp = zv + kr; kpos0 = 0; masked = 0; },
        0.17677669529663687f * 1.4426950408889634f, -1.0e30f, 0.f, 0, dry ? (bf16_t*)(p.ws + WS_END) + (size_t)(row & 8191) * 1024 + h * 64 : Z + (size_t)row * NZ + ZD_Q + h * 64, lam, 1.f - lam_init, p.in[20] + li * 64,
        u < 512 ? (row & 4095) : -1, (const f32x2*)(p.ws + WS_ROPE8));
}
DI void attn_a_unit(const Ctx& p, const int li, const int u, ldsp lds, const int dry = 0) {
    const int wave = tid_now() >> 6, r = tid_now() & 31;
    bf16_t* Z = (bf16_t*)(p.ws + WS_Z); const bf16_t* AVt = (const bf16_t*)(p.ws + WS_X + X_AVT);
    int b, kvh, row, qpos, nt, tlo;
    const bool latq = u < 512;
    if (latq) { b = u >> 6; kvh = (u >> 5) & 1; const int qb = u & 31; qpos = qb * 128 + (wave & 3) * 32 + r; row = b * SEQ + qpos;
        const int lo = qb > 0 ? (qb - 1) * 2 : 0, hi = qb < 31 ? (qb + 2) * 2 : 64; tlo = lo; nt = (hi - lo) + 4; }
    else { const int v = u - 512; b = v >> 2; kvh = (v >> 1) & 1; qpos = 0; row = ML + b * CTXL + (v & 1) * 128 + (wave & 3) * 32 + r; tlo = 64; nt = 4; }
    const int head = 2 * kvh + (wave >> 2);
    const int nband = latq ? nt - 4 : 0;
    const bf16_t* zv = Z + ZA_V + kvh * 64; const bf16_t* zk = Z + ZA_K + kvh * 64;
    const float sink = p.in[12][li * 4 + head] * 1.4426950408889634f;
    attn_unit<64, 1, 2>(lds, Z + (size_t)row * NZ + ZA_Q + head * 64, nt,
        [=](int j, const bf16_t*& kp, int& ldk, const bf16_t*& vp, int& kpos0, int& masked) {
            const int key0 = j < nband ? (tlo + j) * 64 : SEQ + (j - nband) * 64;
            const size_t kr = (size_t)key_row(b, key0) * NZ; kp = zk + kr; ldk = NZ; vp = zv + kr; kpos0 = key0; masked = j < nband; },
        0.125f * 1.4426950408889634f, sink, (tid_now() & 32) ? 0.f : 1.f, qpos, dry ? (bf16_t*)(p.ws + WS_END) + (size_t)(row & 8191) * 1024 + head * 64 : Z + (size_t)row * NZ + ZA_Q + head * 64, 0.f, 0.f, nullptr,
        latq ? qpos : -1, (const f32x2*)(p.ws + WS_ROPE16));
}

enum { PH_PRE = 0, PH_WN1, PH_IN, PH_PREP, PH_MLA, PH_MIX, PH_GATE0, PH_MERGE0, PH_GATE1, PH_MERGE1, PH_OUT, PH_NORM2, PH_SCAT, PH_MOE1, PH_MOE2, PH_FINAL, PH_COUNT };

template <int PH> DI void run_phase(const Params& P, const CtxRaw& pc, const int li, ldsp lds) {
    const Ctx p = fresh(pc);
    unsigned char* ws = p.ws; const char* wt = (const char*)(ws + WS_WT);
    const int G = gdim_now(), c = bid_now();
    if constexpr (PH == PH_PRE) phase_pre(P, lds);
    if constexpr (PH == PH_WN1) { phase_wconv(p, li, lds); phase_norm<0>(p, li); }
    if constexpr (PH == PH_IN) {
        pg8::SchedPlain S{(const char*)(ws + WS_HB), wt + WT_IN, 1024, 1024, MT / 256, NZ / 256, G, c, 0};
        pg8::EpiZ E{(bf16_t*)(ws + WS_Z)};
        pg8::gemm_phase(lds, 1024, 1024, 1024, S, E);
    }
    if constexpr (PH == PH_PREP) phase_prep(p, li, lds);
    if constexpr (PH == PH_MLA) {
        pg8::SchedPlain S{(const char*)(ws + WS_Z) + ZC_Q * 2, wt + WT_MLA, NZ, 384, MT / 256, 4, G, c, 0};
        pg8::EpiMla E{(bf16_t*)(ws + WS_X + X_QC), (bf16_t*)(ws + WS_X + X_KC), (bf16_t*)(ws + WS_X + X_CVT)};
#ifdef DUP_HSCAN
        { int dry = 1; asm volatile("" : "+s"(dry)); phase_hscan(p, dry); }
#endif
        phase_hscan(p);
#ifdef DUP_MLAG
        pg8::gemm_phase(lds, NZ, 384, 384, S, E);
#endif
        pg8::gemm_phase(lds, NZ, 384, 384, S, E);
    }
    if constexpr (PH == PH_MIX) {
        const int nq = li == 0 ? 544 : 512;
        const int cv = (G & 7) == 0 ? (c & 7) * (G >> 3) + (c >> 3) : c;
        for (int u = cv; u < nq; u += G) attn_c_unit(p, u, lds);
#ifdef DUP_ATTN_C
        { int dry = 1; asm volatile("" : "+s"(dry)); __syncthreads(); for (int u = cv; u < nq; u += G) attn_c_unit<DUP_ATTN_C>(p, u, lds, dry); __syncthreads(); }
#endif
#ifdef DUP_ATTN_D
        { int dry = 1; asm volatile("" : "+s"(dry)); for (int u = cv; u < nq; u += G) attn_d_unit(p, li, u, lds, dry); __syncthreads(); }
#endif
        for (int u = (cv + 32) % G; u < nq; u += G) attn_d_unit(p, li, u, lds);
#ifdef DUP_ATTN_A
        { int dry = 1; asm volatile("" : "+s"(dry)); for (int u = cv; u < nq; u += G) attn_a_unit(p, li, u, lds, dry); __syncthreads(); }
#endif
        for (int u = (cv + 64) % G; u < nq; u += G) attn_a_unit(p, li, u, lds);
        __syncthreads();
        const int nch = li == 0 ? NCHUNK : 512;
#ifdef DUP_H3
        { int dry = 1; asm volatile("" : "+s"(dry)); for (int u = cv; u < nch; u += G) hgrn3_unit(p, li, u, lds, dry); __syncthreads(); }
#endif
        for (int u = (cv + 96) % G; u < nch; u += G) hgrn3_unit(p, li, u, lds);
    }
    if constexpr (PH == PH_GATE0) {
        const int nM = li == 0 ? 136 : 128;
        pg8::SchedPlain S{(const char*)(ws + WS_HB), wt + WT_G, 1024, 1024, nM, 16, G, c, 0};
        pg8::EpiGate E{(unsigned char*)(ws + WS_X)};
        pg8::gemm_phase(lds, 1024, 1024, 1024, S, E);
    }
    if constexpr (PH == PH_MERGE0) {
        const int nM = li == 0 ? 136 : 128;
        pg8::SchedSeg S{(const char*)(ws + WS_Z), wt + WT_B, nM, G, c, 0};
        pg8::EpiHorner E{(bf16_t*)(ws + WS_Z), (const unsigned char*)(ws + WS_X)};
        pg8::gemm_seg(lds, NZ, 256, S, E);
    }
    if constexpr (PH == PH_OUT) {
        const int nM = li == 0 ? 136 : 128;
        pg8::SchedPlain S{(const char*)(ws + WS_Z) + ZY * 2, wt + WT_O, NZ, 1024, nM, 4, G, c, 0};
        float* ctxs = (float*)(ws + WS_CTXS);
        pg8::EpiOut E{li == 0 ? p.in[0] : p.out, li == 0 ? p.in[2] : ctxs, p.out, ctxs, (const float*)(ws + WS_MODV) + li * 9 * 6144};
        pg8::gemm_phase(lds, NZ, 1024, 1024, S, E);
    }
    if constexpr (PH == PH_NORM2) {
#ifdef DUP_NORM2
        { int dry = 1; asm volatile("" : "+s"(dry)); phase_norm2(p, li, lds, dry); __syncthreads(); }
#endif
        phase_norm2(p, li, lds); }
    if constexpr (PH == PH_MOE1 || PH == PH_MOE2) {
        LAS unsigned* off = (LAS unsigned*)(lds + pg8::STAGE_BYTES + 1024); LAS unsigned char* pe = (LAS unsigned char*)(lds + pg8::STAGE_BYTES);
        const unsigned* cnt = (const unsigned*)(ws + WS_CTL + CTL_CNT) + li * 32; const int* list = (const int*)(ws + WS_XG);
        const int nP = moe_offsets(cnt, off, pe);
        if constexpr (PH == PH_MOE1) {
            pg8::SchedMoeT<false> S{wt + WT_E1, 1024, nP, 2, G, c, (size_t)512 * 1024 * 2, pe, off, list, cnt, 1, 11};
            pg8::EpiMoeUp E{(bf16_t*)(ws + WS_HMID), off, cnt};
            pg8::gemm_gather(lds, (const char*)(ws + WS_HB), 1024, 1024, S, E);
        } else {
            pg8::SchedMoeT<true> S{wt + WT_E2, 256, nP, 4, G, c, (size_t)1024 * 256 * 2, pe, off, list, cnt, 0, 9};
            pg8::EpiMoeDown E{(bf16_t*)(ws + WS_Y), off, list, cnt, (const float*)(ws + WS_XG) + (size_t)32 * MOE_CAP};
            pg8::gemm_gather(lds, (const char*)(ws + WS_HMID), 256, 256, S, E);
        }
        __syncthreads();
    }
    if constexpr (PH == PH_FINAL) phase_norm<2>(p, 1);
}

#if N_LAUNCH_MODE == 1
template <int PH> __global__ __launch_bounds__(512, 2) void k_phase(Params p, int li) {
    extern __shared__ __attribute__((aligned(16))) unsigned char shm[];
    CtxRaw c; c.tab = (unsigned long long)(p.ws + WS_TAB); c.out = (unsigned long long)p.out; c.ws = (unsigned long long)p.ws;
    run_phase<PH>(p, c, li, (ldsp)shm);
}
#else
__global__ __launch_bounds__(512, 2) void k_mega(Params p) {
    extern __shared__ __attribute__((aligned(16))) unsigned char shm[];
    ldsp lds = (ldsp)shm;
    volatile LAS unsigned* st = (volatile LAS unsigned*)(lds + LDS_BYTES - 16);
    if (tid_now() == 0) { st[0] = 0u; st[1] = 0u; st[2] = 0u; st[3] = 0u; }
    __syncthreads();
    XcdBarrier bar = xcd_barrier_post((unsigned*)(p.ws + WS_CTL), st);
    CtxRaw c; c.tab = (unsigned long long)(p.ws + WS_TAB); c.out = (unsigned long long)p.out; c.ws = (unsigned long long)p.ws;
#ifdef STAMP_A
    LAS unsigned* tacc = (LAS unsigned*)(lds + LDS_BYTES - 512);
    if (tid_now() < 32) tacc[tid_now()] = 0u;
    __syncthreads();
    unsigned long long tprev = __builtin_amdgcn_s_memrealtime();
#define STAMP(ph) do { if (bid_now() == 0 && tid_now() == 0) { const unsigned long long tn = __builtin_amdgcn_s_memrealtime(); tacc[ph] += (unsigned)(tn - tprev); tprev = tn; } } while (0)
#else
#define STAMP(ph) do { } while (0)
#endif
#ifndef DUP_MASK
#define DUP_MASK 0
#endif
#ifndef DUP_L0_MASK
#define DUP_L0_MASK 0
#endif
#define DUP(PHX) do { if (((DUP_MASK >> PHX) & 1) || (((DUP_L0_MASK >> PHX) & 1) && li == 0)) { run_phase<PHX>(p, c, li, lds); xcd_barrier(bar); } } while (0)
    run_phase<PH_PRE>(p, c, 0, lds); xcd_barrier(bar); STAMP(PH_PRE);
#ifdef DUP_PRE
    run_phase<PH_PRE>(p, c, 0, lds); xcd_barrier(bar);
#endif
    for (int li = 0; li < 2; ++li) {
        run_phase<PH_WN1>(p, c, li, lds); xcd_barrier(bar); STAMP(PH_WN1); DUP(PH_WN1);
        run_phase<PH_IN>(p, c, li, lds); xcd_barrier(bar); STAMP(PH_IN); DUP(PH_IN);
        run_phase<PH_PREP>(p, c, li, lds); xcd_barrier(bar); STAMP(PH_PREP); DUP(PH_PREP);
        run_phase<PH_MLA>(p, c, li, lds); xcd_barrier(bar); STAMP(PH_MLA); DUP(PH_MLA);
        run_phase<PH_MIX>(p, c, li, lds); xcd_barrier(bar); STAMP(PH_MIX); DUP(PH_MIX);
        run_phase<PH_GATE0>(p, c, li, lds); xcd_barrier(bar); STAMP(PH_GATE0); DUP(PH_GATE0);
        run_phase<PH_MERGE0>(p, c, li, lds); xcd_barrier(bar); STAMP(PH_MERGE0); DUP(PH_MERGE0);
        run_phase<PH_OUT>(p, c, li, lds); xcd_barrier(bar); STAMP(PH_OUT); DUP(PH_OUT);
        run_phase<PH_NORM2>(p, c, li, lds); xcd_barrier(bar); STAMP(PH_NORM2); DUP(PH_NORM2);
        run_phase<PH_MOE1>(p, c, li, lds); xcd_barrier(bar); STAMP(PH_MOE1); DUP(PH_MOE1);
        run_phase<PH_MOE2>(p, c, li, lds); xcd_barrier(bar); STAMP(PH_MOE2); DUP(PH_MOE2);
    }
#ifdef STAMP_A
    if (bid_now() == 0 && tid_now() == 0) { float* tv = (float*)(p.ws + WS_LAM + 64); unsigned sa = 0u, sb = 0u;
#pragma unroll
        for (int q = 0; q < PH_COUNT; ++q) { if ((STAMP_A >> q) & 1) sa += tacc[q]; if ((STAMP_B >> q) & 1) sb += tacc[q]; }
        tv[0] = (float)sa * 0.01f; tv[1] = (float)sb * 0.01f; }
    xcd_barrier(bar);
#endif
    run_phase<PH_FINAL>(p, c, 1, lds);
}
#endif

extern "C" void kernel_launch(void* const* d_in, const int* in_sizes, int n_in, void* d_out, int out_size, void* d_ws, size_t ws_size, hipStream_t stream) {
    if (n_in != 29 || ws_size < WS_END || out_size != ML * D) { fprintf(stderr, "kernel_launch: unexpected shapes (n_in %d, ws %zu need %zu, out %d)\n", n_in, ws_size, (size_t)WS_END, out_size); return; }
    Params p{};
    for (int i = 0; i < 29; ++i) p.in[i] = (const float*)d_in[i];
    p.out = (float*)d_out; p.ws = (unsigned char*)d_ws;
    hipMemsetAsync((char*)d_ws + WS_CTL, 0, 65536, stream);
    const int grid = 256;
#if N_LAUNCH_MODE == 1
    static bool init = false;
#define SETLDS(PH) hipFuncSetAttribute((const void*)k_phase<PH>, hipFuncAttributeMaxDynamicSharedMemorySize, LDS_BYTES)
    if (!init) { SETLDS(PH_PRE); SETLDS(PH_WN1); SETLDS(PH_IN); SETLDS(PH_PREP); SETLDS(PH_MLA); SETLDS(PH_MIX); SETLDS(PH_GATE0); SETLDS(PH_MERGE0); SETLDS(PH_GATE1); SETLDS(PH_MERGE1);
        SETLDS(PH_OUT); SETLDS(PH_NORM2); SETLDS(PH_SCAT); SETLDS(PH_MOE1); SETLDS(PH_MOE2); SETLDS(PH_FINAL); init = true; }
#define LAUNCH(PH, li) hipLaunchKernelGGL(k_phase<PH>, dim3(grid), dim3(512), LDS_BYTES, stream, p, li)
    LAUNCH(PH_PRE, 0);
    for (int li = 0; li < 2; ++li) {
        LAUNCH(PH_WN1, li); LAUNCH(PH_IN, li); LAUNCH(PH_PREP, li); LAUNCH(PH_MLA, li); LAUNCH(PH_MIX, li);
        LAUNCH(PH_GATE0, li); LAUNCH(PH_MERGE0, li); LAUNCH(PH_OUT, li);
        LAUNCH(PH_NORM2, li); LAUNCH(PH_MOE1, li); LAUNCH(PH_MOE2, li);
    }
    LAUNCH(PH_FINAL, 1);
#else
    static bool init = false;
    if (!init) { hipFuncSetAttribute((const void*)k_mega, hipFuncAttributeMaxDynamicSharedMemorySize, LDS_BYTES); init = true; }
    hipLaunchKernelGGL(k_mega, dim3(grid), dim3(512), LDS_BYTES, stream, p);
#endif
}
```

```cpp
#include <hip/hip_runtime.h>
#include <stdint.h>
#include <stdio.h>

#ifndef N_LAUNCH_MODE
#define N_LAUNCH_MODE 0
#endif

#define LAS __attribute__((address_space(3)))
#define GAS __attribute__((address_space(1)))
typedef LAS unsigned char* ldsp;
typedef unsigned short bf16_t;
typedef short bf16x8 __attribute__((ext_vector_type(8)));
typedef short s16x4 __attribute__((ext_vector_type(4)));
typedef float f32x2 __attribute__((ext_vector_type(2)));
typedef float f32x4 __attribute__((ext_vector_type(4)));
typedef float f32x16 __attribute__((ext_vector_type(16)));
typedef unsigned u32x2 __attribute__((ext_vector_type(2)));
typedef unsigned u32x4 __attribute__((ext_vector_type(4)));
typedef __bf16 bf16x2_t __attribute__((ext_vector_type(2)));
#define DI __device__ __forceinline__

constexpr int D = 1024, NBAT = 8, SEQ = 4096, CTXL = 256;
constexpr int ML = NBAT * SEQ, MC = NBAT * CTXL, MT = ML + MC;
constexpr int NZ = 3072, KEYS = SEQ + CTXL;
constexpr int ZA_Q = 0, ZA_K = 256, ZA_V = 384, ZB_Q = 512, ZB_FF = 768, ZB_FB = 1024, ZB_I = 1280, ZB_G = 1536,
              ZC_Q = 1792, ZC_KV = 2048, ZC_KR = 2176, ZD_Q = 2208, ZD_K = 2464, ZD_V = 2720;
constexpr int ZY = 768;
constexpr int NCHUNK = MT / 64;
constexpr int MOE_MAXROWS = 77824;
constexpr int MOE_CAP = 2 * MT;
constexpr float NORM_EPS = 1e-6f;
constexpr int LDS_BYTES = 155648;
constexpr int HALF_ROWS = MT / 2;

constexpr size_t WS_CTL = 0;
constexpr size_t CTL_CNT = 16384;
constexpr size_t WS_MODV = 65536;
constexpr size_t WS_ROPE16 = 524288;
constexpr size_t WS_ROPE8 = WS_ROPE16 + 8192;
constexpr size_t WS_TAB = WS_ROPE8 + 8192;
constexpr size_t WS_LAM = WS_ROPE8 + 4096;
constexpr size_t WS_TOKI = 1048576;
constexpr size_t WS_ROWI = WS_TOKI + (size_t)MT * 32;
constexpr size_t WS_ROWW = WS_ROWI + (size_t)MOE_MAXROWS * 4;
constexpr size_t WS_HE = WS_ROWW + (size_t)MOE_MAXROWS * 4;
constexpr size_t WS_WT = 4u << 20;
constexpr size_t WT_IN = 0, WT_G = WT_IN + (size_t)NZ * 1024 * 2, WT_B = WT_G + (size_t)4096 * 1024 * 2, WT_O = WT_B + (size_t)4 * 1024 * 256 * 2,
                 WT_MLA = WT_O + (size_t)1024 * 1024 * 2, WT_E1 = WT_MLA + (size_t)1024 * 384 * 2, WT_E2 = WT_E1 + (size_t)32 * 512 * 1024 * 2,
                 WT_END = WT_E2 + (size_t)32 * 1024 * 256 * 2;
constexpr size_t WS_CTXS = WS_WT + WT_END;
constexpr size_t WS_HB = WS_CTXS + (size_t)MC * 1024 * 4;
constexpr size_t WS_Z = WS_HB + (size_t)MT * 1024 * 2;
constexpr size_t WS_X = WS_Z + (size_t)MT * NZ * 2;
constexpr size_t X_QC = 0, X_KC = X_QC + (size_t)MT * 384 * 2, X_CVT = X_KC + (size_t)NBAT * 4 * KEYS * 96 * 2, X_AVT = X_CVT + (size_t)NBAT * 4 * 64 * KEYS * 2,
                 X_DVT = X_AVT + (size_t)NBAT * 2 * 64 * KEYS * 2, X_U = X_DVT + (size_t)NBAT * 4 * 64 * KEYS * 2, X_END_MIX = X_U + (size_t)NCHUNK * 4 * 2 * 4096 * 2;
constexpr size_t X_SIZE = (size_t)MT * 4096;
static_assert(X_END_MIX <= X_SIZE, "mixer extras must fit the gate region");
constexpr size_t WS_END = WS_X + X_SIZE;
constexpr size_t WS_XG = WS_Z;
constexpr size_t WS_HMID = WS_XG + (size_t)MOE_MAXROWS * 1024 * 2;
constexpr size_t WS_Y = WS_HMID + (size_t)MOE_MAXROWS * 256 * 2;
static_assert(WS_Y + (size_t)2 * MT * 1024 * 2 <= WS_END, "MoE buffers must fit");

struct Params { const float* in[29]; float* out; unsigned char* ws; };
struct Inp { const unsigned long long GAS* tab; DI const float* operator[](int i) const { return (const float*)(const float GAS*)tab[i]; } };
struct Ctx { Inp in; float* out; unsigned char* ws; };
struct CtxRaw { unsigned long long tab, out, ws; };
DI Ctx fresh(CtxRaw c) { asm volatile("" : "+s"(c.tab), "+s"(c.out), "+s"(c.ws)); Ctx q; q.in.tab = (const unsigned long long GAS*)c.tab; q.out = (float*)(float GAS*)c.out; q.ws = (unsigned char*)(unsigned char GAS*)c.ws; return q; }

DI int bid_now() { int t = (int)__builtin_amdgcn_workgroup_id_x(); asm volatile("" : "+s"(t)); return t; }
DI int gdim_now() { int t = (int)__builtin_amdgcn_grid_size_x() / 512; asm volatile("" : "+s"(t)); return t; }
DI int tid_now() { int t = (int)__builtin_amdgcn_workitem_id_x(); asm volatile("" : "+v"(t)); return t; }
DI unsigned pk2(float a, float b) { f32x2 v = {a, b}; bf16x2_t r = __builtin_convertvector(v, bf16x2_t); return __builtin_bit_cast(unsigned, r); }
DI float bflo(unsigned u) { return __uint_as_float(u << 16); }
DI float bfhi(unsigned u) { return __uint_as_float(u & 0xffff0000u); }
DI float bf2f(bf16_t v) { return __uint_as_float((unsigned)v << 16); }
DI bf16_t f2bf(float f) { return (bf16_t)(pk2(f, 0.f) & 0xffffu); }
DI float sigmoidf_(float v) { return __builtin_amdgcn_rcpf(1.f + __expf(-v)); }
template <int CTRL> DI float dpp_f(float x) { return __builtin_bit_cast(float, __builtin_amdgcn_update_dpp(0, __builtin_bit_cast(int, x), CTRL, 0xf, 0xf, true)); }
DI float wave_sum(float v) { v += dpp_f<0xB1>(v); v += dpp_f<0x4E>(v); v += dpp_f<0x141>(v); v += dpp_f<0x140>(v);
    { const auto s = __builtin_amdgcn_permlane16_swap(__float_as_uint(v), __float_as_uint(v), false, false); v = __uint_as_float(s[0]) + __uint_as_float(s[1]); }
    { const auto s = __builtin_amdgcn_permlane32_swap(__float_as_uint(v), __float_as_uint(v), false, false); v = __uint_as_float(s[0]) + __uint_as_float(s[1]); }
    return v; }
DI void row_bk(int row, int& b, int& key) { if (row < ML) { b = row >> 12; key = row & 4095; } else { const int r = row - ML; b = r >> 8; key = SEQ + (r & 255); } }
DI int key_row(int b, int key) { return key < SEQ ? b * SEQ + key : ML + b * CTXL + (key - SEQ); }
DI int chunk_row0(int cidx) { return cidx < 512 ? cidx * 64 : ML + (cidx - 512) * 64; }

#define XB_TMO      128
#define XB_XCNT(j)  (256  + 64 * (j))
#define XB_XSUB(j)  (1280 + 64 * (j))
#define XB_XGEN(j)  (2304 + 64 * (j))
#define XB_TOP      3328
#define XB_TOPGEN   3392
#define XCD_BAR_WORDS 3456
#define XB_SPIN_CAP (1u << 22)
DI unsigned xb_ld(unsigned* p)              { return __hip_atomic_load(p, __ATOMIC_RELAXED, __HIP_MEMORY_SCOPE_AGENT); }
DI unsigned xb_add(unsigned* p, unsigned v) { return __hip_atomic_fetch_add(p, v, __ATOMIC_RELAXED, __HIP_MEMORY_SCOPE_AGENT); }
DI unsigned xb_xcc_id() { return (unsigned)__builtin_amdgcn_s_getreg((3 << 11) | 20) & 0xFu; }
#define XB_SPIN(cond, bar) do { unsigned _sp = 0; while (cond) { __builtin_amdgcn_s_sleep(1); \
    if ((++_sp & 255u) == 0u) { if (xb_ld(&(bar)[XB_TMO])) break; if (_sp > XB_SPIN_CAP) { atomicAdd(&(bar)[XB_TMO], 1u); break; } } } } while (0)
struct XcdBarrier { unsigned* bar; unsigned x; volatile LAS unsigned* st; };
DI XcdBarrier xcd_barrier_post(unsigned* bar, volatile LAS unsigned* st) {
    XcdBarrier b; b.bar = bar; b.x = xb_xcc_id(); b.st = st;
    if (tid_now() == 0) (void)xb_add(&bar[XB_XCNT(b.x)], 1u);
    return b;
}
DI void xcd_barrier_complete(unsigned* bar, unsigned x, unsigned& nloc, unsigned& nx) {
    const unsigned G = (unsigned)gdim_now();
    unsigned sum, cnt, mine, sp = 0u;
    for (;;) {
        sum = 0u; cnt = 0u;
#pragma unroll 1
        for (unsigned j = 0; j < 16; ++j) { const unsigned c = xb_ld(&bar[XB_XCNT(j)]); sum += c; cnt += (c > 0u) ? 1u : 0u; }
        if (sum == G) break;
        __builtin_amdgcn_s_sleep(1);
        if ((++sp & 255u) == 0u) { if (xb_ld(&bar[XB_TMO])) break; if (sp > XB_SPIN_CAP) { atomicAdd(&bar[XB_TMO], 1u); break; } }
    }
    mine = xb_ld(&bar[XB_XCNT(x)]);
    nloc = mine > 0u ? mine : 1u; nx = cnt > 0u ? cnt : 1u;
}
DI void xcd_barrier1(const XcdBarrier& b) {
    asm volatile("s_waitcnt vmcnt(0)" ::: "memory");
    __syncthreads();
    if (tid_now() == 0) {
        unsigned long long ba = (unsigned long long)b.bar; unsigned bx = b.x; asm volatile("" : "+s"(ba), "+s"(bx));
        unsigned* bar = (unsigned*)(unsigned GAS*)ba;
        __builtin_amdgcn_s_waitcnt(0);
        unsigned nloc = b.st[0], nx = b.st[1];
        if (nloc == 0u) { xcd_barrier_complete(bar, bx, nloc, nx); b.st[0] = nloc; b.st[1] = nx; }
        const unsigned old = xb_add(&bar[XB_XSUB(bx)], 1u);
        const unsigned gen = old / nloc;
        if (old + 1u == (gen + 1u) * nloc) {
            __builtin_amdgcn_fence(__ATOMIC_RELEASE, "agent");
            asm volatile("s_waitcnt vmcnt(0)" ::: "memory");
            const unsigned og = xb_add(&bar[XB_TOP], 1u);
            const unsigned tg = og / nx;
            if (og + 1u == (tg + 1u) * nx) xb_add(&bar[XB_TOPGEN], 1u);
            else XB_SPIN(xb_ld(&bar[XB_TOPGEN]) == tg, bar);
            __builtin_amdgcn_fence(__ATOMIC_ACQUIRE, "agent");
            xb_add(&bar[XB_XGEN(bx)], 1u);
            asm volatile("s_waitcnt vmcnt(0)" ::: "memory");
        } else {
            XB_SPIN(xb_ld(&bar[XB_XGEN(bx)]) == gen, bar);
            __builtin_amdgcn_fence(__ATOMIC_ACQUIRE, "agent");
            asm volatile("s_waitcnt vmcnt(0)" ::: "memory");
        }
    }
    __syncthreads();
}
DI void xcd_barrier(const XcdBarrier& b) {
    xcd_barrier1(b);
#ifdef DUP_BARRIER
    xcd_barrier1(b); xcd_barrier1(b);
#endif
}

namespace pg8 {
constexpr int BM = 256, BK = 64, HALF = 128, HTB = HALF * BK * 2, STAGE_BYTES = 8 * HTB, NXCD = 8, WGM = 8;
DI int lds_byte(int r, int c) { const int st = (r >> 4) * 2 + (c >> 5), rr = r & 15, cc = c & 31, ob = rr * 64 + cc * 2; return st * 1024 + (ob ^ (((ob >> 9) & 1) << 5)); }
DI void stage_rc(int b, int& R, int& C) { const int st = b / 1024, sb = b % 1024, swz = sb ^ (((sb >> 9) & 1) << 5); R = (st >> 1) * 16 + swz / 64; C = (st & 1) * 32 + (swz % 64) / 2; }
DI int perm32(int rho) { const int n = rho >> 4, i = rho & 15; return 8 * (i >> 2) + 4 * n + (i & 3); }
struct Unit { int pm, pn, aux; };
DI void tile_of(int L, int nM, int nN, int& pm, int& pn) {
    const int nwg = nM * nN; int wgid = L;
    { const int q = nwg / NXCD, r = nwg % NXCD, xcd = wgid % NXCD, off = wgid / NXCD; wgid = (xcd < r ? xcd * (q + 1) : r * (q + 1) + (xcd - r) * q) + off; }
    const int nig = WGM * nN, gid = wgid / nig, fm = gid * WGM, gsz = (nM - fm) < WGM ? (nM - fm) : WGM;
    pm = fm + ((wgid % nig) % gsz); pn = (wgid % nig) / gsz;
}

template <class Epi, class Sched>
DI void gemm_phase(ldsp lds, const int lda, const int ldb, const int K, const Sched& S, const Epi& E) {
    const int tid = tid_now(), wid = __builtin_amdgcn_readfirstlane(tid >> 6), lane = tid & 63, wr = wid >> 2, wc = wid & 3, fr = lane & 15, fq = lane >> 4;
    const int nt = K / BK;
    unsigned voffA[2], voffB[2];
#pragma unroll
    for (int i = 0; i < 2; ++i) { int R, C; stage_rc(tid * 16 + i * 8192, R, C); const int Rb = Epi::PERM ? ((R & ~31) + perm32(R & 31)) : R;
        voffA[i] = (unsigned)(R * lda + C) * 2u; voffB[i] = (unsigned)(Rb * ldb + C) * 2u; }
    const size_t kstep = (size_t)(BK * 2);
    const size_t hstepA = (size_t)HALF * lda * 2, hstepB = (size_t)HALF * ldb * 2;
    const unsigned ldsw = (unsigned)wid * 1024u;
    const int aoff = lds_byte(wr * 64 + fr, fq * 8), boff = lds_byte(wc * 32 + fr, fq * 8);
#define PG8_SA(b, h) (((b) * 2 + (h)) * HTB)
#define PG8_SB(b, h) ((4 + (b) * 2 + (h)) * HTB)
#define PG8_STAGE(bufoff, gbase, voff) do { _Pragma("unroll") for (int _i = 0; _i < 2; ++_i) \
        __builtin_amdgcn_global_load_lds((const unsigned*)((const char*)(gbase) + (voff)[_i]), (LAS unsigned*)(lds + (bufoff) + ldsw + _i * 8192), 16, 0, 0); } while (0)
#define PG8_LDA(dst, b, h) do { _Pragma("unroll") for (int m = 0; m < 4; ++m) _Pragma("unroll") for (int k = 0; k < 2; ++k) dst[m][k] = *(const LAS bf16x8*)(lds + PG8_SA(b, h) + aoff + m * 2048 + k * 1024); } while (0)
#define PG8_LDB(dst, b, h) do { _Pragma("unroll") for (int n = 0; n < 2; ++n) _Pragma("unroll") for (int k = 0; k < 2; ++k) dst[n][k] = *(const LAS bf16x8*)(lds + PG8_SB(b, h) + boff + n * 2048 + k * 1024); } while (0)
#define PG8_MMA(ai, bj, At, Bt) do { __builtin_amdgcn_s_setprio(1); _Pragma("unroll") for (int m = 0; m < 4; ++m) _Pragma("unroll") for (int n = 0; n < 2; ++n) _Pragma("unroll") for (int k = 0; k < 2; ++k) \
        acc[ai][bj][m][n] = __builtin_amdgcn_mfma_f32_16x16x32_bf16(Bt[n][k], At[m][k], acc[ai][bj][m][n], 0, 0, 0); __builtin_amdgcn_s_setprio(0); } while (0)
#define PG8_WAIT_V(n) asm volatile("s_waitcnt vmcnt(" #n ")" ::: "memory")
#define PG8_WAIT_L(n) asm volatile("s_waitcnt lgkmcnt(" #n ")" ::: "memory")
#define PG8_BAR __builtin_amdgcn_s_barrier()
#define PG8_SCHED __builtin_amdgcn_sched_barrier(0)
    Unit cur, nxt; int ui = 0;
    if (!S.next(0, cur)) return;
    f32x4 acc[2][2][4][2];
#pragma unroll
    for (int a = 0; a < 2; ++a)
#pragma unroll
        for (int b = 0; b < 2; ++b)
#pragma unroll
            for (int m = 0; m < 4; ++m)
#pragma unroll
                for (int n = 0; n < 2; ++n) acc[a][b][m][n] = (f32x4){0.f, 0.f, 0.f, 0.f};
    bf16x8 At[4][2], B0[2][2], B1[2][2];
    const char* cA = S.abase(cur); const char* cB = S.bbase(cur);
    PG8_STAGE(PG8_SB(0, 0), cB, voffB); PG8_STAGE(PG8_SA(0, 0), cA, voffA); PG8_STAGE(PG8_SB(0, 1), cB + hstepB, voffB); PG8_STAGE(PG8_SA(0, 1), cA + hstepA, voffA);
    if (wr == 1) PG8_BAR;
    PG8_WAIT_V(4); PG8_BAR;
    PG8_STAGE(PG8_SB(1, 0), cB + kstep, voffB); PG8_STAGE(PG8_SA(1, 0), cA + kstep, voffA); PG8_STAGE(PG8_SB(1, 1), cB + hstepB + kstep, voffB);
    PG8_WAIT_V(6); PG8_BAR;
    for (;;) {
        const bool has_next = S.next(ui + 1, nxt);
        const char* nA = has_next ? S.abase(nxt) : cA; const char* nB = has_next ? S.bbase(nxt) : cB;
#pragma unroll 1
        for (int t = 0; t < nt; t += 2) {
            const bool last = (t == nt - 2);
            const char* a1 = cA + (size_t)(t + 1) * kstep;
            const char* a2 = last ? nA : cA + (size_t)(t + 2) * kstep; const char* b2 = last ? nB : cB + (size_t)(t + 2) * kstep;
            const char* a3 = a2 + kstep; const char* b3 = b2 + kstep;
            PG8_LDB(B0, 0, 0); PG8_SCHED; PG8_LDA(At, 0, 0); PG8_STAGE(PG8_SA(1, 1), a1 + hstepA, voffA);
            PG8_WAIT_L(8); PG8_BAR; PG8_WAIT_L(0); PG8_MMA(0, 0, At, B0); PG8_BAR; PG8_SCHED;
            PG8_LDB(B1, 0, 1); PG8_STAGE(PG8_SB(0, 0), b2, voffB);
            PG8_BAR; PG8_WAIT_L(0); PG8_MMA(0, 1, At, B1); PG8_BAR;
            PG8_LDA(At, 0, 1); PG8_STAGE(PG8_SA(0, 0), a2, voffA);
            PG8_BAR; PG8_WAIT_L(0); PG8_MMA(1, 0, At, B0); PG8_BAR; PG8_SCHED;
            PG8_STAGE(PG8_SB(0, 1), b2 + hstepB, voffB);
            PG8_WAIT_V(6); PG8_BAR; PG8_MMA(1, 1, At, B1); PG8_BAR;
            PG8_LDB(B0, 1, 0); PG8_SCHED; PG8_LDA(At, 1, 0); PG8_STAGE(PG8_SA(0, 1), a2 + hstepA, voffA);
            PG8_WAIT_L(8); PG8_BAR; PG8_WAIT_L(0); PG8_MMA(0, 0, At, B0); PG8_BAR; PG8_SCHED;
            PG8_LDB(B1, 1, 1); PG8_STAGE(PG8_SB(1, 0), b3, voffB);
            PG8_BAR; PG8_WAIT_L(0); PG8_MMA(0, 1, At, B1); PG8_BAR;
            PG8_LDA(At, 1, 1); PG8_STAGE(PG8_SA(1, 0), a3, voffA);
            PG8_BAR; PG8_WAIT_L(0); PG8_MMA(1, 0, At, B0); PG8_BAR; PG8_SCHED;
            PG8_STAGE(PG8_SB(1, 1), b3 + hstepB, voffB);
            PG8_WAIT_V(6); PG8_BAR; PG8_MMA(1, 1, At, B1); PG8_BAR;
        }
        { int fr2 = fr, fq2 = fq; asm volatile("" : "+v"(fr2), "+v"(fq2));
          E(acc, cur, wr, wc, fr2, fq2); }
        if (!has_next) break;
#pragma unroll
        for (int a = 0; a < 2; ++a)
#pragma unroll
            for (int b = 0; b < 2; ++b)
#pragma unroll
                for (int m = 0; m < 4; ++m)
#pragma unroll
                    for (int n = 0; n < 2; ++n) acc[a][b][m][n] = (f32x4){0.f, 0.f, 0.f, 0.f};
        cur = nxt; cA = nA; cB = nB; ++ui;
    }
    PG8_WAIT_V(0);
    if (wr == 0) PG8_BAR;
    PG8_BAR;
#undef PG8_SA
#undef PG8_SB
#undef PG8_STAGE
#undef PG8_LDA
#undef PG8_LDB
#undef PG8_MMA
#undef PG8_WAIT_V
#undef PG8_WAIT_L
#undef PG8_BAR
#undef PG8_SCHED
}

template <class Epi, class Sched>
DI void gemm_gather(ldsp lds, const char* Abase, const int ldb, const int K, const Sched& S, const Epi& E) {
    const int tid = tid_now(), wid = __builtin_amdgcn_readfirstlane(tid >> 6), lane = tid & 63, wr = wid >> 2, wc = wid & 3, fr = lane & 15, fq = lane >> 4;
    const int nt = K / BK;
    unsigned voffB[2]; int Ra0, Ca0, Ra1, Ca1; stage_rc(tid * 16, Ra0, Ca0); stage_rc(tid * 16 + 8192, Ra1, Ca1);
#pragma unroll
    for (int i = 0; i < 2; ++i) { int R, C; stage_rc(tid * 16 + i * 8192, R, C); const int Rb = Epi::PERM ? ((R & ~31) + perm32(R & 31)) : R; voffB[i] = (unsigned)(Rb * ldb + C) * 2u; }
    const size_t kstep = (size_t)(BK * 2);
    const size_t hstepB = (size_t)HALF * ldb * 2;
    unsigned c00, c01, c10, c11, n00 = 0u, n01 = 0u, n10 = 0u, n11 = 0u;
#define PG8_STAGE2(bufoff, gbase, v0, v1) do { \
        __builtin_amdgcn_global_load_lds((const unsigned*)((const char*)(gbase) + (v0)), (LAS unsigned*)(lds + (bufoff) + ldsw), 16, 0, 0); \
        __builtin_amdgcn_global_load_lds((const unsigned*)((const char*)(gbase) + (v1)), (LAS unsigned*)(lds + (bufoff) + ldsw + 8192), 16, 0, 0); } while (0)
    const unsigned ldsw = (unsigned)wid * 1024u;
    const int aoff = lds_byte(wr * 64 + fr, fq * 8), boff = lds_byte(wc * 32 + fr, fq * 8);
#define PG8_SA(b, h) (((b) * 2 + (h)) * HTB)
#define PG8_SB(b, h) ((4 + (b) * 2 + (h)) * HTB)
#define PG8_STAGE(bufoff, gbase, voff) do { _Pragma("unroll") for (int _i = 0; _i < 2; ++_i) \
        __builtin_amdgcn_global_load_lds((const unsigned*)((const char*)(gbase) + (voff)[_i]), (LAS unsigned*)(lds + (bufoff) + ldsw + _i * 8192), 16, 0, 0); } while (0)
#define PG8_LDA(dst, b, h) do { _Pragma("unroll") for (int m = 0; m < 4; ++m) _Pragma("unroll") for (int k = 0; k < 2; ++k) dst[m][k] = *(const LAS bf16x8*)(lds + PG8_SA(b, h) + aoff + m * 2048 + k * 1024); } while (0)
#define PG8_LDB(dst, b, h) do { _Pragma("unroll") for (int n = 0; n < 2; ++n) _Pragma("unroll") for (int k = 0; k < 2; ++k) dst[n][k] = *(const LAS bf16x8*)(lds + PG8_SB(b, h) + boff + n * 2048 + k * 1024); } while (0)
#define PG8_MMA(ai, bj, At, Bt) do { __builtin_amdgcn_s_setprio(1); _Pragma("unroll") for (int m = 0; m < 4; ++m) _Pragma("unroll") for (int n = 0; n < 2; ++n) _Pragma("unroll") for (int k = 0; k < 2; ++k) \
        acc[ai][bj][m][n] = __builtin_amdgcn_mfma_f32_16x16x32_bf16(Bt[n][k], At[m][k], acc[ai][bj][m][n], 0, 0, 0); __builtin_amdgcn_s_setprio(0); } while (0)
#define PG8_WAIT_V(n) asm volatile("s_waitcnt vmcnt(" #n ")" ::: "memory")
#define PG8_WAIT_L(n) asm volatile("s_waitcnt lgkmcnt(" #n ")" ::: "memory")
#define PG8_BAR __builtin_amdgcn_s_barrier()
#define PG8_SCHED __builtin_amdgcn_sched_barrier(0)
    Unit cur, nxt; int ui = 0;
    if (!S.next(0, cur)) return;
    f32x4 acc[2][2][4][2];
#pragma unroll
    for (int a = 0; a < 2; ++a)
#pragma unroll
        for (int b = 0; b < 2; ++b)
#pragma unroll
            for (int m = 0; m < 4; ++m)
#pragma unroll
                for (int n = 0; n < 2; ++n) acc[a][b][m][n] = (f32x4){0.f, 0.f, 0.f, 0.f};
    bf16x8 At[4][2], B0[2][2], B1[2][2];
    const char* cA = Abase; const char* cB = S.bbase(cur);
    S.rowoff(cur, Ra0, Ca0, Ra1, Ca1, c00, c01, c10, c11);
    PG8_STAGE(PG8_SB(0, 0), cB, voffB); PG8_STAGE2(PG8_SA(0, 0), cA, c00, c01); PG8_STAGE(PG8_SB(0, 1), cB + hstepB, voffB); PG8_STAGE2(PG8_SA(0, 1), cA, c10, c11);
    if (wr == 1) PG8_BAR;
    PG8_WAIT_V(4); PG8_BAR;
    PG8_STAGE(PG8_SB(1, 0), cB + kstep, voffB); PG8_STAGE2(PG8_SA(1, 0), cA + kstep, c00, c01); PG8_STAGE(PG8_SB(1, 1), cB + hstepB + kstep, voffB);
    PG8_WAIT_V(6); PG8_BAR;
    for (;;) {
        const bool has_next = S.next(ui + 1, nxt);
        const char* nB = has_next ? S.bbase(nxt) : cB;
        if (has_next) S.rowoff(nxt, Ra0, Ca0, Ra1, Ca1, n00, n01, n10, n11); else { n00 = c00; n01 = c01; n10 = c10; n11 = c11; }
#pragma unroll 1
        for (int t = 0; t < nt; t += 2) {
            const bool last = (t == nt - 2);
            const char* a1 = cA + (size_t)(t + 1) * kstep;
            const char* a2 = last ? cA : cA + (size_t)(t + 2) * kstep; const char* b2 = last ? nB : cB + (size_t)(t + 2) * kstep;
            const char* a3 = a2 + kstep; const char* b3 = b2 + kstep;
            const unsigned w00 = last ? n00 : c00, w01 = last ? n01 : c01, w10 = last ? n10 : c10, w11 = last ? n11 : c11;
            PG8_LDB(B0, 0, 0); PG8_SCHED; PG8_LDA(At, 0, 0); PG8_STAGE2(PG8_SA(1, 1), a1, c10, c11);
            PG8_WAIT_L(8); PG8_BAR; PG8_WAIT_L(0); PG8_MMA(0, 0, At, B0); PG8_BAR; PG8_SCHED;
            PG8_LDB(B1, 0, 1); PG8_STAGE(PG8_SB(0, 0), b2, voffB);
            PG8_BAR; PG8_WAIT_L(0); PG8_MMA(0, 1, At, B1); PG8_BAR;
            PG8_LDA(At, 0, 1); PG8_STAGE2(PG8_SA(0, 0), a2, w00, w01);
            PG8_BAR; PG8_WAIT_L(0); PG8_MMA(1, 0, At, B0); PG8_BAR; PG8_SCHED;
            PG8_STAGE(PG8_SB(0, 1), b2 + hstepB, voffB);
            PG8_WAIT_V(6); PG8_BAR; PG8_MMA(1, 1, At, B1); PG8_BAR;
            PG8_LDB(B0, 1, 0); PG8_SCHED; PG8_LDA(At, 1, 0); PG8_STAGE2(PG8_SA(0, 1), a2, w10, w11);
            PG8_WAIT_L(8); PG8_BAR; PG8_WAIT_L(0); PG8_MMA(0, 0, At, B0); PG8_BAR; PG8_SCHED;
            PG8_LDB(B1, 1, 1); PG8_STAGE(PG8_SB(1, 0), b3, voffB);
            PG8_BAR; PG8_WAIT_L(0); PG8_MMA(0, 1, At, B1); PG8_BAR;
            PG8_LDA(At, 1, 1); PG8_STAGE2(PG8_SA(1, 0), a3, w00, w01);
            PG8_BAR; PG8_WAIT_L(0); PG8_MMA(1, 0, At, B0); PG8_BAR; PG8_SCHED;
            PG8_STAGE(PG8_SB(1, 1), b3 + hstepB, voffB);
            PG8_WAIT_V(6); PG8_BAR; PG8_MMA(1, 1, At, B1); PG8_BAR;
        }
        { int fr2 = fr, fq2 = fq; asm volatile("" : "+v"(fr2), "+v"(fq2));
          E(acc, cur, wr, wc, fr2, fq2); }
        if (!has_next) break;
#pragma unroll
        for (int a = 0; a < 2; ++a)
#pragma unroll
            for (int b = 0; b < 2; ++b)
#pragma unroll
                for (int m = 0; m < 4; ++m)
#pragma unroll
                    for (int n = 0; n < 2; ++n) acc[a][b][m][n] = (f32x4){0.f, 0.f, 0.f, 0.f};
        cur = nxt; cB = nB; ++ui; c00 = n00; c01 = n01; c10 = n10; c11 = n11;
    }
    PG8_WAIT_V(0);
    if (wr == 0) PG8_BAR;
    PG8_BAR;
#undef PG8_SA
#undef PG8_SB
#undef PG8_STAGE
#undef PG8_STAGE2
#undef PG8_LDA
#undef PG8_LDB
#undef PG8_MMA
#undef PG8_WAIT_V
#undef PG8_WAIT_L
#undef PG8_BAR
#undef PG8_SCHED
}


template <class Epi, class Sched>
DI void gemm_seg(ldsp lds, const int lda, const int ldb, const Sched& S, const Epi& E) {
    constexpr int K = 1024;
    const int tid = tid_now(), wid = __builtin_amdgcn_readfirstlane(tid >> 6), lane = tid & 63, wr = wid >> 2, wc = wid & 3, fr = lane & 15, fq = lane >> 4;
    const int nt = K / BK;
    unsigned voffA[2], voffB[2];
#pragma unroll
    for (int i = 0; i < 2; ++i) { int R, C; stage_rc(tid * 16 + i * 8192, R, C); const int Rb = Epi::PERM ? ((R & ~31) + perm32(R & 31)) : R;
        voffA[i] = (unsigned)(R * lda + C) * 2u; voffB[i] = (unsigned)(Rb * ldb + C) * 2u; }
    const size_t kstep = (size_t)(BK * 2);
    const size_t hstepA = (size_t)HALF * lda * 2, hstepB = (size_t)HALF * ldb * 2;
    const unsigned ldsw = (unsigned)wid * 1024u;
    const int aoff = lds_byte(wr * 64 + fr, fq * 8), boff = lds_byte(wc * 32 + fr, fq * 8);
#define PG8_SA(b, h) (((b) * 2 + (h)) * HTB)
#define PG8_SB(b, h) ((4 + (b) * 2 + (h)) * HTB)
#define PG8_STAGE(bufoff, gbase, voff) do { _Pragma("unroll") for (int _i = 0; _i < 2; ++_i) \
        __builtin_amdgcn_global_load_lds((const unsigned*)((const char*)(gbase) + (voff)[_i]), (LAS unsigned*)(lds + (bufoff) + ldsw + _i * 8192), 16, 0, 0); } while (0)
#define PG8_LDA(dst, b, h) do { _Pragma("unroll") for (int m = 0; m < 4; ++m) _Pragma("unroll") for (int k = 0; k < 2; ++k) dst[m][k] = *(const LAS bf16x8*)(lds + PG8_SA(b, h) + aoff + m * 2048 + k * 1024); } while (0)
#define PG8_LDB(dst, b, h) do { _Pragma("unroll") for (int n = 0; n < 2; ++n) _Pragma("unroll") for (int k = 0; k < 2; ++k) dst[n][k] = *(const LAS bf16x8*)(lds + PG8_SB(b, h) + boff + n * 2048 + k * 1024); } while (0)
#define PG8_MMA(ai, bj, At, Bt) do { __builtin_amdgcn_s_setprio(1); _Pragma("unroll") for (int m = 0; m < 4; ++m) _Pragma("unroll") for (int n = 0; n < 2; ++n) _Pragma("unroll") for (int k = 0; k < 2; ++k) \
        acc[ai][bj][m][n] = __builtin_amdgcn_mfma_f32_16x16x32_bf16(Bt[n][k], At[m][k], acc[ai][bj][m][n], 0, 0, 0); __builtin_amdgcn_s_setprio(0); } while (0)
#define PG8_WAIT_V(n) asm volatile("s_waitcnt vmcnt(" #n ")" ::: "memory")
#define PG8_WAIT_L(n) asm volatile("s_waitcnt lgkmcnt(" #n ")" ::: "memory")
#define PG8_BAR __builtin_amdgcn_s_barrier()
#define PG8_SCHED __builtin_amdgcn_sched_barrier(0)
    Unit cur, nxt; int ui = 0;
    if (!S.next(0, cur)) return;
    f32x4 acc[2][2][4][2];
#pragma unroll
    for (int a = 0; a < 2; ++a)
#pragma unroll
        for (int b = 0; b < 2; ++b)
#pragma unroll
            for (int m = 0; m < 4; ++m)
#pragma unroll
                for (int n = 0; n < 2; ++n) acc[a][b][m][n] = (f32x4){0.f, 0.f, 0.f, 0.f};
    bf16x8 At[4][2], B0[2][2], B1[2][2];
    const char* cA = S.ak(cur, 0); const char* cB = S.bk(cur, 0);
    PG8_STAGE(PG8_SB(0, 0), cB, voffB); PG8_STAGE(PG8_SA(0, 0), cA, voffA); PG8_STAGE(PG8_SB(0, 1), cB + hstepB, voffB); PG8_STAGE(PG8_SA(0, 1), cA + hstepA, voffA);
    if (wr == 1) PG8_BAR;
    PG8_WAIT_V(4); PG8_BAR;
    PG8_STAGE(PG8_SB(1, 0), S.bk(cur, 1), voffB); PG8_STAGE(PG8_SA(1, 0), S.ak(cur, 1), voffA); PG8_STAGE(PG8_SB(1, 1), S.bk(cur, 1) + hstepB, voffB);
    PG8_WAIT_V(6); PG8_BAR;
    for (;;) {
        const bool has_next = S.next(ui + 1, nxt);
        Unit nu; nu.pm = has_next ? nxt.pm : cur.pm; nu.pn = has_next ? nxt.pn : cur.pn; nu.aux = 0;
#pragma unroll 1
        for (int t = 0; t < nt; t += 2) {
            const bool last = (t == nt - 2);
            const char* a1 = S.ak(cur, t + 1);
            const char* a2 = last ? S.ak(nu, 0) : S.ak(cur, t + 2); const char* b2 = last ? S.bk(nu, 0) : S.bk(cur, t + 2);
            const char* a3 = last ? S.ak(nu, 1) : S.ak(cur, t + 3); const char* b3 = last ? S.bk(nu, 1) : S.bk(cur, t + 3);
            if (t != 0 && (t & 3) == 0) { int fr2 = fr, fq2 = fq; asm volatile("" : "+v"(fr2), "+v"(fq2)); E.mid(acc, cur, (t >> 2) - 1, wr, wc, fr2, fq2); }
            PG8_LDB(B0, 0, 0); PG8_SCHED; PG8_LDA(At, 0, 0); PG8_STAGE(PG8_SA(1, 1), a1 + hstepA, voffA);
            PG8_WAIT_L(8); PG8_BAR; PG8_WAIT_L(0); PG8_MMA(0, 0, At, B0); PG8_BAR; PG8_SCHED;
            PG8_LDB(B1, 0, 1); PG8_STAGE(PG8_SB(0, 0), b2, voffB);
            PG8_BAR; PG8_WAIT_L(0); PG8_MMA(0, 1, At, B1); PG8_BAR;
            PG8_LDA(At, 0, 1); PG8_STAGE(PG8_SA(0, 0), a2, voffA);
            PG8_BAR; PG8_WAIT_L(0); PG8_MMA(1, 0, At, B0); PG8_BAR; PG8_SCHED;
            PG8_STAGE(PG8_SB(0, 1), b2 + hstepB, voffB);
            PG8_WAIT_V(6); PG8_BAR; PG8_MMA(1, 1, At, B1); PG8_BAR;
            PG8_LDB(B0, 1, 0); PG8_SCHED; PG8_LDA(At, 1, 0); PG8_STAGE(PG8_SA(0, 1), a2 + hstepA, voffA);
            PG8_WAIT_L(8); PG8_BAR; PG8_WAIT_L(0); PG8_MMA(0, 0, At, B0); PG8_BAR; PG8_SCHED;
            PG8_LDB(B1, 1, 1); PG8_STAGE(PG8_SB(1, 0), b3, voffB);
            PG8_BAR; PG8_WAIT_L(0); PG8_MMA(0, 1, At, B1); PG8_BAR;
            PG8_LDA(At, 1, 1); PG8_STAGE(PG8_SA(1, 0), a3, voffA);
            PG8_BAR; PG8_WAIT_L(0); PG8_MMA(1, 0, At, B0); PG8_BAR; PG8_SCHED;
            PG8_STAGE(PG8_SB(1, 1), b3 + hstepB, voffB);
            PG8_WAIT_V(6); PG8_BAR; PG8_MMA(1, 1, At, B1); PG8_BAR;
        }
        { int fr2 = fr, fq2 = fq; asm volatile("" : "+v"(fr2), "+v"(fq2));
          E(acc, cur, wr, wc, fr2, fq2); }
        if (!has_next) break;
#pragma unroll
        for (int a = 0; a < 2; ++a)
#pragma unroll
            for (int b = 0; b < 2; ++b)
#pragma unroll
                for (int m = 0; m < 4; ++m)
#pragma unroll
                    for (int n = 0; n < 2; ++n) acc[a][b][m][n] = (f32x4){0.f, 0.f, 0.f, 0.f};
        cur = nxt; ++ui;
    }
    PG8_WAIT_V(0);
    if (wr == 0) PG8_BAR;
    PG8_BAR;
#undef PG8_SA
#undef PG8_SB
#undef PG8_STAGE
#undef PG8_LDA
#undef PG8_LDB
#undef PG8_MMA
#undef PG8_WAIT_V
#undef PG8_WAIT_L
#undef PG8_BAR
#undef PG8_SCHED
}


struct SchedPlain {
    const char* A; const char* B; int lda, ldb, nM, nN, G, c, pm0;
    DI bool next(int i, Unit& u) const { const long L = (long)i * G + c; if (L >= (long)nM * nN) return false; tile_of((int)L, nM, nN, u.pm, u.pn); u.pm += pm0; u.aux = 0; return true; }
    DI const char* abase(const Unit& u) const { return A + (size_t)u.pm * 256 * lda * 2; }
    DI const char* bbase(const Unit& u) const { return B + (size_t)u.pn * 256 * ldb * 2; }
};
struct SchedMerge {
    const char* Z; const char* Wb; int nM, G, c, pm0;
    DI bool next(int i, Unit& u) const { const long L = (long)(i >> 2) * G + c; if (L >= (long)nM * 4) return false; tile_of((int)L, nM, 4, u.pm, u.pn); u.pm += pm0; u.aux = i & 3; return true; }
    DI const char* abase(const Unit& u) const { const int co = u.aux == 0 ? ZA_Q : (u.aux == 1 ? ZB_Q : (u.aux == 2 ? ZC_Q : ZD_Q)); return Z + ((size_t)u.pm * 256 * NZ + co) * 2; }
    DI const char* bbase(const Unit& u) const { return Wb + ((size_t)u.aux * 1024 * 256 + (size_t)u.pn * 256 * 256) * 2; }
};
struct SchedSeg {
    const char* Z; const char* Wb; int nM, G, c, pm0;
    DI bool next(int i, Unit& u) const { const long L = (long)i * G + c; if (L >= (long)nM * 4) return false; tile_of((int)L, nM, 4, u.pm, u.pn); u.pm += pm0; u.aux = 0; return true; }
    DI const char* ak(const Unit& u, const int kt) const { const int sg = kt >> 2; const int co = sg == 0 ? ZA_Q : (sg == 1 ? ZB_Q : (sg == 2 ? ZC_Q : ZD_Q)); return Z + ((size_t)u.pm * 256 * NZ + co + (kt & 3) * 64) * 2; }
    DI const char* bk(const Unit& u, const int kt) const { return Wb + ((size_t)(kt >> 2) * 1024 * 256 + (size_t)u.pn * 256 * 256 + (kt & 3) * 64) * 2; }
};
template <bool PLAIN> struct SchedMoeT {
    const char* B; int ldb, nP, nN, G, c; size_t estride; const LAS unsigned char* pe; const LAS unsigned* off; const int* list; const unsigned* cnt; int sh_r, sh_l;
    DI bool next(int i, Unit& u) const { const long L = (long)i * G + c; if (L >= (long)nP * nN) return false; u.pm = (int)(L / nN); u.pn = (int)(L % nN); u.aux = pe[u.pm]; return true; }
    DI const char* bbase(const Unit& u) const { return B + (size_t)u.aux * estride + (size_t)u.pn * 256 * ldb * 2; }
    DI void rowoff(const Unit& u, const int R0, const int C0, const int R1, const int C1, unsigned& v00, unsigned& v01, unsigned& v10, unsigned& v11) const {
        if (PLAIN) { const unsigned b = (unsigned)u.pm * 256u; v00 = ((b + R0) << sh_l) + C0 * 2; v01 = ((b + R1) << sh_l) + C1 * 2; v10 = ((b + 128 + R0) << sh_l) + C0 * 2; v11 = ((b + 128 + R1) << sh_l) + C1 * 2; return; }
        const int j0 = (u.pm - (int)(off[u.aux] >> 8)) * 256; const int n = (int)cnt[u.aux]; const int* lp = list + (size_t)u.aux * MOE_CAP;
        const int p00 = j0 + R0, p01 = j0 + R1, p10 = j0 + 128 + R0, p11 = j0 + 128 + R1;
        const unsigned i00 = p00 < n ? (unsigned)lp[p00] : 0u, i01 = p01 < n ? (unsigned)lp[p01] : 0u, i10 = p10 < n ? (unsigned)lp[p10] : 0u, i11 = p11 < n ? (unsigned)lp[p11] : 0u;
        v00 = ((i00 >> sh_r) << sh_l) + C0 * 2; v01 = ((i01 >> sh_r) << sh_l) + C1 * 2; v10 = ((i10 >> sh_r) << sh_l) + C0 * 2; v11 = ((i11 >> sh_r) << sh_l) + C1 * 2; }
};

#define EPI_ARGS const f32x4 (&acc)[2][2][4][2], const Unit& u, int wr, int wc, int fr, int fq
struct EpiZ { static constexpr bool PERM = true; bf16_t* Z;
    DI void operator()(EPI_ARGS) const {
        const int row0 = u.pm * 256 + wr * 64 + fr, col0 = u.pn * 256 + wc * 32 + 8 * fq;
#pragma unroll
        for (int ai = 0; ai < 2; ++ai)
#pragma unroll
            for (int m = 0; m < 4; ++m) { bf16_t* rp = Z + (size_t)(row0 + ai * 128 + m * 16) * NZ + col0;
#pragma unroll
                for (int bj = 0; bj < 2; ++bj) { const f32x4 v0 = acc[ai][bj][m][0], v1 = acc[ai][bj][m][1];
                    u32x4 w; w.x = pk2(v0[0], v0[1]); w.y = pk2(v0[2], v0[3]); w.z = pk2(v1[0], v1[1]); w.w = pk2(v1[2], v1[3]);
                    *(u32x4*)(rp + bj * 128) = w; } }
    } };
struct EpiMla { static constexpr bool PERM = true; bf16_t* QC; bf16_t* KC; bf16_t* CVt;
    DI void operator()(const f32x4 (&acc)[2][2][4][2], const Unit& u, int wr, int wc, int fr_in, int fq_in) const {
        int fr = fr_in, fq = fq_in; asm volatile("" : "+v"(fr), "+v"(fq));
#pragma unroll
        for (int ai = 0; ai < 2; ++ai)
#pragma unroll
            for (int m = 0; m < 4; ++m) {
                const int row = u.pm * 256 + wr * 64 + fr + ai * 128 + m * 16; int b, key; row_bk(row, b, key);
#pragma unroll
                for (int bj = 0; bj < 2; ++bj) {
                    const int c = u.pn * 256 + bj * 128 + wc * 32 + 8 * fq;
                    const f32x4 v0 = acc[ai][bj][m][0], v1 = acc[ai][bj][m][1];
                    float v[8] = {v0[0], v0[1], v0[2], v0[3], v1[0], v1[1], v1[2], v1[3]};
                    if (c < 384) {
                        u32x4 w; w.x = pk2(v[0], v[1]); w.y = pk2(v[2], v[3]); w.z = pk2(v[4], v[5]); w.w = pk2(v[6], v[7]);
                        *(u32x4*)(QC + (size_t)row * 384 + c) = w;
                    } else if (c < 896) {
                        const int c2 = c - 384, hh = c2 >> 7, j = c2 & 127;
                        if (j < 64) { u32x4 w; w.x = pk2(v[0], v[1]); w.y = pk2(v[2], v[3]); w.z = pk2(v[4], v[5]); w.w = pk2(v[6], v[7]);
                            *(u32x4*)(KC + ((size_t)(b * 4 + hh) * KEYS + key) * 160 + j) = w; }
                        else { u32x4 w; w.x = pk2(v[0], v[1]); w.y = pk2(v[2], v[3]); w.z = pk2(v[4], v[5]); w.w = pk2(v[6], v[7]);
                            *(u32x4*)(KC + ((size_t)(b * 4 + hh) * KEYS + key) * 160 + 96 + (j - 64)) = w; }
                    }
                }
                __builtin_amdgcn_sched_barrier(0);
            }
    } };
struct EpiGate { static constexpr bool PERM = true; unsigned char* G;
    DI void operator()(EPI_ARGS) const {
        const int row0 = u.pm * 256 + wr * 64 + fr, col0 = u.pn * 256 + wc * 32 + 8 * fq;
#pragma unroll
        for (int ai = 0; ai < 2; ++ai)
#pragma unroll
            for (int m = 0; m < 4; ++m) { unsigned char* rp = G + (size_t)(row0 + ai * 128 + m * 16) * 4096 + col0;
#pragma unroll
                for (int bj = 0; bj < 2; ++bj) { const f32x4 v0 = acc[ai][bj][m][0], v1 = acc[ai][bj][m][1];
                    auto q = [](float x) { return fmaxf(255.f * sigmoidf_(x), 1.f); };
                    u32x2 w; w.x = 0u; w.y = 0u;
#pragma unroll
                    for (int j = 0; j < 4; ++j) { w.x = __builtin_amdgcn_cvt_pk_u8_f32(q(v0[j]), j, w.x); w.y = __builtin_amdgcn_cvt_pk_u8_f32(q(v1[j]), j, w.y); }
                    *(u32x2*)(rp + bj * 128) = w; } }
    } };
struct EpiMerge { static constexpr bool PERM = true; bf16_t* Z; const bf16_t* G; int row_base;
    DI void operator()(EPI_ARGS) const {
        const int row0 = u.pm * 256 + wr * 64 + fr, col0 = u.pn * 256 + wc * 32 + 8 * fq;
#pragma unroll
        for (int ai = 0; ai < 2; ++ai) {
            u32x4 g[4][2], y[4][2];
#pragma unroll
            for (int m = 0; m < 4; ++m) { const int row = row0 + ai * 128 + m * 16;
                const bf16_t* yp = Z + (size_t)row * NZ + ZY + col0; const bf16_t* gp = G + (size_t)(row - row_base) * 4096 + u.aux * 1024 + col0;
#pragma unroll
                for (int bj = 0; bj < 2; ++bj) { g[m][bj] = *(const u32x4*)(gp + bj * 128); y[m][bj] = (u32x4){0u, 0u, 0u, 0u}; if (u.aux != 0) y[m][bj] = *(const u32x4*)(yp + bj * 128); } }
#pragma unroll
            for (int m = 0; m < 4; ++m) { const int row = row0 + ai * 128 + m * 16; bf16_t* yp = Z + (size_t)row * NZ + ZY + col0;
#pragma unroll
                for (int bj = 0; bj < 2; ++bj) { const f32x4 v0 = acc[ai][bj][m][0], v1 = acc[ai][bj][m][1]; const u32x4 gg = g[m][bj], yy = y[m][bj];
                    u32x4 w;
                    w.x = pk2(bflo(yy.x) + bflo(gg.x) * v0[0], bfhi(yy.x) + bfhi(gg.x) * v0[1]); w.y = pk2(bflo(yy.y) + bflo(gg.y) * v0[2], bfhi(yy.y) + bfhi(gg.y) * v0[3]);
                    w.z = pk2(bflo(yy.z) + bflo(gg.z) * v1[0], bfhi(yy.z) + bfhi(gg.z) * v1[1]); w.w = pk2(bflo(yy.w) + bflo(gg.w) * v1[2], bfhi(yy.w) + bfhi(gg.w) * v1[3]);
                    *(u32x4*)(yp + bj * 128) = w; } }
        }
    } };
struct EpiHorner { static constexpr bool PERM = true; bf16_t* Z; const unsigned char* G;
    DI void mid(f32x4 (&acc)[2][2][4][2], const Unit& u, const int seg, int wr, int wc, int fr, int fq) const {
        const int row0 = u.pm * 256 + wr * 64 + fr, col0 = u.pn * 256 + wc * 32 + 8 * fq;
        u32x2 gc[2][4][2], gn[2][4][2];
#pragma unroll
        for (int ai = 0; ai < 2; ++ai)
#pragma unroll
            for (int m = 0; m < 4; ++m) { const unsigned char* gp = G + (size_t)(row0 + ai * 128 + m * 16) * 4096 + seg * 1024 + col0;
#pragma unroll
                for (int bj = 0; bj < 2; ++bj) { gc[ai][m][bj] = *(const u32x2*)(gp + bj * 128); gn[ai][m][bj] = *(const u32x2*)(gp + 1024 + bj * 128); } }
#pragma unroll
        for (int ai = 0; ai < 2; ++ai)
#pragma unroll
            for (int m = 0; m < 4; ++m)
#pragma unroll
                for (int bj = 0; bj < 2; ++bj) { const u32x2 c2 = gc[ai][m][bj], n2 = gn[ai][m][bj];
#pragma unroll
                    for (int j = 0; j < 4; ++j) {
                        acc[ai][bj][m][0][j] *= (float)((c2.x >> (8 * j)) & 255u) * __builtin_amdgcn_rcpf((float)((n2.x >> (8 * j)) & 255u));
                        acc[ai][bj][m][1][j] *= (float)((c2.y >> (8 * j)) & 255u) * __builtin_amdgcn_rcpf((float)((n2.y >> (8 * j)) & 255u)); } }
    }
    DI void operator()(EPI_ARGS) const {
        const int row0 = u.pm * 256 + wr * 64 + fr, col0 = u.pn * 256 + wc * 32 + 8 * fq;
#pragma unroll
        for (int ai = 0; ai < 2; ++ai) {
            u32x2 g[4][2];
#pragma unroll
            for (int m = 0; m < 4; ++m)
#pragma unroll
                for (int bj = 0; bj < 2; ++bj) g[m][bj] = *(const u32x2*)(G + (size_t)(row0 + ai * 128 + m * 16) * 4096 + 3 * 1024 + col0 + bj * 128);
#pragma unroll
            for (int m = 0; m < 4; ++m) { bf16_t* yp = Z + (size_t)(row0 + ai * 128 + m * 16) * NZ + ZY + col0;
#pragma unroll
                for (int bj = 0; bj < 2; ++bj) { const f32x4 v0 = acc[ai][bj][m][0], v1 = acc[ai][bj][m][1]; const u32x2 gg = g[m][bj]; const float k = 1.f / 255.f;
                    u32x4 w; w.x = pk2((float)(gg.x & 255u) * k * v0[0], (float)((gg.x >> 8) & 255u) * k * v0[1]); w.y = pk2((float)((gg.x >> 16) & 255u) * k * v0[2], (float)(gg.x >> 24) * k * v0[3]);
                    w.z = pk2((float)(gg.y & 255u) * k * v1[0], (float)((gg.y >> 8) & 255u) * k * v1[1]); w.w = pk2((float)((gg.y >> 16) & 255u) * k * v1[2], (float)(gg.y >> 24) * k * v1[3]);
                    *(u32x4*)(yp + bj * 128) = w; } }
        }
    } };
struct EpiOut { static constexpr bool PERM = false; const float* res_l; const float* res_c; float* xs_l; float* xs_c; const float* modv_l;
    DI void operator()(EPI_ARGS) const {
        const int row0 = u.pm * 256 + wr * 64 + fr, col0 = u.pn * 256 + wc * 32 + 4 * fq;
        const bool lat = u.pm < ML / 256; const int bsel = lat ? (u.pm >> 4) : 8;
        const float* gp = modv_l + (bsel * 6 + 2) * 1024 + col0;
        f32x4 gt[2][2];
#pragma unroll
        for (int bj = 0; bj < 2; ++bj)
#pragma unroll
            for (int n = 0; n < 2; ++n) gt[bj][n] = *(const f32x4*)(gp + bj * 128 + n * 16);
#pragma unroll
        for (int ai = 0; ai < 2; ++ai) {
            f32x4 rs[4][2][2];
#pragma unroll
            for (int m = 0; m < 4; ++m) { const int row = row0 + ai * 128 + m * 16; const size_t ro = lat ? (size_t)row * 1024 : (size_t)(row - ML) * 1024;
                const float* rp = (lat ? res_l : res_c) + ro + col0;
#pragma unroll
                for (int bj = 0; bj < 2; ++bj)
#pragma unroll
                    for (int n = 0; n < 2; ++n) rs[m][bj][n] = *(const f32x4*)(rp + bj * 128 + n * 16); }
#pragma unroll
            for (int m = 0; m < 4; ++m) { const int row = row0 + ai * 128 + m * 16; const size_t ro = lat ? (size_t)row * 1024 : (size_t)(row - ML) * 1024;
                float* xp = (lat ? xs_l : xs_c) + ro + col0;
#pragma unroll
                for (int bj = 0; bj < 2; ++bj)
#pragma unroll
                    for (int n = 0; n < 2; ++n) *(f32x4*)(xp + bj * 128 + n * 16) = rs[m][bj][n] + gt[bj][n] * acc[ai][bj][m][n]; }
        }
    } };
struct EpiMoeUp { static constexpr bool PERM = true; bf16_t* H; const LAS unsigned* off; const unsigned* cnt;
    DI void operator()(EPI_ARGS) const {
        const int j0 = (u.pm - (int)(off[u.aux] >> 8)) * 256 + wr * 64 + fr, h0 = (u.pn * 256 + wc * 32 + 8 * fq) >> 1; const int n = (int)cnt[u.aux];
        bf16_t* hb = H + (size_t)(u.pm * 256 + wr * 64 + fr) * 256 + h0;
#pragma unroll
        for (int ai = 0; ai < 2; ++ai)
#pragma unroll
            for (int m = 0; m < 4; ++m) if (j0 + ai * 128 + m * 16 < n) { bf16_t* hp = hb + (size_t)(ai * 128 + m * 16) * 256;
#pragma unroll
                for (int bj = 0; bj < 2; ++bj) { const f32x4 g = acc[ai][bj][m][0], up = acc[ai][bj][m][1];
                    u32x2 w; w.x = pk2(g[0] * sigmoidf_(g[0]) * up[0], g[1] * sigmoidf_(g[1]) * up[1]); w.y = pk2(g[2] * sigmoidf_(g[2]) * up[2], g[3] * sigmoidf_(g[3]) * up[3]);
                    *(u32x2*)(hp + bj * 64) = w; } }
    } };
struct EpiMoeDown { static constexpr bool PERM = true; bf16_t* Y; const LAS unsigned* off; const int* list; const unsigned* cnt; const float* listw;
    DI void operator()(EPI_ARGS) const {
        const int j0 = (u.pm - (int)(off[u.aux] >> 8)) * 256 + wr * 64 + fr, col0 = u.pn * 256 + wc * 32 + 8 * fq; const int n = (int)cnt[u.aux]; const int* lp = list + (size_t)u.aux * MOE_CAP; const float* lp_w = listw + (size_t)u.aux * MOE_CAP;
        int it[2][4]; float wt8[2][4];
#pragma unroll
        for (int ai = 0; ai < 2; ++ai)
#pragma unroll
            for (int m = 0; m < 4; ++m) { const int pos = j0 + ai * 128 + m * 16; it[ai][m] = pos < n ? lp[pos] : -1; wt8[ai][m] = pos < n ? lp_w[pos] : 0.f; }
#pragma unroll
        for (int ai = 0; ai < 2; ++ai)
#pragma unroll
            for (int m = 0; m < 4; ++m) if (it[ai][m] >= 0) { const int ri = it[ai][m]; const float w8 = wt8[ai][m]; bf16_t* yp = Y + ((size_t)(ri & 1) * MT + (ri >> 1)) * 1024 + col0;
#pragma unroll
                for (int bj = 0; bj < 2; ++bj) { const f32x4 v0 = acc[ai][bj][m][0] * w8, v1 = acc[ai][bj][m][1] * w8;
                    u32x4 w; w.x = pk2(v0[0], v0[1]); w.y = pk2(v0[2], v0[3]); w.z = pk2(v1[0], v1[1]); w.w = pk2(v1[2], v1[3]);
                    *(u32x4*)(yp + bj * 128) = w; } }
    } };
}

DI void phase_pre(const Params& p, ldsp lds) {
    float* modv = (float*)(p.ws + WS_MODV);
    LAS float* sc = (LAS float*)lds;
    LAS float* red = (LAS float*)(lds + 9 * 1024 * 4);
    const int tid = tid_now();
    for (int i = tid; i < 9 * 1024; i += 512) { const int r = i >> 10, k = i & 1023; const float v = r < 8 ? p.in[1][r * 1024 + k] : p.in[3][k]; sc[i] = v / (1.f + __expf(-v)); }
    __syncthreads();
    const int kg = tid >> 6, col = tid & 63;
    for (int u = bid_now(); u < 192; u += gdim_now()) {
        const int li = u / 96, j = (u % 96) * 64 + col;
        const float* w = p.in[4] + (size_t)li * 1024 * 6144 + j;
        float acc[9];
#pragma unroll
        for (int r = 0; r < 9; ++r) acc[r] = 0.f;
        for (int k = kg * 128; k < kg * 128 + 128; ++k) { const float wv = w[(size_t)k * 6144];
#pragma unroll
            for (int r = 0; r < 9; ++r) acc[r] += sc[r * 1024 + k] * wv; }
#pragma unroll
        for (int r = 0; r < 9; ++r) red[(kg * 9 + r) * 64 + col] = acc[r];
        __syncthreads();
        if (tid < 64) {
#pragma unroll
            for (int r = 0; r < 9; ++r) { float s = 0.f;
#pragma unroll
                for (int g = 0; g < 8; ++g) s += red[(g * 9 + r) * 64 + col];
                modv[(li * 9 + r) * 6144 + j] = s + p.in[5][li * 6144 + j]; } }
        __syncthreads();
    }
    if (bid_now() == gdim_now() - 1) {
        f32x2* cs16 = (f32x2*)(p.ws + WS_ROPE16); f32x2* cs8 = (f32x2*)(p.ws + WS_ROPE8);
        for (int i = tid; i < 64 * 16 + 64 * 8; i += 512) {
            const bool a = i < 1024; const int ii = a ? i : i - 1024; const int pos = a ? ii >> 4 : ii >> 3, f = a ? ii & 15 : ii & 7;
            const float inv = exp2f(-(float)f * (13.287712379549449f / (a ? 16.f : 8.f)));
            const float x = (float)pos * inv; const float n = rintf(x * 0.15915494309189535f);
            float r = fmaf(-n, 6.2831855f, x); r = fmaf(-n, -1.7484555e-7f, r);
            const f32x2 cs = {__cosf(r), __sinf(r)};
            if (a) cs16[ii] = cs; else cs8[ii] = cs;
        }
        if (tid == 64) { const float** tab = (const float**)(p.ws + WS_TAB);
#pragma unroll
            for (int i = 0; i < 29; ++i) tab[i] = p.in[i]; }
        if (tid < 2) { const float* lp = p.in[19] + tid * 128; float s1 = 0.f, s2 = 0.f;
            for (int i = 0; i < 32; ++i) { s1 += lp[i] * lp[32 + i]; s2 += lp[64 + i] * lp[96 + i]; }
            const float lam_init = 0.8f - 0.6f * expf(-0.3f * (float)tid);
            float* lamv = (float*)(p.ws + WS_LAM); lamv[tid * 2] = expf(s1) - expf(s2) + lam_init; lamv[tid * 2 + 1] = lam_init; }
    }
}

template <class DM> DI void conv_tiles(ldsp lds, const float* W0, const int ldw, const int Kd, const int Ncols, bf16_t* Wt0, const int ldt, const int koff, DM dmap, const int nb = 1, const size_t wstride = 0, const size_t tstride = 0) {
    const int tid = tid_now(); LAS bf16_t* T = (LAS bf16_t*)lds;
    const int ntn = (Ncols + 63) >> 6, ntk = Kd >> 6;
    for (int tt = bid_now(); tt < nb * ntn * ntk; tt += gdim_now()) {
        const int bi = tt / (ntn * ntk), t = tt - bi * (ntn * ntk); const float* W = W0 + (size_t)bi * wstride; bf16_t* Wt = Wt0 + (size_t)bi * tstride;
        const int n0 = (t % ntn) * 64, k0 = (t / ntn) * 64;
        { const int kk = tid >> 3, nn = (tid & 7) * 8; float v[8];
          if (n0 + nn + 8 <= Ncols) { const f32x4 a = *(const f32x4*)(W + (size_t)(k0 + kk) * ldw + n0 + nn), c = *(const f32x4*)(W + (size_t)(k0 + kk) * ldw + n0 + nn + 4);
              v[0] = a[0]; v[1] = a[1]; v[2] = a[2]; v[3] = a[3]; v[4] = c[0]; v[5] = c[1]; v[6] = c[2]; v[7] = c[3]; }
          else {
#pragma unroll
              for (int j = 0; j < 8; ++j) v[j] = 0.f; }
#pragma unroll
          for (int j = 0; j < 8; ++j) T[(nn + j) * 72 + kk] = f2bf(v[j]); }
        __syncthreads();
        { const int n = tid >> 3, k8 = (tid & 7) * 8;
          if (n0 + n < Ncols) { const u32x4 w = *(const LAS u32x4*)(T + n * 72 + k8); *(u32x4*)(Wt + (size_t)dmap(n0 + n) * ldt + koff + k0 + k8) = w; } }
        __syncthreads();
    }
}
DI void zero_rows(bf16_t* Wt, const int ldt, const int r0, const int nr, const int c0, const int nc) {
    const int per = nc >> 3;
    unsigned z = 0u; asm volatile("" : "+v"(z));
    const u32x4 zz = {z, z, z, z};
    for (int i = bid_now() * 512 + tid_now(); i < nr * per; i += gdim_now() * 512) { const int r = i / per, c8 = (i - r * per) * 8; *(u32x4*)(Wt + (size_t)(r0 + r) * ldt + c0 + c8) = zz; }
}
DI void phase_wconv(const Ctx& p, const int li, ldsp lds) {
    unsigned char* wt = p.ws + WS_WT; auto id = [](int n) { return n; };
    conv_tiles(lds, p.in[8] + (size_t)li * 1024 * 2976, 2976, 1024, 2976, (bf16_t*)(wt + WT_IN), 1024, 0, id);
    zero_rows((bf16_t*)(wt + WT_IN), 1024, 2976, NZ - 2976, 0, 1024);
    conv_tiles(lds, p.in[9] + (size_t)li * 1024 * 4096, 4096, 1024, 4096, (bf16_t*)(wt + WT_G), 1024, 0, id);
    conv_tiles(lds, p.in[10] + (size_t)li * 4 * 256 * 1024, 1024, 256, 1024, (bf16_t*)(wt + WT_B), 256, 0, id, 4, (size_t)256 * 1024, (size_t)1024 * 256);
    conv_tiles(lds, p.in[11] + (size_t)li * 1024 * 1024, 1024, 1024, 1024, (bf16_t*)(wt + WT_O), 1024, 0, id);
    conv_tiles(lds, p.in[17] + (size_t)li * 256 * 384, 384, 256, 384, (bf16_t*)(wt + WT_MLA), 384, 0, id);
    conv_tiles(lds, p.in[18] + (size_t)li * 128 * 512, 512, 128, 512, (bf16_t*)(wt + WT_MLA), 384, 256, [](int n) { return 384 + n; });
    zero_rows((bf16_t*)(wt + WT_MLA), 384, 0, 384, 256, 128); zero_rows((bf16_t*)(wt + WT_MLA), 384, 384, 512, 0, 256); zero_rows((bf16_t*)(wt + WT_MLA), 384, 896, 128, 0, 384);
    conv_tiles(lds, p.in[25] + (size_t)li * 32 * 1024 * 256, 256, 1024, 256, (bf16_t*)(wt + WT_E1), 1024, 0, [](int hc) { return (hc >> 2) * 8 + (hc & 3); }, 32, (size_t)1024 * 256, (size_t)512 * 1024);
    conv_tiles(lds, p.in[26] + (size_t)li * 32 * 1024 * 256, 256, 1024, 256, (bf16_t*)(wt + WT_E1), 1024, 0, [](int hc) { return (hc >> 2) * 8 + 4 + (hc & 3); }, 32, (size_t)1024 * 256, (size_t)512 * 1024);
    conv_tiles(lds, p.in[27] + (size_t)li * 32 * 256 * 1024, 1024, 256, 1024, (bf16_t*)(wt + WT_E2), 256, 0, id, 32, (size_t)256 * 1024, (size_t)1024 * 256);
}

template <int MODE> DI void phase_norm(const Ctx& p, const int li) {
    const int lane = tid_now() & 63, wave = tid_now() >> 6;
    const int nrows = MODE == 2 ? ML : MT;
    const float* modv = (const float*)(p.ws + WS_MODV);
    float* ctxs = (float*)(p.ws + WS_CTXS); bf16_t* HB = (bf16_t*)(p.ws + WS_HB); const bf16_t* Y = (const bf16_t*)(p.ws + WS_Y);
    const bool combine = (MODE == 2) || (li > 0);
    const int lprev = MODE == 2 ? 1 : li - 1;
    const float* gain = MODE == 2 ? p.in[28] : p.in[6] + li * 1024;
    const int rpw = (nrows + gdim_now() * 8 - 1) / (gdim_now() * 8), r0w = (bid_now() * 8 + wave) * rpw, r1w = r0w + rpw < nrows ? r0w + rpw : nrows;
    int cur_b = -1; f32x4 gs[4], s0v[4], g2v[4];
#pragma unroll
    for (int i = 0; i < 4; ++i) { gs[i] = (f32x4){0.f, 0.f, 0.f, 0.f}; s0v[i] = gs[i]; g2v[i] = gs[i]; }
    for (int row = r0w; row < r1w; ++row) {
        const bool lat = row < ML; const int bsel = lat ? (row >> 12) : 8;
        float* xs = lat ? p.out + (size_t)row * 1024 : ctxs + (size_t)(row - ML) * 1024;
        const float* src = combine ? xs : (lat ? p.in[0] + (size_t)row * 1024 : p.in[2] + (size_t)(row - ML) * 1024);
        f32x4 v[4]; u32x2 y0[4], y1[4];
#pragma unroll
        for (int i = 0; i < 4; ++i) { const int col = i * 256 + lane * 4; v[i] = *(const f32x4*)(src + col);
            if (combine) { y0[i] = *(const u32x2*)(Y + (size_t)row * 1024 + col); y1[i] = *(const u32x2*)(Y + ((size_t)MT + row) * 1024 + col); } }
        if (bsel != cur_b) { cur_b = bsel;
#pragma unroll
            for (int i = 0; i < 4; ++i) { const int col = i * 256 + lane * 4;
                if (MODE == 2) gs[i] = *(const f32x4*)(gain + col);
                else { gs[i] = *(const f32x4*)(gain + col) * (*(const f32x4*)(modv + ((li * 9 + bsel) * 6 + 1) * 1024 + col) + 1.f); s0v[i] = *(const f32x4*)(modv + ((li * 9 + bsel) * 6 + 0) * 1024 + col); }
                if (combine) g2v[i] = *(const f32x4*)(modv + ((lprev * 9 + bsel) * 6 + 5) * 1024 + col); } }
        if (combine) {
#pragma unroll
            for (int i = 0; i < 4; ++i) { const int col = i * 256 + lane * 4; const f32x4 g = g2v[i];
                v[i][0] += g[0] * (bflo(y0[i].x) + bflo(y1[i].x)); v[i][1] += g[1] * (bfhi(y0[i].x) + bfhi(y1[i].x));
                v[i][2] += g[2] * (bflo(y0[i].y) + bflo(y1[i].y)); v[i][3] += g[3] * (bfhi(y0[i].y) + bfhi(y1[i].y));
                if (MODE == 0) *(f32x4*)(xs + col) = v[i]; }
        }
        float ss = 0.f;
#pragma unroll
        for (int i = 0; i < 4; ++i) ss += v[i][0] * v[i][0] + v[i][1] * v[i][1] + v[i][2] * v[i][2] + v[i][3] * v[i][3];
        ss = wave_sum(ss);
        const float rstd = rsqrtf(ss * (1.f / 1024.f) + NORM_EPS);
        if (MODE == 2) {
#pragma unroll
            for (int i = 0; i < 4; ++i) { const int col = i * 256 + lane * 4; f32x4 o = v[i] * rstd * gs[i];
#ifdef STAMP_A
                { const float* tv = (const float*)(p.ws + WS_LAM + 64); if (row == 0 && col == 0) o[0] += tv[1] * 0.05f; }
#endif
                *(f32x4*)(xs + col) = o; }
        } else {
#pragma unroll
            for (int i = 0; i < 4; ++i) { const int col = i * 256 + lane * 4;
                const f32x4 h = v[i] * rstd * gs[i] + s0v[i];
                u32x2 w; w.x = pk2(h[0], h[1]); w.y = pk2(h[2], h[3]); *(u32x2*)(HB + (size_t)row * 1024 + col) = w; }
        }
    }
}

DI void phase_norm2(const Ctx& p, const int li, ldsp lds, const int dry = 0) {
    const int tid = tid_now(), lane = tid & 63, wave = tid >> 6;
    const int nrows = li == 0 ? MT : ML;
    const float* modv = (const float*)(p.ws + WS_MODV);
    const float* ctxs = (const float*)(p.ws + WS_CTXS); bf16_t* HB = (bf16_t*)(p.ws + WS_HB);
    unsigned* cnt = (unsigned*)(p.ws + WS_CTL + CTL_CNT) + li * 32;
    int* list = (int*)(p.ws + WS_XG); float* listw = (float*)(p.ws + WS_XG) + (size_t)32 * MOE_CAP;
    constexpr int RWS = 1028;
    LAS float* rw = (LAS float*)lds;
    const float* wrg = p.in[21] + (size_t)li * 1024 * 4; const float* wre = p.in[23] + (size_t)li * 1024 * 32;
    for (int i = tid; i < 4 * 1024; i += 512) rw[(i & 3) * RWS + (i >> 2)] = wrg[i];
    for (int i = tid; i < 32 * 1024; i += 512) rw[(4 + (i & 31)) * RWS + (i >> 5)] = wre[i];
    LAS unsigned* lcnt = (LAS unsigned*)(lds + 148480); LAS unsigned* lbase = lcnt + 32; LAS int* rec = (LAS int*)(lcnt + 64);
    if (tid < 32) lcnt[tid] = 0u;
    __syncthreads();
    const float* gain = p.in[7] + li * 1024;
    LAS float* bias = (LAS float*)(rec + 144 * 8);
    if (tid < 4) bias[tid] = p.in[22][li * 4 + tid]; else if (tid < 36) bias[tid] = p.in[24][li * 32 + tid - 4];
    __syncthreads();
    const int rpw = (nrows + gdim_now() * 8 - 1) / (gdim_now() * 8), r0w = (bid_now() * 8 + wave) * rpw, r1w = r0w + rpw < nrows ? r0w + rpw : nrows;
    int cur_b = -1; f32x4 gs[4], s0v[4];
#pragma unroll
    for (int i = 0; i < 4; ++i) { gs[i] = (f32x4){0.f, 0.f, 0.f, 0.f}; s0v[i] = gs[i]; }
    f32x4 vn[4];
    { const int rw0 = r0w < nrows ? r0w : nrows - 1; const float* xs0 = rw0 < ML ? p.out + (size_t)rw0 * 1024 : ctxs + (size_t)(rw0 - ML) * 1024;
#pragma unroll
      for (int i = 0; i < 4; ++i) vn[i] = *(const f32x4*)(xs0 + i * 256 + lane * 4); }
    for (int row = r0w; row < r1w; ++row) {
        const bool lat = row < ML; const int bsel = lat ? (row >> 12) : 8;
        f32x4 v[4];
#pragma unroll
        for (int i = 0; i < 4; ++i) v[i] = vn[i];
        { const int rn = row + 1 < r1w ? row + 1 : row; const float* xsn = rn < ML ? p.out + (size_t)rn * 1024 : ctxs + (size_t)(rn - ML) * 1024;
#pragma unroll
          for (int i = 0; i < 4; ++i) vn[i] = *(const f32x4*)(xsn + i * 256 + lane * 4); }
        if (bsel != cur_b) { cur_b = bsel; const float* sh = modv + ((li * 9 + bsel) * 6 + 3) * 1024; const float* scl = modv + ((li * 9 + bsel) * 6 + 4) * 1024;
#pragma unroll
            for (int i = 0; i < 4; ++i) { const int col = i * 256 + lane * 4; gs[i] = *(const f32x4*)(gain + col) * (*(const f32x4*)(scl + col) + 1.f); s0v[i] = *(const f32x4*)(sh + col); } }
        float ss = 0.f;
#pragma unroll
        for (int i = 0; i < 4; ++i) ss += v[i][0] * v[i][0] + v[i][1] * v[i][1] + v[i][2] * v[i][2] + v[i][3] * v[i][3];
        ss = wave_sum(ss);
        const float rstd = rsqrtf(ss * (1.f / 1024.f) + NORM_EPS);
#pragma unroll
        for (int i = 0; i < 4; ++i) { const int col = i * 256 + lane * 4;
            v[i] = v[i] * rstd * gs[i] + s0v[i];
            u32x2 w; w.x = pk2(v[i][0], v[i][1]); w.y = pk2(v[i][2], v[i][3]); *(u32x2*)(HB + (size_t)row * 1024 + col) = w; }
        float lg[4];
#pragma unroll
        for (int e = 0; e < 4; ++e) { float s = 0.f;
#pragma unroll
            for (int i = 0; i < 4; ++i) { const f32x4 w = *(const LAS f32x4*)(rw + e * RWS + i * 256 + lane * 4); s += v[i][0] * w[0] + v[i][1] * w[1] + v[i][2] * w[2] + v[i][3] * w[3]; }
            lg[e] = wave_sum(s) + bias[e]; }
        int gi = 0; float gm = lg[0];
#pragma unroll
        for (int g = 1; g < 4; ++g) { if (lg[g] > gm) { gm = lg[g]; gi = g; } }
        gi = __builtin_amdgcn_readfirstlane(gi);
        float gden = 0.f;
#pragma unroll
        for (int g = 0; g < 4; ++g) gden += __expf(lg[g] - gm);
        const float gval = 1.f / gden;
        float el[8];
#pragma unroll
        for (int j = 0; j < 8; ++j) { float s = 0.f; const LAS float* wp = rw + (4 + gi * 8 + j) * RWS + lane * 4;
#pragma unroll
            for (int i = 0; i < 4; ++i) { const f32x4 w = *(const LAS f32x4*)(wp + i * 256); s += v[i][0] * w[0] + v[i][1] * w[1] + v[i][2] * w[2] + v[i][3] * w[3]; }
            el[j] = wave_sum(s) + bias[4 + gi * 8 + j]; }
        int i1 = 0; float m1 = el[0];
#pragma unroll
        for (int j = 1; j < 8; ++j) if (el[j] > m1) { m1 = el[j]; i1 = j; }
        int i2 = -1; float m2 = -3.0e38f;
#pragma unroll
        for (int j = 0; j < 8; ++j) if (j != i1 && el[j] > m2) { m2 = el[j]; i2 = j; }
        const float t = __expf(m2 - m1); const float w1 = gval / (1.f + t), w2 = gval * t / (1.f + t);
        if (dry && w1 + w2 == 123.f) HB[0] = 0;
        if (lane == 0 && !dry) {
            const int e1 = gi * 8 + i1, e2 = gi * 8 + i2; const int lr = wave * 18 + (row - r0w);
            const unsigned p1 = __hip_atomic_fetch_add(lcnt + e1, 1u, __ATOMIC_RELAXED, __HIP_MEMORY_SCOPE_WORKGROUP), p2 = __hip_atomic_fetch_add(lcnt + e2, 1u, __ATOMIC_RELAXED, __HIP_MEMORY_SCOPE_WORKGROUP);
            rec[lr * 8 + 0] = e1; rec[lr * 8 + 1] = (int)p1; rec[lr * 8 + 2] = __float_as_int(w1); rec[lr * 8 + 3] = e2; rec[lr * 8 + 4] = (int)p2; rec[lr * 8 + 5] = __float_as_int(w2);
        }
    }
    __syncthreads();
    if (tid < 32 && !dry) { const unsigned n = lcnt[tid]; lbase[tid] = n ? atomicAdd(&cnt[tid], n) : 0u; }
    __syncthreads();
    if (!dry) for (int lr = tid; lr < 144; lr += 512) { const int wv = lr / 18, k = lr - wv * 18; const int row = (bid_now() * 8 + wv) * rpw + k;
        if (k < rpw && row < nrows) { const int e1 = rec[lr * 8 + 0], e2 = rec[lr * 8 + 3];
            { const size_t q1 = (size_t)e1 * MOE_CAP + lbase[e1] + rec[lr * 8 + 1], q2 = (size_t)e2 * MOE_CAP + lbase[e2] + rec[lr * 8 + 4];
              list[q1] = row * 2;     listw[q1] = __int_as_float(rec[lr * 8 + 2]);
              list[q2] = row * 2 + 1; listw[q2] = __int_as_float(rec[lr * 8 + 5]); } } }
    __syncthreads();
}

DI int moe_offsets(const unsigned* cnt, LAS unsigned* off, LAS unsigned char* pe) {
    if (tid_now() == 0) { unsigned o = 0;
#pragma unroll 1
        for (int e = 0; e < 32; ++e) { const unsigned c = __hip_atomic_load(cnt + e, __ATOMIC_RELAXED, __HIP_MEMORY_SCOPE_AGENT); const unsigned np = (c + 255u) >> 8; off[e] = o;
#pragma unroll 1
            for (unsigned q = 0; q < np; ++q) pe[(o >> 8) + q] = (unsigned char)e;
            o += np << 8; } off[32] = o; }
    __syncthreads();
    return (int)(off[32] >> 8);
}
template <int N> DI float dpp_row_shr(float x) { return __builtin_bit_cast(float, __builtin_amdgcn_update_dpp(0, __builtin_bit_cast(int, x), 0x110 + N, 0xf, 0xf, true)); }
DI float row_scan16(float x) { x += dpp_row_shr<1>(x); x += dpp_row_shr<2>(x); x += dpp_row_shr<4>(x); x += dpp_row_shr<8>(x); return x; }
DI bf16x8 pack8(const float* v) { u32x4 w; w.x = pk2(v[0], v[1]); w.y = pk2(v[2], v[3]); w.z = pk2(v[4], v[5]); w.w = pk2(v[6], v[7]); return __builtin_bit_cast(bf16x8, w); }
DI void unpack8(const u32x4 w, float* v) { v[0] = bflo(w.x); v[1] = bfhi(w.x); v[2] = bflo(w.y); v[3] = bfhi(w.y); v[4] = bflo(w.z); v[5] = bfhi(w.z); v[6] = bflo(w.w); v[7] = bfhi(w.w); }
#define MFMA16(a, b, c) __builtin_amdgcn_mfma_f32_16x16x32_bf16((a), (b), (c), 0, 0, 0)
constexpr int HG_RS = 136;
constexpr int HG_TILE = 64 * HG_RS;
DI void hgrn_gate_block(const bf16_t* zf  , const float* lb, float* logf, float* kf) {
    float x[16]; unpack8(*(const u32x4*)zf, x); unpack8(*(const u32x4*)(zf + 32), x + 8);
#pragma unroll
    for (int i = 0; i < 16; ++i) { const float sf = sigmoidf_(x[i]); logf[i] = __logf(fmaxf(lb[i] + (1.f - lb[i]) * sf, 1e-30f)); kf[i] = (1.f - lb[i]) * (1.f - sf); }
}
DI void hgrn_lb(const float* lbl, const int li, const int dir, const int h, const int g, float* lb) {
#pragma unroll
    for (int i = 0; i < 16; ++i) { const int hd = h * 64 + 32 * (i >> 3) + 8 * g + (i & 7); lb[i] = li > 0 ? sigmoidf_(lbl[(2 + dir) * 256 + hd] - lbl[dir * 256 + hd]) : 0.f; }
}
DI void hgrn_stage_v(const bf16_t* Z, const int row0, const int h, const int dir, const int lane, ldsp VT) {
#pragma unroll
    for (int i = 0; i < 8; ++i) { const int tau = (lane >> 3) + 8 * i, t = dir ? 63 - tau : tau;
        const u32x4 v = *(const u32x4*)(Z + (size_t)(row0 + t) * NZ + ZB_I + h * 64 + (lane & 7) * 8);
        *(LAS u32x2*)(VT + tau * HG_RS + (lane & 7) * 16) = (u32x2){v.x, v.y}; *(LAS u32x2*)(VT + tau * HG_RS + (lane & 7) * 16 + 8) = (u32x2){v.z, v.w}; }
}
DI bf16x8 hgrn_tr_frag(ldsp T, const int col, const int r0, const int r1) {
    const LAS bf16_t* p0 = (const LAS bf16_t*)(T + r0 * HG_RS) + col; const LAS bf16_t* p1 = (const LAS bf16_t*)(T + r1 * HG_RS) + col;
    u32x4 w;
    w.x = (unsigned)p0[0] | ((unsigned)p0[HG_RS / 2] << 16); w.y = (unsigned)p0[HG_RS] | ((unsigned)p0[3 * HG_RS / 2] << 16);
    w.z = (unsigned)p1[0] | ((unsigned)p1[HG_RS / 2] << 16); w.w = (unsigned)p1[HG_RS] | ((unsigned)p1[3 * HG_RS / 2] << 16);
    return __builtin_bit_cast(bf16x8, w);
}

DI void hgrn1_unit(const Ctx& p, const int li, const int cidx, ldsp lds) {
    const int tid = tid_now(), lane = tid & 63, w = __builtin_amdgcn_readfirstlane(tid >> 6), h = w >> 1, dir = w & 1, tl = lane & 15, g = lane >> 4;
    const bf16_t* Z = (const bf16_t*)(p.ws + WS_Z); bf16_t* U = (bf16_t*)(p.ws + WS_X + X_U); float* HE = (float*)(p.ws + WS_HE);
    const int row0 = chunk_row0(cidx);
    ldsp VT = lds + w * HG_TILE; ldsp KT = lds + 8 * HG_TILE + w * HG_TILE;
    hgrn_stage_v(Z, row0, h, dir, lane, VT);
    float lb[16]; hgrn_lb(p.in[13], li, dir, h, g, lb);
    const int fcol = (dir ? ZB_FB : ZB_FF) + h * 64 + 8 * g;
    float tot[4][16];
#pragma unroll
    for (int I = 0; I < 4; ++I) { const int tau = 16 * I + tl, t = dir ? 63 - tau : tau; float logf[16], kf[16];
        hgrn_gate_block(Z + (size_t)(row0 + t) * NZ + fcol, lb, logf, kf);
#pragma unroll
        for (int i = 0; i < 16; ++i) { const float a = row_scan16(logf[i]); tot[I][i] = __shfl(a, (lane & 48) | 15); } }
#pragma unroll
    for (int I = 0; I < 4; ++I) { const int tau = 16 * I + tl, t = dir ? 63 - tau : tau; float logf[16], kf[16], kd[16];
        hgrn_gate_block(Z + (size_t)(row0 + t) * NZ + fcol, lb, logf, kf);
#pragma unroll
        for (int i = 0; i < 16; ++i) { const float a = row_scan16(logf[i]); float rest = tot[I][i] - a;
#pragma unroll
            for (int M = I + 1; M < 4; ++M) rest += tot[M][i];
            kd[i] = kf[i] * __expf(rest); }
        { const u32x4 k0 = __builtin_bit_cast(u32x4, pack8(kd)), k1 = __builtin_bit_cast(u32x4, pack8(kd + 8));
          LAS u32x2* d0 = (LAS u32x2*)(KT + tau * HG_RS + (8 * g) * 2); LAS u32x2* d1 = (LAS u32x2*)(KT + tau * HG_RS + (32 + 8 * g) * 2);
          d0[0] = (u32x2){k0.x, k0.y}; d0[1] = (u32x2){k0.z, k0.w}; d1[0] = (u32x2){k1.x, k1.y}; d1[1] = (u32x2){k1.z, k1.w}; } }
    if (tl == 0) {
#pragma unroll
        for (int i = 0; i < 16; ++i) HE[((size_t)(cidx * 4 + h) * 2 + dir) * 64 + 32 * (i >> 3) + 8 * g + (i & 7)] = __expf(tot[0][i] + tot[1][i] + tot[2][i] + tot[3][i]); }
    asm volatile("s_waitcnt lgkmcnt(0)" ::: "memory"); __builtin_amdgcn_wave_barrier();
    bf16x8 va[4][2];
#pragma unroll
    for (int E = 0; E < 4; ++E)
#pragma unroll
        for (int st = 0; st < 2; ++st) va[E][st] = hgrn_tr_frag(VT, 16 * E + tl, 32 * st + 8 * g, 32 * st + 8 * g + 4);
    bf16_t* up = U + ((size_t)(cidx * 4 + h) * 2 + dir) * 4096;
#pragma unroll
    for (int Dt = 0; Dt < 4; ++Dt) {
        const bf16x8 kb0 = hgrn_tr_frag(KT, 16 * Dt + tl, 8 * g, 8 * g + 4), kb1 = hgrn_tr_frag(KT, 16 * Dt + tl, 32 + 8 * g, 32 + 8 * g + 4);
#pragma unroll
        for (int E = 0; E < 4; ++E) { f32x4 acc = {0.f, 0.f, 0.f, 0.f}; acc = MFMA16(kb0, va[E][0], acc); acc = MFMA16(kb1, va[E][1], acc);
            *(u32x2*)(up + (16 * E + tl) * 64 + 16 * Dt + 4 * g) = (u32x2){pk2(acc[0], acc[1]), pk2(acc[2], acc[3])}; }
    }
}

DI void hgrn3_unit(const Ctx& p, const int li, const int cidx, ldsp lds, const int dry = 0) {
    const int tid = tid_now(), lane = tid & 63, w = __builtin_amdgcn_readfirstlane(tid >> 6), h = w >> 1, dir = w & 1, tl = lane & 15, g = lane >> 4;
    bf16_t* Z = (bf16_t*)(p.ws + WS_Z); const bf16_t* U = (const bf16_t*)(p.ws + WS_X + X_U);
    const int row0 = chunk_row0(cidx);
    ldsp VT = lds + w * HG_TILE; ldsp OX = lds + 8 * HG_TILE;
    hgrn_stage_v(Z, row0, h, dir, lane, VT);
    float lb[16]; hgrn_lb(p.in[13], li, dir, h, g, lb);
    const int fcol = (dir ? ZB_FB : ZB_FF) + h * 64 + 8 * g;
    const bf16_t* sp = U + ((size_t)(cidx * 4 + h) * 2 + dir) * 4096;
    float crun[16], tot1[16], tot2[16];
#pragma unroll
    for (int i = 0; i < 16; ++i) { crun[i] = 0.f; tot1[i] = 0.f; tot2[i] = 0.f; }
    bf16x8 kend[3][2];
    asm volatile("s_waitcnt lgkmcnt(0)" ::: "memory"); __builtin_amdgcn_wave_barrier();
#pragma unroll
    for (int I = 0; I < 4; ++I) {
        const int tau = 16 * I + tl, t = dir ? 63 - tau : tau;
        const bf16_t* zr = Z + (size_t)(row0 + t) * NZ;
        float logf[16], kf[16], qv[16], al[16], tot[16], tmp[16];
        hgrn_gate_block(zr + fcol, lb, logf, kf);
        unpack8(*(const u32x4*)(zr + ZB_Q + h * 64 + 8 * g), qv); unpack8(*(const u32x4*)(zr + ZB_Q + h * 64 + 32 + 8 * g), qv + 8);
#pragma unroll
        for (int i = 0; i < 16; ++i) { al[i] = row_scan16(logf[i]); tot[i] = __shfl(al[i], (lane & 48) | 15); }
        f32x4 wt[4];
#pragma unroll
        for (int i = 0; i < 16; ++i) tmp[i] = kf[i] * __expf(fminf(-al[i], 80.f));
        const bf16x8 kd0 = pack8(tmp), kd1 = pack8(tmp + 8);
#pragma unroll
        for (int i = 0; i < 16; ++i) tmp[i] = qv[i] * __expf(al[i]);
        const bf16x8 qp0 = pack8(tmp), qp1 = pack8(tmp + 8);
        { f32x4 a = {0.f, 0.f, 0.f, 0.f}; a = MFMA16(kd0, qp0, a); a = MFMA16(kd1, qp1, a);
#pragma unroll
          for (int r = 0; r < 4; ++r) a[r] = (4 * g + r <= tl) ? a[r] : 0.f;
          wt[I] = a; }
#pragma unroll
        for (int J = 0; J < I; ++J) {
            bf16x8 q0 = qp0, q1 = qp1;
            if (J < I - 1) {
#pragma unroll
                for (int i = 0; i < 16; ++i) { float dl = (I - 1 - J >= 1) ? ((I - 1 == 1) ? tot1[i] : tot2[i]) : 0.f; if (I - 1 - J == 2) dl += tot1[i]; tmp[i] = qv[i] * __expf(al[i] + dl); }
                q0 = pack8(tmp); q1 = pack8(tmp + 8);
            }
            f32x4 a = {0.f, 0.f, 0.f, 0.f}; a = MFMA16(kend[J][0], q0, a); a = MFMA16(kend[J][1], q1, a); wt[J] = a;
        }
        if (I < 3) {
#pragma unroll
            for (int i = 0; i < 16; ++i) tmp[i] = kf[i] * __expf(tot[i] - al[i]);
            kend[I][0] = pack8(tmp); kend[I][1] = pack8(tmp + 8);
        }
#pragma unroll
        for (int i = 0; i < 16; ++i) tmp[i] = qv[i] * __expf(al[i] + crun[i]);
        const bf16x8 qd0 = pack8(tmp), qd1 = pack8(tmp + 8);
        bf16x8 bw[2];
#pragma unroll
        for (int st = 0; st < 2; ++st) { float v8[8];
#pragma unroll
            for (int r = 0; r < 4; ++r) { v8[r] = (2 * st <= I) ? wt[(2 * st <= I) ? 2 * st : 0][r] : 0.f; v8[4 + r] = (2 * st + 1 <= I) ? wt[(2 * st + 1 <= I) ? 2 * st + 1 : 0][r] : 0.f; }
            bw[st] = pack8(v8); }
        bf16_t* ox = (bf16_t*)nullptr;
#pragma unroll
        for (int E = 0; E < 4; ++E) {
            f32x4 acc = {0.f, 0.f, 0.f, 0.f};
#pragma unroll
            for (int st = 0; st < 2; ++st) if (2 * st <= I) { const bf16x8 va = hgrn_tr_frag(VT, 16 * E + tl, 32 * st + 4 * g, 32 * st + 16 + 4 * g); acc = MFMA16(va, bw[st], acc); }
            const bf16x8 s0 = *(const bf16x8*)(sp + (16 * E + tl) * 64 + 8 * g), s1 = *(const bf16x8*)(sp + (16 * E + tl) * 64 + 32 + 8 * g);
            acc = MFMA16(s0, qd0, acc); acc = MFMA16(s1, qd1, acc);
            u32x2 o2; o2.x = pk2(acc[0], acc[1]); o2.y = pk2(acc[2], acc[3]);
            *(LAS u32x2*)(OX + ((dir * 4 + h) * 64 + t) * HG_RS + (16 * E + 4 * g) * 2) = o2;
        }
        (void)ox;
#pragma unroll
        for (int i = 0; i < 16; ++i) { crun[i] += tot[i]; if (I == 1) tot1[i] = tot[i]; if (I == 2) tot2[i] = tot[i]; }
    }
    __syncthreads();
    { const int t = 32 * dir + (lane >> 1), e0 = (lane & 1) * 32; const float* gn = p.in[14] + li * 64;
      const LAS unsigned char* of = OX + ((0 * 4 + h) * 64 + t) * HG_RS + e0 * 2; const LAS unsigned char* ob = OX + ((1 * 4 + h) * 64 + t) * HG_RS + e0 * 2;
      bf16_t* zr = Z + (size_t)(row0 + t) * NZ + h * 64 + e0;
      float o[32]; float ss = 0.f;
#pragma unroll
      for (int q = 0; q < 4; ++q) { float a8[8], b8[8];
          { const u32x2 x0 = *(const LAS u32x2*)(of + q * 16), x1 = *(const LAS u32x2*)(of + q * 16 + 8), y0 = *(const LAS u32x2*)(ob + q * 16), y1 = *(const LAS u32x2*)(ob + q * 16 + 8);
            unpack8((u32x4){x0.x, x0.y, x1.x, x1.y}, a8); unpack8((u32x4){y0.x, y0.y, y1.x, y1.y}, b8); }
#pragma unroll
          for (int j = 0; j < 8; ++j) { o[q * 8 + j] = a8[j] + b8[j]; ss += o[q * 8 + j] * o[q * 8 + j]; } }
      ss += dpp_f<0xB1>(ss);
      const float rstd = rsqrtf(ss * (1.f / 64.f) + NORM_EPS);
#pragma unroll
      for (int q = 0; q < 4; ++q) { float g8[8], r8[8]; unpack8(*(const u32x4*)(zr + ZB_G + q * 8), g8);
#pragma unroll
          for (int j = 0; j < 8; ++j) r8[j] = o[q * 8 + j] * rstd * gn[e0 + q * 8 + j] * g8[j] * sigmoidf_(g8[j]);
          if (!dry) *(bf16x8*)(zr + ZB_Q + q * 8) = pack8(r8); } }
    __syncthreads();
}

DI void phase_prep(const Ctx& p, const int li, ldsp lds) {
    const int tid = tid_now();
    bf16_t* Z = (bf16_t*)(p.ws + WS_Z);
    const f32x2* cs16 = (const f32x2*)(p.ws + WS_ROPE16); const f32x2* cs8 = (const f32x2*)(p.ws + WS_ROPE8);
    bf16_t* KC = (bf16_t*)(p.ws + WS_X + X_KC); bf16_t* AVt = (bf16_t*)(p.ws + WS_X + X_AVT); bf16_t* DVt = (bf16_t*)(p.ws + WS_X + X_DVT);
    bf16_t* U = (bf16_t*)(p.ws + WS_X + X_U); float* HE = (float*)(p.ws + WS_HE);
    const float* qn = p.in[15] + li * 256; const float* kvn = p.in[16] + li * 128; const float* lbl = p.in[13];
    for (int cidx = bid_now(); cidx < NCHUNK; cidx += gdim_now()) {
        const int row0 = chunk_row0(cidx); const bool lat = cidx < 512;
        int b, key0; row_bk(row0, b, key0);
        if (lat) {
            const int prow = key0 >> 6;
            if (tid < 128) { const int t = tid >> 1, blk = 4 + (tid & 1), pcol = (key0 + t) & 63;
                bf16_t* zp = Z + (size_t)(row0 + t) * NZ + ZA_Q + blk * 64; u32x4 w[8]; float x[64];
#pragma unroll
                for (int q = 0; q < 8; ++q) w[q] = *(const u32x4*)(zp + q * 8);
#pragma unroll
                for (int q = 0; q < 8; ++q) unpack8(w[q], x + q * 8);
#pragma unroll
                for (int j = 0; j < 16; ++j) { const f32x2 cr = cs16[prow * 16 + j], cc = cs16[pcol * 16 + j];
                    const float a1 = x[j], a2 = x[16 + j], b1 = x[32 + j], b2 = x[48 + j];
                    x[j] = a1 * cr.x - a2 * cr.y; x[16 + j] = a2 * cr.x + a1 * cr.y; x[32 + j] = b1 * cc.x - b2 * cc.y; x[48 + j] = b2 * cc.x + b1 * cc.y; }
#pragma unroll
                for (int q = 0; q < 8; ++q) *(bf16x8*)(zp + q * 8) = pack8(x + q * 8); }
            { const int t = tid >> 3, blk = 8 + (tid & 7), pcol = (key0 + t) & 63;
                bf16_t* zp = Z + (size_t)(row0 + t) * NZ + ZD_Q + blk * 32; u32x4 w[4]; float x[32];
#pragma unroll
                for (int q = 0; q < 4; ++q) w[q] = *(const u32x4*)(zp + q * 8);
#pragma unroll
                for (int q = 0; q < 4; ++q) unpack8(w[q], x + q * 8);
#pragma unroll
                for (int j = 0; j < 8; ++j) { const f32x2 cr = cs8[prow * 8 + j], cc = cs8[pcol * 8 + j];
                    const float a1 = x[j], a2 = x[8 + j], b1 = x[16 + j], b2 = x[24 + j];
                    x[j] = a1 * cr.x - a2 * cr.y; x[8 + j] = a2 * cr.x + a1 * cr.y; x[16 + j] = b1 * cc.x - b2 * cc.y; x[24 + j] = b2 * cc.x + b1 * cc.y; }
#pragma unroll
                for (int q = 0; q < 4; ++q) *(bf16x8*)(zp + q * 8) = pack8(x + q * 8); }
        }
#ifdef DUP_PREP234
        for (int rep = 0; rep < 2; ++rep) { int dryp = rep == 0; asm volatile("" : "+s"(dryp));
#else
        { const int dryp = 0;
#endif
        { const int t = tid >> 3, s = tid & 7; bf16_t* zr = Z + (size_t)(row0 + t) * NZ;
          float xq[32], xk[16]; float sq = 0.f, sk = 0.f;
#pragma unroll
          for (int j = 0; j < 4; ++j) { const u32x4 w = *(const u32x4*)(zr + ZC_Q + s * 32 + j * 8); const unsigned wu[4] = {w.x, w.y, w.z, w.w};
#pragma unroll
              for (int q = 0; q < 4; ++q) { xq[j * 8 + 2 * q] = bflo(wu[q]); xq[j * 8 + 2 * q + 1] = bfhi(wu[q]); } }
#pragma unroll
          for (int j = 0; j < 2; ++j) { const u32x4 w = *(const u32x4*)(zr + ZC_KV + s * 16 + j * 8); const unsigned wu[4] = {w.x, w.y, w.z, w.w};
#pragma unroll
              for (int q = 0; q < 4; ++q) { xk[j * 8 + 2 * q] = bflo(wu[q]); xk[j * 8 + 2 * q + 1] = bfhi(wu[q]); } }
#pragma unroll
          for (int j = 0; j < 32; ++j) sq += xq[j] * xq[j];
#pragma unroll
          for (int j = 0; j < 16; ++j) sk += xk[j] * xk[j];
          sq += dpp_f<0xB1>(sq); sq += dpp_f<0x4E>(sq); sq += dpp_f<0x141>(sq); sk += dpp_f<0xB1>(sk); sk += dpp_f<0x4E>(sk); sk += dpp_f<0x141>(sk);
          const float rq = rsqrtf(sq * (1.f / 256.f) + NORM_EPS), rk = rsqrtf(sk * (1.f / 128.f) + NORM_EPS);
#pragma unroll
          for (int j = 0; j < 4; ++j) { u32x4 w; const float* g = qn + s * 32 + j * 8;
              w.x = pk2(xq[j * 8 + 0] * rq * g[0], xq[j * 8 + 1] * rq * g[1]); w.y = pk2(xq[j * 8 + 2] * rq * g[2], xq[j * 8 + 3] * rq * g[3]);
              w.z = pk2(xq[j * 8 + 4] * rq * g[4], xq[j * 8 + 5] * rq * g[5]); w.w = pk2(xq[j * 8 + 6] * rq * g[6], xq[j * 8 + 7] * rq * g[7]);
              if (!dryp) *(u32x4*)(zr + ZC_Q + s * 32 + j * 8) = w; }
#pragma unroll
          for (int j = 0; j < 2; ++j) { u32x4 w; const float* g = kvn + s * 16 + j * 8;
              w.x = pk2(xk[j * 8 + 0] * rk * g[0], xk[j * 8 + 1] * rk * g[1]); w.y = pk2(xk[j * 8 + 2] * rk * g[2], xk[j * 8 + 3] * rk * g[3]);
              w.z = pk2(xk[j * 8 + 4] * rk * g[4], xk[j * 8 + 5] * rk * g[5]); w.w = pk2(xk[j * 8 + 6] * rk * g[6], xk[j * 8 + 7] * rk * g[7]);
              if (!dryp) *(u32x4*)(zr + ZC_KV + s * 16 + j * 8) = w; } }
        if (tid < 128) { const int t = tid >> 1, half = tid & 1;
            const bf16_t* x = Z + (size_t)(row0 + t) * NZ + ZC_KR + half * 16; float v[16];
            unpack8(*(const u32x4*)x, v); unpack8(*(const u32x4*)(x + 8), v + 8);
            if (lat) { const int pos = half ? ((key0 + t) & 63) : ((key0 + t) >> 6);
#pragma unroll
                for (int j = 0; j < 8; ++j) { const f32x2 cs = cs8[pos * 8 + j]; const float x1 = v[j], x2 = v[8 + j]; v[j] = x1 * cs.x - x2 * cs.y; v[8 + j] = x2 * cs.x + x1 * cs.y; } }
            const bf16x8 o0 = pack8(v), o1 = pack8(v + 8);
#pragma unroll
            for (int hh = 0; hh < 4; ++hh) { bf16_t* kp = KC + ((size_t)(b * 4 + hh) * KEYS + key0 + t) * 160 + 64 + half * 16; *(bf16x8*)kp = o0; *(bf16x8*)(kp + 8) = o1; } }
        }
        hgrn1_unit(p, li, cidx, lds);
        asm volatile("s_waitcnt vmcnt(0) lgkmcnt(0)" ::: "memory"); __syncthreads();
#ifdef DUP_H1
        hgrn1_unit(p, li, cidx, lds);
#endif
    }
}

DI void phase_hscan(const Ctx& p, const int dry = 0) {
    unsigned* U = (unsigned*)(p.ws + WS_X + X_U); const float* HE = (const float*)(p.ws + WS_HE);
    for (int g = bid_now() * 512 + tid_now(); g < 64 * 2048; g += gdim_now() * 512) {
        const int chain = g >> 11, pr = g & 2047, d = (pr * 2) & 63; const int b = chain >> 3, h = (chain >> 1) & 3, dir = chain & 1;
        float S0 = 0.f, S1 = 0.f;
#pragma unroll 1
        for (int k0 = 0; k0 < 68; k0 += 17) {
            unsigned u[17]; f32x2 e[17];
#pragma unroll
            for (int q = 0; q < 17; ++q) { const int k = k0 + q; int cidx;
                if (dir == 0) cidx = k < 4 ? 512 + b * 4 + k : b * 64 + (k - 4); else cidx = k < 4 ? 512 + b * 4 + (3 - k) : b * 64 + (67 - k);
                const size_t ch = (size_t)(cidx * 4 + h) * 2 + dir; u[q] = U[ch * 2048 + pr]; e[q] = *(const f32x2*)(HE + ch * 64 + d); }
#pragma unroll
            for (int q = 0; q < 17; ++q) { const int k = k0 + q; int cidx;
                if (dir == 0) cidx = k < 4 ? 512 + b * 4 + k : b * 64 + (k - 4); else cidx = k < 4 ? 512 + b * 4 + (3 - k) : b * 64 + (67 - k);
                const size_t ch = (size_t)(cidx * 4 + h) * 2 + dir; if (!dry) U[ch * 2048 + pr] = pk2(S0, S1); S0 = e[q].x * S0 + bflo(u[q]); S1 = e[q].y * S1 + bfhi(u[q]); }
        }
        if (dry && S0 == 1.2345f) U[0] = 0u;
    }
}

template <int DQK, int NMAP, int MODE>
struct AttnCfg { static constexpr bool VROW = true;
    static constexpr int KW = DQK * NMAP, RSK = KW * 2 + 16, RSV = VROW ? 192 : 144, KBYTES = 64 * RSK, VBYTES = 64 * RSV, CPR = KW / 8, NCK = 64 * CPR; };

template <int DQK, int NMAP, int MODE, int ABL = 0, class TileFn>
DI void attn_unit(ldsp lds, const bf16_t* qrow  , const int ntiles, TileFn tile,
                  const float scl2  , const float m_init, const float l_init, const int qpos  ,
                  bf16_t* orow, const float lam, const float post, const float* subln, const int qtok = -1, const f32x2* cs8 = nullptr) {
    typedef AttnCfg<DQK, NMAP, MODE> C;
    const int tid = tid_now(), lane = tid & 63, r = lane & 31, hh = lane >> 5;
    bf16x8 qf[NMAP][DQK / 16];
#pragma unroll
    for (int mp = 0; mp < NMAP; ++mp)
#pragma unroll
        for (int kk = 0; kk < DQK / 16; ++kk) qf[mp][kk] = *(const bf16x8*)(qrow + mp * DQK + kk * 16 + hh * 8);
    auto rope_x = [&](bf16x8& frag, const int pos) {
        const u32x4 w = __builtin_bit_cast(u32x4, frag); const unsigned wu[4] = {w.x, w.y, w.z, w.w}; unsigned ou[4];
#pragma unroll
        for (int q2 = 0; q2 < 4; ++q2) { const auto sw = __builtin_amdgcn_permlane32_swap(wu[q2], wu[q2], false, false); const unsigned pw = hh ? sw[0] : sw[1];
            const f32x2 c0 = cs8[pos * 8 + 2 * q2], c1 = cs8[pos * 8 + 2 * q2 + 1];
            const float a0 = bflo(wu[q2]), a1 = bfhi(wu[q2]), b0 = bflo(pw), b1 = bfhi(pw);
            const float r0 = hh ? a0 * c0.x + b0 * c0.y : a0 * c0.x - b0 * c0.y, r1 = hh ? a1 * c1.x + b1 * c1.y : a1 * c1.x - b1 * c1.y;
            ou[q2] = pk2(r0, r1); }
        const u32x4 o4 = {ou[0], ou[1], ou[2], ou[3]}; frag = __builtin_bit_cast(bf16x8, o4); };
    auto rope_in = [&](bf16x8& fa, bf16x8& fb, const int pos) {
        const u32x4 wa = __builtin_bit_cast(u32x4, fa), wb = __builtin_bit_cast(u32x4, fb); const unsigned ua[4] = {wa.x, wa.y, wa.z, wa.w}, ub[4] = {wb.x, wb.y, wb.z, wb.w}; unsigned oa[4], ob[4];
#pragma unroll
        for (int q2 = 0; q2 < 4; ++q2) { const f32x2 c0 = cs8[pos * 16 + hh * 8 + 2 * q2], c1 = cs8[pos * 16 + hh * 8 + 2 * q2 + 1];
            const float a0 = bflo(ua[q2]), a1 = bfhi(ua[q2]), b0 = bflo(ub[q2]), b1 = bfhi(ub[q2]);
            oa[q2] = pk2(a0 * c0.x - b0 * c0.y, a1 * c1.x - b1 * c1.y); ob[q2] = pk2(b0 * c0.x + a0 * c0.y, b1 * c1.x + a1 * c1.y); }
        fa = __builtin_bit_cast(bf16x8, (u32x4){oa[0], oa[1], oa[2], oa[3]}); fb = __builtin_bit_cast(bf16x8, (u32x4){ob[0], ob[1], ob[2], ob[3]}); };
    if (qtok >= 0) {
        const int prow = qtok >> 6, pcol = qtok & 63;
        if (MODE == 0) { rope_x(qf[0][4], prow); rope_x(qf[0][5], pcol); }
        if (MODE == 1) {
#pragma unroll
            for (int mp = 0; mp < NMAP; ++mp) { rope_x(qf[mp][0], prow); rope_x(qf[mp][DQK / 16 - 1], pcol); } }
        if (MODE == 2) { rope_in(qf[0][0], qf[0][1], prow); rope_in(qf[0][DQK / 16 - 2], qf[0][DQK / 16 - 1], pcol); }
    }
    constexpr bool FOLD = true;
#pragma unroll
    for (int mp = 0; mp < NMAP; ++mp)
#pragma unroll
        for (int kk = 0; kk < DQK / 16; ++kk) { const u32x4 w = __builtin_bit_cast(u32x4, qf[mp][kk]); u32x4 o4;
            o4.x = pk2(bflo(w.x) * scl2, bfhi(w.x) * scl2); o4.y = pk2(bflo(w.y) * scl2, bfhi(w.y) * scl2); o4.z = pk2(bflo(w.z) * scl2, bfhi(w.z) * scl2); o4.w = pk2(bflo(w.w) * scl2, bfhi(w.w) * scl2);
            qf[mp][kk] = __builtin_bit_cast(bf16x8, o4); }
    const bool noinit = m_init < -1.0e29f;
    const bf16x8 onesA = __builtin_bit_cast(bf16x8, (u32x4){hh == 0 ? 0x3F803F80u : 0u, 0u, 0u, 0u});
    bf16x8 mB[NMAP];
    auto set_mB = [&](const int mp, const float mv) { const float nm = -mv; const unsigned t = pk2(nm, 0.f); const unsigned w = pk2(nm, nm - bflo(t)); mB[mp] = __builtin_bit_cast(bf16x8, (u32x4){hh == 0 ? w : 0u, 0u, 0u, 0u}); };
    f32x16 O[NMAP][2];
    float m[NMAP], l[NMAP];
#pragma unroll
    for (int mp = 0; mp < NMAP; ++mp) { m[mp] = noinit ? 0.f : m_init; l[mp] = l_init; set_mB(mp, m[mp]);
#pragma unroll
        for (int dv = 0; dv < 2; ++dv)
#pragma unroll
            for (int i = 0; i < 16; ++i) O[mp][dv][i] = 0.f; }
    const int kr0 = tid / C::CPR, kc0 = tid % C::CPR; const int kr1 = (tid + 512) / C::CPR, kc1 = (tid + 512) % C::CPR;
    const int vr = tid >> 3, vc = tid & 7;
    const bool k2 = C::NCK > 512 && tid + 512 < C::NCK;
    const int kr1c = k2 ? kr1 : kr0, kc1c = k2 ? kc1 : kc0;
    struct Stg { u32x4 k0, k1, v; };
    auto ld_tile = [&](const int jt, Stg& g) { const bf16_t* kp; const bf16_t* vp; int ldk, kpos0, masked; tile(jt, kp, ldk, vp, kpos0, masked);
        g.k0 = *(const u32x4*)(kp + (size_t)kr0 * ldk + kc0 * 8); if (C::NCK > 512) g.k1 = *(const u32x4*)(kp + (size_t)kr1c * ldk + kc1c * 8);
        g.v = *(const u32x4*)(vp + (size_t)vr * (C::VROW ? ldk : KEYS) + vc * 8); };
    auto st_tile = [&](const int jt, const Stg& g) { ldsp kb = lds + (jt & 1) * C::KBYTES; ldsp vb = lds + 2 * C::KBYTES + (jt % 3) * C::VBYTES + vr * C::RSV + (vc >> 1) * 32 + (vc & 1) * 8;
        *(LAS u32x4*)(kb + kr0 * C::RSK + kc0 * 16) = g.k0; if (k2) *(LAS u32x4*)(kb + kr1 * C::RSK + kc1 * 16) = g.k1;
        if (C::VROW) *(LAS u32x4*)(lds + 2 * C::KBYTES + (jt % 3) * C::VBYTES + vr * C::RSV + vc * 16) = g.v;
        else { *(LAS u32x2*)vb = (u32x2){g.v.x, g.v.y}; *(LAS u32x2*)(vb + 16) = (u32x2){g.v.z, g.v.w}; } };
    const int grp = __builtin_amdgcn_readfirstlane(tid >> 8);
    bf16x8 pf[NMAP][2][2];
#pragma unroll
    for (int mp = 0; mp < NMAP; ++mp)
#pragma unroll
        for (int a2 = 0; a2 < 2; ++a2)
#pragma unroll
            for (int b2 = 0; b2 < 2; ++b2) pf[mp][a2][b2] = (bf16x8){0, 0, 0, 0, 0, 0, 0, 0};
    auto vbuf = [&](const int x) -> ldsp { return lds + 2 * C::KBYTES + (x % 3) * C::VBYTES; };
#define TR_READ(dst, addr, off) asm volatile("ds_read_b64_tr_b16 %0, %1 offset:%2" : "=v"(dst) : "v"(addr), "n"(off) : "memory")
    const int trb = ((lane >> 5) * 4 + ((lane >> 2) & 3)) * C::RSV + (((lane >> 4) & 1) * 16 + (lane & 3) * 4) * 2;
    auto pv_load = [&](ldsp vb, bf16x8 (&vf)[2][2][2]) {
#pragma unroll
        for (int dv = 0; dv < 2; ++dv)
#pragma unroll
            for (int ks = 0; ks < 2; ++ks)
#pragma unroll
                for (int s2 = 0; s2 < 2; ++s2) {
                    if (C::VROW) { const unsigned ad = (unsigned)(size_t)(vb + trb); u32x2 lo, hi;
                        TR_READ(lo, ad, (32 * ks + 16 * s2) * C::RSV + dv * 64); TR_READ(hi, ad, (32 * ks + 16 * s2 + 8) * C::RSV + dv * 64);
                        vf[dv][ks][s2] = __builtin_bit_cast(bf16x8, (u32x4){lo.x, lo.y, hi.x, hi.y}); }
                    else vf[dv][ks][s2] = *(const LAS bf16x8*)(vb + (32 * dv + r) * C::RSV + (32 * ks + 16 * s2 + 8 * hh) * 2); }
        if (C::VROW) asm volatile("s_waitcnt lgkmcnt(0)" : "+v"(vf[0][0][0]), "+v"(vf[0][0][1]), "+v"(vf[0][1][0]), "+v"(vf[0][1][1]), "+v"(vf[1][0][0]), "+v"(vf[1][0][1]), "+v"(vf[1][1][0]), "+v"(vf[1][1][1])); };
    auto pv_mma = [&](const bf16x8 (&vf)[2][2][2]) {
#pragma unroll
        for (int dv = 0; dv < 2; ++dv)
#pragma unroll
            for (int ks = 0; ks < 2; ++ks)
#pragma unroll
                for (int s2 = 0; s2 < 2; ++s2)
#pragma unroll
                    for (int mp = 0; mp < NMAP; ++mp) O[mp][dv] = __builtin_amdgcn_mfma_f32_32x32x16_bf16(vf[dv][ks][s2], pf[mp][ks][s2], O[mp][dv], 0, 0, 0); };
    auto pv_half = [&](ldsp vb, const int dv) {
        bf16x8 vh[2][2];
#pragma unroll
        for (int ks = 0; ks < 2; ++ks)
#pragma unroll
            for (int s2 = 0; s2 < 2; ++s2) {
                if (C::VROW) { const unsigned ad = (unsigned)(size_t)(vb + trb) + dv * 64; u32x2 lo, hi;
                    TR_READ(lo, ad, (32 * ks + 16 * s2) * C::RSV); TR_READ(hi, ad, (32 * ks + 16 * s2 + 8) * C::RSV);
                    vh[ks][s2] = __builtin_bit_cast(bf16x8, (u32x4){lo.x, lo.y, hi.x, hi.y}); }
                else vh[ks][s2] = *(const LAS bf16x8*)(vb + (32 * dv + r) * C::RSV + (32 * ks + 16 * s2 + 8 * hh) * 2); }
        if (C::VROW) asm volatile("s_waitcnt lgkmcnt(0)" : "+v"(vh[0][0]), "+v"(vh[0][1]), "+v"(vh[1][0]), "+v"(vh[1][1]));
        __builtin_amdgcn_sched_barrier(0);
#pragma unroll
        for (int ks = 0; ks < 2; ++ks)
#pragma unroll
            for (int s2 = 0; s2 < 2; ++s2)
#pragma unroll
                for (int mp = 0; mp < NMAP; ++mp) O[mp][dv] = __builtin_amdgcn_mfma_f32_32x32x16_bf16(vh[ks][s2], pf[mp][ks][s2], O[mp][dv], 0, 0, 0);
        __builtin_amdgcn_sched_barrier(0); };
    auto pv_tile = [&](ldsp vb) { if (NMAP == 1) { bf16x8 vf[2][2][2]; pv_load(vb, vf); __builtin_amdgcn_sched_barrier(0); pv_mma(vf); } else { pv_half(vb, 0); pv_half(vb, 1); } };
    auto smax = [&](const int mp, f32x16 (&s)[2], const int cur_kpos0, const int cur_masked, const bool first) {
        float mx = -3.0e38f;
#pragma unroll
        for (int ks = 0; ks < 2; ++ks)
#pragma unroll
            for (int i = 0; i < 16; ++i) {
                if (MODE == 2) { const int rel = cur_kpos0 + 32 * ks + (i & 3) + 8 * (i >> 2) + 4 * hh - qpos; if (cur_masked && (rel > 128 || rel < -128)) s[ks][i] = -1.0e30f; }
                mx = fmaxf(mx, s[ks][i]); }
        { const auto sw = __builtin_amdgcn_permlane32_swap(__float_as_uint(mx), __float_as_uint(mx), false, false); mx = fmaxf(__uint_as_float(sw[0]), __uint_as_float(sw[1])); }
        const bool force = noinit && first;
        if (force || __any(mx > 8.f)) {
            const float dl = force ? mx : fmaxf(mx, 0.f), alpha = force ? 1.f : __builtin_amdgcn_exp2f(-dl); m[mp] += dl; l[mp] *= alpha; set_mB(mp, m[mp]);
#pragma unroll
            for (int i = 0; i < 16; ++i) { s[0][i] -= dl; s[1][i] -= dl; }
#pragma unroll
            for (int dv = 0; dv < 2; ++dv)
#pragma unroll
                for (int i = 0; i < 16; ++i) O[mp][dv][i] *= alpha;
        }
        float ps = 0.f;
#pragma unroll
        for (int ks = 0; ks < 2; ++ks)
#pragma unroll
            for (int i = 0; i < 16; ++i) { const float pv = (ABL == 1) ? s[ks][i] : __builtin_amdgcn_exp2f(s[ks][i]); s[ks][i] = pv; if (ABL != 1) ps += pv; }
        l[mp] += ps;
#pragma unroll
        for (int ks = 0; ks < 2; ++ks)
#pragma unroll
            for (int s2 = 0; s2 < 2; ++s2) { u32x4 w; w.x = pk2(s[ks][8 * s2 + 0], s[ks][8 * s2 + 1]); w.y = pk2(s[ks][8 * s2 + 2], s[ks][8 * s2 + 3]);
                w.z = pk2(s[ks][8 * s2 + 4], s[ks][8 * s2 + 5]); w.w = pk2(s[ks][8 * s2 + 6], s[ks][8 * s2 + 7]);
                pf[mp][ks][s2] = __builtin_bit_cast(bf16x8, w); }
    };
    Stg ga, gb; ga.k1 = (u32x4){0u, 0u, 0u, 0u}; gb.k1 = (u32x4){0u, 0u, 0u, 0u}; gb.k0 = ga.k1; gb.v = ga.k1;
    auto step = [&](const int j, Stg& gx  , Stg& gy  ) {
        if (ABL != 8) ld_tile(j + 2 < ntiles ? j + 2 : ntiles - 1, gy);
        const bf16_t* kp_; const bf16_t* vp_; int ldk_, cur_kpos0, cur_masked; tile(j, kp_, ldk_, vp_, cur_kpos0, cur_masked);
        ldsp kb = lds + (j & 1) * C::KBYTES;
        if (grp == 1 && j > 0) pv_tile(vbuf(j - 1));
        bf16x8 vf0[2][2][2];
#pragma unroll
        for (int mp = 0; mp < NMAP; ++mp) {
            f32x16 s[2];
            bf16x8 kfr[2][DQK / 16];
#pragma unroll
            for (int ks = 0; ks < 2; ++ks)
#pragma unroll
                for (int kk = 0; kk < DQK / 16; ++kk) kfr[ks][kk] = *(const LAS bf16x8*)(kb + (32 * ks + r) * C::RSK + (mp * DQK + kk * 16 + hh * 8) * 2);
            if (NMAP == 1) __builtin_amdgcn_sched_barrier(0);
#pragma unroll
            for (int ks = 0; ks < 2; ++ks) {
#pragma unroll
                for (int i = 0; i < 16; ++i) s[ks][i] = 0.f;
                s[ks] = __builtin_amdgcn_mfma_f32_32x32x16_bf16(onesA, mB[mp], s[ks], 0, 0, 0);
#pragma unroll
                for (int kk = 0; kk < DQK / 16; ++kk) s[ks] = __builtin_amdgcn_mfma_f32_32x32x16_bf16(kfr[ks][kk], qf[mp][kk], s[ks], 0, 0, 0); }
            if (NMAP == 1 && grp == 0) pv_load(vbuf(j), vf0);
            if (NMAP == 1) __builtin_amdgcn_sched_barrier(0);
            smax(mp, s, cur_kpos0, cur_masked, j == 0);
        }
        if (grp == 0) { if (NMAP == 1) pv_mma(vf0); else pv_tile(vbuf(j)); }
        if (ABL != 8) if (j + 1 < ntiles) st_tile(j + 1, gx);
        if (ABL != 7) __syncthreads();
    };
    ld_tile(0, ga); ld_tile(ntiles > 1 ? 1 : 0, gb);
    __syncthreads();
    st_tile(0, ga);
    __syncthreads();
#pragma unroll 1
    for (int j = 0; j < ntiles; j += 2) { step(j, gb, ga); if (j + 1 < ntiles) step(j + 1, ga, gb); }
    if (grp == 1) pv_tile(vbuf(ntiles - 1));
    asm volatile("" ::: "memory");
    float inv[NMAP];
#pragma unroll
    for (int mp = 0; mp < NMAP; ++mp) { const auto sw = __builtin_amdgcn_permlane32_swap(__float_as_uint(l[mp]), __float_as_uint(l[mp]), false, false); const float lt = __uint_as_float(sw[0]) + __uint_as_float(sw[1]); inv[mp] = 1.f / lt; }
    float o[2][16];
#pragma unroll
    for (int dv = 0; dv < 2; ++dv)
#pragma unroll
        for (int i = 0; i < 16; ++i) { if (MODE == 1) o[dv][i] = O[0][dv][i] * inv[0] - lam * O[NMAP - 1][dv][i] * inv[NMAP - 1]; else o[dv][i] = O[0][dv][i] * inv[0]; }
    if (MODE == 1) {
        float ss = 0.f;
#pragma unroll
        for (int dv = 0; dv < 2; ++dv)
#pragma unroll
            for (int i = 0; i < 16; ++i) ss += o[dv][i] * o[dv][i];
        { const auto sw = __builtin_amdgcn_permlane32_swap(__float_as_uint(ss), __float_as_uint(ss), false, false); ss = __uint_as_float(sw[0]) + __uint_as_float(sw[1]); }
        const float rstd = rsqrtf(ss * (1.f / 64.f) + NORM_EPS) * post;
#pragma unroll
        for (int dv = 0; dv < 2; ++dv)
#pragma unroll
            for (int i = 0; i < 16; ++i) o[dv][i] *= rstd * subln[32 * dv + (i & 3) + 8 * (i >> 2) + 4 * hh];
    }
#pragma unroll
    for (int dv = 0; dv < 2; ++dv)
#pragma unroll
        for (int k = 0; k < 2; ++k) {
            unsigned ax = pk2(o[dv][8 * k + 0], o[dv][8 * k + 1]), ay = pk2(o[dv][8 * k + 2], o[dv][8 * k + 3]);
            unsigned bx = pk2(o[dv][8 * k + 4], o[dv][8 * k + 5]), by = pk2(o[dv][8 * k + 6], o[dv][8 * k + 7]);
            const auto sx = __builtin_amdgcn_permlane32_swap(ax, bx, false, false), sy = __builtin_amdgcn_permlane32_swap(ay, by, false, false);
            const u32x4 w = {sx[0], sy[0], sx[1], sy[1]};
            *(u32x4*)(orow + 32 * dv + 16 * k + 8 * hh) = w; }
}

template <int ABL = 0> DI void attn_c_unit(const Ctx& p, const int u, ldsp lds, const int dry = 0) {
    const int wave = tid_now() >> 6, r = tid_now() & 31;
    const bf16_t* QC = (const bf16_t*)(p.ws + WS_X + X_QC); const bf16_t* KC = (const bf16_t*)(p.ws + WS_X + X_KC); const bf16_t* CVt = (const bf16_t*)(p.ws + WS_X + X_CVT);
    bf16_t* Z = (bf16_t*)(p.ws + WS_Z);
    int b, h, row, nt, t0;
    if (u < 512) { b = u >> 6; h = (u >> 4) & 3; row = b * SEQ + (u & 15) * 256 + wave * 32 + r; nt = 68; t0 = 0; }
    else { const int v = u - 512; b = v >> 2; h = v & 3; row = ML + b * CTXL + wave * 32 + r; nt = 4; t0 = 64; }
    const bf16_t* kbase = KC + (size_t)(b * 4 + h) * KEYS * 160;
    attn_unit<96, 1, 0, ABL>(lds, QC + (size_t)row * 384 + h * 96, nt,
        [=](int j, const bf16_t*& kp, int& ldk, const bf16_t*& vp, int& kpos0, int& masked) { const int key0 = (t0 + j) * 64; kp = kbase + (size_t)key0 * 160; ldk = 160; vp = kp + 96; kpos0 = 0; masked = 0; },
        0.10206207261596577f * 1.4426950408889634f, -1.0e30f, 0.f, 0, dry ? (bf16_t*)(p.ws + WS_END) + (size_t)(row & 8191) * 1024 + h * 64 : Z + (size_t)row * NZ + ZC_Q + h * 64, 0.f, 0.f, nullptr,
        u < 512 ? (row & 4095) : -1, (const f32x2*)(p.ws + WS_ROPE8));
}
DI void attn_d_unit(const Ctx& p, const int li, const int u, ldsp lds, const int dry = 0) {
    const int wave = tid_now() >> 6, r = tid_now() & 31;
    bf16_t* Z = (bf16_t*)(p.ws + WS_Z); const bf16_t* DVt = (const bf16_t*)(p.ws + WS_X + X_DVT);
    int b, h, row, nt, t0;
    if (u < 512) { b = u >> 6; h = (u >> 4) & 3; row = b * SEQ + (u & 15) * 256 + wave * 32 + r; nt = 68; t0 = 0; }
    else { const int v = u - 512; b = v >> 2; h = v & 3; row = ML + b * CTXL + wave * 32 + r; nt = 4; t0 = 64; }
    const float* lamv = (const float*)(p.ws + WS_LAM); const float lam = lamv[li * 2], lam_init = lamv[li * 2 + 1];
    const bf16_t* zv = Z + ZD_V + h * 64; const bf16_t* zk = Z + ZD_K + h * 64;
    attn_unit<32, 2, 1>(lds, Z + (size_t)row * NZ + ZD_Q + h * 64, nt,
        [=](int j, const bf16_t*& kp, int& ldk, const bf16_t*& vp, int& kpos0, int& masked) { const int key0 = (t0 + j) * 64; const size_t kr = (size_t)key_row(b, key0) * NZ; kp = zk + kr; ldk = NZ; vp = zv + kr; kpos0 = 0; masked = 0; },
        0.17677669529663687f * 1.4426950408889634f, -1.0e30f, 0.f, 0, dry ? (bf16_t*)(p.ws + WS_END) + (size_t)(row & 8191) * 1024 + h * 64 : Z + (size_t)row * NZ + ZD_Q + h * 64, lam, 1.f - lam_init, p.in[20] + li * 64,
        u < 512 ? (row & 4095) : -1, (const f32x2*)(p.ws + WS_ROPE8));
}
DI void attn_a_unit(const Ctx& p, const int li, const int u, ldsp lds, const int dry = 0) {
    const int wave = tid_now() >> 6, r = tid_now() & 31;
    bf16_t* Z = (bf16_t*)(p.ws + WS_Z); const bf16_t* AVt = (const bf16_t*)(p.ws + WS_X + X_AVT);
    int b, kvh, row, qpos, nt, tlo;
    const bool latq = u < 512;
    if (latq) { b = u >> 6; kvh = (u >> 5) & 1; const int qb = u & 31; qpos = qb * 128 + (wave & 3) * 32 + r; row = b * SEQ + qpos;
        const int lo = qb > 0 ? (qb - 1) * 2 : 0, hi = qb < 31 ? (qb + 2) * 2 : 64; tlo = lo; nt = (hi - lo) + 4; }
    else { const int v = u - 512; b = v >> 2; kvh = (v >> 1) & 1; qpos = 0; row = ML + b * CTXL + (v & 1) * 128 + (wave & 3) * 32 + r; tlo = 64; nt = 4; }
    const int head = 2 * kvh + (wave >> 2);
    const int nband = latq ? nt - 4 : 0;
    const bf16_t* zv = Z + ZA_V + kvh * 64; const bf16_t* zk = Z + ZA_K + kvh * 64;
    const float sink = p.in[12][li * 4 + head] * 1.4426950408889634f;
    attn_unit<64, 1, 2>(lds, Z + (size_t)row * NZ + ZA_Q + head * 64, nt,
        [=](int j, const bf16_t*& kp, int& ldk, const bf16_t*& vp, int& kpos0, int& masked) {
            const int key0 = j < nband ? (tlo + j) * 64 : SEQ + (j - nband) * 64;
            const size_t kr = (size_t)key_row(b, key0) * NZ; kp = zk + kr; ldk = NZ; vp = zv + kr; kpos0 = key0; masked = j < nband; },
        0.125f * 1.4426950408889634f, sink, (tid_now() & 32) ? 0.f : 1.f, qpos, dry ? (bf16_t*)(p.ws + WS_END) + (size_t)(row & 8191) * 1024 + head * 64 : Z + (size_t)row * NZ + ZA_Q + head * 64, 0.f, 0.f, nullptr,
        latq ? qpos : -1, (const f32x2*)(p.ws + WS_ROPE16));
}

enum { PH_PRE = 0, PH_WN1, PH_IN, PH_PREP, PH_MLA, PH_MIX, PH_GATE0, PH_MERGE0, PH_GATE1, PH_MERGE1, PH_OUT, PH_NORM2, PH_SCAT, PH_MOE1, PH_MOE2, PH_FINAL, PH_COUNT };

template <int PH> DI void run_phase(const Params& P, const CtxRaw& pc, const int li, ldsp lds) {
    const Ctx p = fresh(pc);
    unsigned char* ws = p.ws; const char* wt = (const char*)(ws + WS_WT);
    const int G = gdim_now(), c = bid_now();
    if constexpr (PH == PH_PRE) phase_pre(P, lds);
    if constexpr (PH == PH_WN1) { phase_wconv(p, li, lds); phase_norm<0>(p, li); }
    if constexpr (PH == PH_IN) {
        pg8::SchedPlain S{(const char*)(ws + WS_HB), wt + WT_IN, 1024, 1024, MT / 256, NZ / 256, G, c, 0};
        pg8::EpiZ E{(bf16_t*)(ws + WS_Z)};
        pg8::gemm_phase(lds, 1024, 1024, 1024, S, E);
    }
    if constexpr (PH == PH_PREP) phase_prep(p, li, lds);
    if constexpr (PH == PH_MLA) {
        pg8::SchedPlain S{(const char*)(ws + WS_Z) + ZC_Q * 2, wt + WT_MLA, NZ, 384, MT / 256, 4, G, c, 0};
        pg8::EpiMla E{(bf16_t*)(ws + WS_X + X_QC), (bf16_t*)(ws + WS_X + X_KC), (bf16_t*)(ws + WS_X + X_CVT)};
#ifdef DUP_HSCAN
        { int dry = 1; asm volatile("" : "+s"(dry)); phase_hscan(p, dry); }
#endif
        phase_hscan(p);
#ifdef DUP_MLAG
        pg8::gemm_phase(lds, NZ, 384, 384, S, E);
#endif
        pg8::gemm_phase(lds, NZ, 384, 384, S, E);
    }
    if constexpr (PH == PH_MIX) {
        const int nq = li == 0 ? 544 : 512;
        const int cv = (G & 7) == 0 ? (c & 7) * (G >> 3) + (c >> 3) : c;
        for (int u = cv; u < nq; u += G) attn_c_unit(p, u, lds);
#ifdef DUP_ATTN_C
        { int dry = 1; asm volatile("" : "+s"(dry)); __syncthreads(); for (int u = cv; u < nq; u += G) attn_c_unit<DUP_ATTN_C>(p, u, lds, dry); __syncthreads(); }
#endif
#ifdef DUP_ATTN_D
        { int dry = 1; asm volatile("" : "+s"(dry)); for (int u = cv; u < nq; u += G) attn_d_unit(p, li, u, lds, dry); __syncthreads(); }
#endif
        for (int u = (cv + 32) % G; u < nq; u += G) attn_d_unit(p, li, u, lds);
#ifdef DUP_ATTN_A
        { int dry = 1; asm volatile("" : "+s"(dry)); for (int u = cv; u < nq; u += G) attn_a_unit(p, li, u, lds, dry); __syncthreads(); }
#endif
        for (int u = (cv + 64) % G; u < nq; u += G) attn_a_unit(p, li, u, lds);
        __syncthreads();
        const int nch = li == 0 ? NCHUNK : 512;
#ifdef DUP_H3
        { int dry = 1; asm volatile("" : "+s"(dry)); for (int u = cv; u < nch; u += G) hgrn3_unit(p, li, u, lds, dry); __syncthreads(); }
#endif
        for (int u = (cv + 96) % G; u < nch; u += G) hgrn3_unit(p, li, u, lds);
    }
    if constexpr (PH == PH_GATE0) {
        const int nM = li == 0 ? 136 : 128;
        pg8::SchedPlain S{(const char*)(ws + WS_HB), wt + WT_G, 1024, 1024, nM, 16, G, c, 0};
        pg8::EpiGate E{(unsigned char*)(ws + WS_X)};
        pg8::gemm_phase(lds, 1024, 1024, 1024, S, E);
    }
    if constexpr (PH == PH_MERGE0) {
        const int nM = li == 0 ? 136 : 128;
        pg8::SchedSeg S{(const char*)(ws + WS_Z), wt + WT_B, nM, G, c, 0};
        pg8::EpiHorner E{(bf16_t*)(ws + WS_Z), (const unsigned char*)(ws + WS_X)};
        pg8::gemm_seg(lds, NZ, 256, S, E);
    }
    if constexpr (PH == PH_OUT) {
        const int nM = li == 0 ? 136 : 128;
        pg8::SchedPlain S{(const char*)(ws + WS_Z) + ZY * 2, wt + WT_O, NZ, 1024, nM, 4, G, c, 0};
        float* ctxs = (float*)(ws + WS_CTXS);
        pg8::EpiOut E{li == 0 ? p.in[0] : p.out, li == 0 ? p.in[2] : ctxs, p.out, ctxs, (const float*)(ws + WS_MODV) + li * 9 * 6144};
        pg8::gemm_phase(lds, NZ, 1024, 1024, S, E);
    }
    if constexpr (PH == PH_NORM2) {
#ifdef DUP_NORM2
        { int dry = 1; asm volatile("" : "+s"(dry)); phase_norm2(p, li, lds, dry); __syncthreads(); }
#endif
        phase_norm2(p, li, lds); }
    if constexpr (PH == PH_MOE1 || PH == PH_MOE2) {
        LAS unsigned* off = (LAS unsigned*)(lds + pg8::STAGE_BYTES + 1024); LAS unsigned char* pe = (LAS unsigned char*)(lds + pg8::STAGE_BYTES);
        const unsigned* cnt = (const unsigned*)(ws + WS_CTL + CTL_CNT) + li * 32; const int* list = (const int*)(ws + WS_XG);
        const int nP = moe_offsets(cnt, off, pe);
        if constexpr (PH == PH_MOE1) {
            pg8::SchedMoeT<false> S{wt + WT_E1, 1024, nP, 2, G, c, (size_t)512 * 1024 * 2, pe, off, list, cnt, 1, 11};
            pg8::EpiMoeUp E{(bf16_t*)(ws + WS_HMID), off, cnt};
            pg8::gemm_gather(lds, (const char*)(ws + WS_HB), 1024, 1024, S, E);
        } else {
            pg8::SchedMoeT<true> S{wt + WT_E2, 256, nP, 4, G, c, (size_t)1024 * 256 * 2, pe, off, list, cnt, 0, 9};
            pg8::EpiMoeDown E{(bf16_t*)(ws + WS_Y), off, list, cnt, (const float*)(ws + WS_XG) + (size_t)32 * MOE_CAP};
            pg8::gemm_gather(lds, (const char*)(ws + WS_HMID), 256, 256, S, E);
        }
        __syncthreads();
    }
    if constexpr (PH == PH_FINAL) phase_norm<2>(p, 1);
}

#if N_LAUNCH_MODE == 1
template <int PH> __global__ __launch_bounds__(512, 2) void k_phase(Params p, int li) {
    extern __shared__ __attribute__((aligned(16))) unsigned char shm[];
    CtxRaw c; c.tab = (unsigned long long)(p.ws + WS_TAB); c.out = (unsigned long long)p.out; c.ws = (unsigned long long)p.ws;
    run_phase<PH>(p, c, li, (ldsp)shm);
}
#else
__global__ __launch_bounds__(512, 2) void k_mega(Params p) {
    extern __shared__ __attribute__((aligned(16))) unsigned char shm[];
    ldsp lds = (ldsp)shm;
    volatile LAS unsigned* st = (volatile LAS unsigned*)(lds + LDS_BYTES - 16);
    if (tid_now() == 0) { st[0] = 0u; st[1] = 0u; st[2] = 0u; st[3] = 0u; }
    __syncthreads();
    XcdBarrier bar = xcd_barrier_post((unsigned*)(p.ws + WS_CTL), st);
    CtxRaw c; c.tab = (unsigned long long)(p.ws + WS_TAB); c.out = (unsigned long long)p.out; c.ws = (unsigned long long)p.ws;
#ifdef STAMP_A
    LAS unsigned* tacc = (LAS unsigned*)(lds + LDS_BYTES - 512);
    if (tid_now() < 32) tacc[tid_now()] = 0u;
    __syncthreads();
    unsigned long long tprev = __builtin_amdgcn_s_memrealtime();
#define STAMP(ph) do { if (bid_now() == 0 && tid_now() == 0) { const unsigned long long tn = __builtin_amdgcn_s_memrealtime(); tacc[ph] += (unsigned)(tn - tprev); tprev = tn; } } while (0)
#else
#define STAMP(ph) do { } while (0)
#endif
#ifndef DUP_MASK
#define DUP_MASK 0
#endif
#ifndef DUP_L0_MASK
#define DUP_L0_MASK 0
#endif
#define DUP(PHX) do { if (((DUP_MASK >> PHX) & 1) || (((DUP_L0_MASK >> PHX) & 1) && li == 0)) { run_phase<PHX>(p, c, li, lds); xcd_barrier(bar); } } while (0)
    run_phase<PH_PRE>(p, c, 0, lds); xcd_barrier(bar); STAMP(PH_PRE);
#ifdef DUP_PRE
    run_phase<PH_PRE>(p, c, 0, lds); xcd_barrier(bar);
#endif
    for (int li = 0; li < 2; ++li) {
        run_phase<PH_WN1>(p, c, li, lds); xcd_barrier(bar); STAMP(PH_WN1); DUP(PH_WN1);
        run_phase<PH_IN>(p, c, li, lds); xcd_barrier(bar); STAMP(PH_IN); DUP(PH_IN);
        run_phase<PH_PREP>(p, c, li, lds); xcd_barrier(bar); STAMP(PH_PREP); DUP(PH_PREP);
        run_phase<PH_MLA>(p, c, li, lds); xcd_barrier(bar); STAMP(PH_MLA); DUP(PH_MLA);
        run_phase<PH_MIX>(p, c, li, lds); xcd_barrier(bar); STAMP(PH_MIX); DUP(PH_MIX);
        run_phase<PH_GATE0>(p, c, li, lds); xcd_barrier(bar); STAMP(PH_GATE0); DUP(PH_GATE0);
        run_phase<PH_MERGE0>(p, c, li, lds); xcd_barrier(bar); STAMP(PH_MERGE0); DUP(PH_MERGE0);
        run_phase<PH_OUT>(p, c, li, lds); xcd_barrier(bar); STAMP(PH_OUT); DUP(PH_OUT);
        run_phase<PH_NORM2>(p, c, li, lds); xcd_barrier(bar); STAMP(PH_NORM2); DUP(PH_NORM2);
        run_phase<PH_MOE1>(p, c, li, lds); xcd_barrier(bar); STAMP(PH_MOE1); DUP(PH_MOE1);
        run_phase<PH_MOE2>(p, c, li, lds); xcd_barrier(bar); STAMP(PH_MOE2); DUP(PH_MOE2);
    }
#ifdef STAMP_A
    if (bid_now() == 0 && tid_now() == 0) { float* tv = (float*)(p.ws + WS_LAM + 64); unsigned sa = 0u, sb = 0u;
#pragma unroll
        for (int q = 0; q < PH_COUNT; ++q) { if ((STAMP_A >> q) & 1) sa += tacc[q]; if ((STAMP_B >> q) & 1) sb += tacc[q]; }
        tv[0] = (float)sa * 0.01f; tv[1] = (float)sb * 0.01f; }
    xcd_barrier(bar);
#endif
    run_phase<PH_FINAL>(p, c, 1, lds);
}
#endif

extern "C" void kernel_launch(void* const* d_in, const int* in_sizes, int n_in, void* d_out, int out_size, void* d_ws, size_t ws_size, hipStream_t stream) {
    if (n_in != 29 || ws_size < WS_END || out_size != ML * D) { fprintf(stderr, "kernel_launch: unexpected shapes (n_in %d, ws %zu need %zu, out %d)\n", n_in, ws_size, (size_t)WS_END, out_size); return; }
    Params p{};
    for (int i = 0; i < 29; ++i) p.in[i] = (const float*)d_in[i];
    p.out = (float*)d_out; p.ws = (unsigned char*)d_ws;
    hipMemsetAsync((char*)d_ws + WS_CTL, 0, 65536, stream);
    const int grid = 256;
#if N_LAUNCH_MODE == 1
    static bool init = false;
#define SETLDS(PH) hipFuncSetAttribute((const void*)k_phase<PH>, hipFuncAttributeMaxDynamicSharedMemorySize, LDS_BYTES)
    if (!init) { SETLDS(PH_PRE); SETLDS(PH_WN1); SETLDS(PH_IN); SETLDS(PH_PREP); SETLDS(PH_MLA); SETLDS(PH_MIX); SETLDS(PH_GATE0); SETLDS(PH_MERGE0); SETLDS(PH_GATE1); SETLDS(PH_MERGE1);
        SETLDS(PH_OUT); SETLDS(PH_NORM2); SETLDS(PH_SCAT); SETLDS(PH_MOE1); SETLDS(PH_MOE2); SETLDS(PH_FINAL); init = true; }
#define LAUNCH(PH, li) hipLaunchKernelGGL(k_phase<PH>, dim3(grid), dim3(512), LDS_BYTES, stream, p, li)
    LAUNCH(PH_PRE, 0);
    for (int li = 0; li < 2; ++li) {
        LAUNCH(PH_WN1, li); LAUNCH(PH_IN, li); LAUNCH(PH_PREP, li); LAUNCH(PH_MLA, li); LAUNCH(PH_MIX, li);
        LAUNCH(PH_GATE0, li); LAUNCH(PH_MERGE0, li); LAUNCH(PH_OUT, li);
        LAUNCH(PH_NORM2, li); LAUNCH(PH_MOE1, li); LAUNCH(PH_MOE2, li);
    }
    LAUNCH(PH_FINAL, 1);
#else
    static bool init = false;
    if (!init) { hipFuncSetAttribute((const void*)k_mega, hipFuncAttributeMaxDynamicSharedMemorySize, LDS_BYTES); init = true; }
    hipLaunchKernelGGL(k_mega, dim3(grid), dim3(512), LDS_BYTES, stream, p);
#endif
}
```
